# Optimizing an MI355X kernel written in HIP

```python
import jax, jax.numpy as jnp
from jax import lax
import numpy as np

D_MODEL = 1024
BATCH = 32
SEQ = 2048
DEPTH = 2

D_POOL = D_MODEL // 2
POOL_WINDOWS = (2, 4, 8, 16)
POOL_GROUP = D_POOL // len(POOL_WINDOWS)
D_GLA_V = D_MODEL // 2
GLA_HEADS = 4
GLA_DK = (D_GLA_V // 2) // GLA_HEADS
GLA_DV = D_GLA_V // GLA_HEADS
GLA_RANK = 16
GATE_NORM = 16.0
GLA_CHUNK = 64
D_IN = D_POOL + 2 * GLA_HEADS * GLA_DK + 2 * D_GLA_V + 2 * GLA_RANK

N_EXPERTS = 32
N_GROUPS = 4
EXPERTS_PER_GROUP = N_EXPERTS // N_GROUPS
TOP_K = 2
D_FF = 512
MOE_BLOCK = 512
EPS = 1e-6

kernel_name = "hybrid_pool_gla_groupmoe_adaln_encoder"


def rms_norm(x):
    xf = x.astype(jnp.float32)
    y = xf * lax.rsqrt(jnp.mean(xf * xf, axis=-1, keepdims=True) + EPS)
    return y.astype(x.dtype)


def pool_mixer(u, w_pool, pool_scale):
    bn, sn, _ = u.shape
    uf = u.astype(jnp.float32)
    pos = jnp.arange(sn)
    outs = []
    for gi, w in enumerate(POOL_WINDOWS):
        ug = uf[..., gi * POOL_GROUP:(gi + 1) * POOL_GROUP]
        csum = jnp.concatenate([jnp.zeros((bn, 1, POOL_GROUP), jnp.float32), jnp.cumsum(ug, axis=1)], axis=1)
        lo = jnp.clip(pos - w // 2, 0, sn - 1)
        hi = jnp.clip(pos - w // 2 + w - 1, 0, sn - 1)
        cnt = (hi - lo + 1).astype(jnp.float32)[None, :, None]
        outs.append((csum[:, hi + 1] - csum[:, lo]) / cnt - ug)
    pooled = jnp.stack(outs, axis=2).astype(u.dtype)
    y = jnp.einsum('bsgc,gcd->bsgd', pooled, w_pool)
    return y.reshape(bn, sn, D_POOL) * pool_scale


def gla_chunked(q, k, v, loga, strict):
    bn, hn, sn, dk = q.shape
    dv = v.shape[-1]
    nc = sn // GLA_CHUNK
    q = q.reshape(bn, hn, nc, GLA_CHUNK, dk)
    k = k.reshape(bn, hn, nc, GLA_CHUNK, dk)
    v = v.reshape(bn, hn, nc, GLA_CHUNK, dv)
    b = jnp.cumsum(loga.reshape(bn, hn, nc, GLA_CHUNK, dk), axis=3)
    qe = q * jnp.exp(b)
    ke = k * jnp.exp(-b)
    mask = jnp.tril(jnp.ones((GLA_CHUNK, GLA_CHUNK), bool), -1 if strict else 0)
    att = jnp.where(mask, jnp.einsum('bhnid,bhnjd->bhnij', qe, ke), 0.0)
    o = jnp.einsum('bhnij,bhnjv->bhniv', att, v)
    b_last = b[..., -1:, :]
    upd = jnp.einsum('bhncd,bhncv->bhndv', k * jnp.exp(b_last - b), v)
    decay = jnp.exp(b_last[..., 0, :])

    def step(state, inp):
        u_n, g_n = inp
        return g_n[..., None] * state + u_n, state

    _, s_before = lax.scan(step, jnp.zeros((bn, hn, dk, dv), jnp.float32),
                           (jnp.moveaxis(upd, 2, 0), jnp.moveaxis(decay, 2, 0)))
    s_before = jnp.moveaxis(s_before, 0, 2)
    o = o + jnp.einsum('bhncd,bhndv->bhncv', qe, s_before)
    return o.reshape(bn, hn, sn, dv)


def gla_mixer(q, k, v, g, r_f, r_b, w_gk_up, b_gk, norm_g):
    bn, sn, _ = q.shape

    def heads(t, d):
        return t.reshape(bn, sn, GLA_HEADS, d).transpose(0, 2, 1, 3).astype(jnp.float32)

    qh = heads(q, GLA_DK) * (GLA_DK ** -0.5)
    kh = heads(k, GLA_DK)
    vh = heads(v, GLA_DV)
    la_f = heads(jax.nn.log_sigmoid((r_f @ w_gk_up[0] + b_gk[0]).astype(jnp.float32)) / GATE_NORM, GLA_DK)
    la_b = heads(jax.nn.log_sigmoid((r_b @ w_gk_up[1] + b_gk[1]).astype(jnp.float32)) / GATE_NORM, GLA_DK)
    flip = lambda t: jnp.flip(t, axis=2)
    o = gla_chunked(qh, kh, vh, la_f, False) + flip(gla_chunked(flip(qh), flip(kh), flip(vh), flip(la_b), True))
    o = o * lax.rsqrt(jnp.mean(o * o, axis=-1, keepdims=True) + EPS) * norm_g.astype(jnp.float32)
    o = o.transpose(0, 2, 1, 3).reshape(bn, sn, D_GLA_V).astype(q.dtype)
    return o * jax.nn.silu(g)


def moe_ffn(h, w_router, b_router, w1, w3, w2):
    bn, sn, d = h.shape
    t = bn * sn
    ht = h.reshape(t, d)
    s = jax.nn.sigmoid(jnp.dot(ht.astype(jnp.float32), w_router.astype(jnp.float32)))
    sel = (s + b_router.astype(jnp.float32)).reshape(t, N_GROUPS, EXPERTS_PER_GROUP)
    g_idx = jnp.argmax(lax.top_k(sel, TOP_K)[0].sum(-1), axis=-1)
    in_grp = jnp.take_along_axis(sel, g_idx[:, None, None], axis=1)[:, 0]
    _, loc = lax.top_k(in_grp, TOP_K)
    e_idx = (g_idx[:, None] * EXPERTS_PER_GROUP + loc).astype(jnp.int32)
    gw = jnp.take_along_axis(s, e_idx, axis=1)
    gw = gw / jnp.sum(gw, axis=-1, keepdims=True)

    n_assign = t * TOP_K
    flat_e = e_idx.reshape(n_assign)
    flat_w = gw.reshape(n_assign).astype(h.dtype)
    flat_tok = jnp.arange(n_assign, dtype=jnp.int32) // TOP_K
    order = jnp.argsort(flat_e)
    sorted_e = flat_e[order]
    counts = jnp.bincount(flat_e, length=N_EXPERTS).astype(jnp.int32)
    padded = (counts + MOE_BLOCK - 1) // MOE_BLOCK * MOE_BLOCK
    pad_end = jnp.cumsum(padded)
    pad_start = pad_end - padded
    start = jnp.cumsum(counts) - counts
    dest = pad_start[sorted_e] + jnp.arange(n_assign, dtype=jnp.int32) - start[sorted_e]
    n_blocks = -(-n_assign // MOE_BLOCK) + N_EXPERTS
    rows = n_blocks * MOE_BLOCK
    row_tok = jnp.full((rows,), t, jnp.int32).at[dest].set(flat_tok[order])
    row_w = jnp.zeros((rows,), h.dtype).at[dest].set(flat_w[order])
    blk_e = jnp.minimum(jnp.searchsorted(pad_end, jnp.arange(n_blocks, dtype=jnp.int32) * MOE_BLOCK, side='right'),
                        N_EXPERTS - 1)
    x_pad = jnp.concatenate([ht, jnp.zeros((1, d), h.dtype)], axis=0)

    def block_ffn(args):
        e, tok, wt = args
        xb = x_pad[tok]
        hid = jax.nn.silu(xb @ w1[e]) * (xb @ w3[e])
        return (hid @ w2[e]) * wt[:, None]

    ys = lax.map(block_ffn, (blk_e, row_tok.reshape(n_blocks, MOE_BLOCK), row_w.reshape(n_blocks, MOE_BLOCK)))
    out = jnp.zeros((t + 1, d), h.dtype).at[row_tok].add(ys.reshape(rows, d))
    return out[:t].reshape(bn, sn, d)


def setup_inputs(seed: int = 0) -> dict:
    key = jax.random.key(seed)
    ks = jax.random.split(key, 20)
    f32 = jnp.float32
    nrm = lambda k, shape, scale: jax.random.normal(k, shape, f32) * scale
    L, D = DEPTH, D_MODEL
    return {
        "x": nrm(ks[0], (BATCH, SEQ, D), 1.0),
        "c": nrm(ks[1], (BATCH, D), 1.0),
        "w_mod": nrm(ks[2], (L, D, 6 * D), 0.5 * D ** -0.5),
        "b_mod": nrm(ks[3], (L, 6 * D), 0.02),
        "w_in": nrm(ks[4], (L, D, D_IN), D ** -0.5),
        "w_pool": nrm(ks[5], (L, len(POOL_WINDOWS), POOL_GROUP, POOL_GROUP), POOL_GROUP ** -0.5),
        "pool_scale": 1.0 + nrm(ks[6], (L, D_POOL), 0.02),
        "w_gk_up": nrm(ks[7], (L, 2, GLA_RANK, GLA_HEADS * GLA_DK), GLA_RANK ** -0.5),
        "b_gk": nrm(ks[8], (L, 2, GLA_HEADS * GLA_DK), 0.1),
        "gla_norm_g": 1.0 + nrm(ks[9], (L, GLA_DV), 0.02),
        "w_out": nrm(ks[10], (L, D, D), D ** -0.5),
        "w_router": nrm(ks[11], (D, N_EXPERTS), D ** -0.5),
        "b_router": nrm(ks[12], (N_EXPERTS,), 0.01),
        "w1": nrm(ks[13], (L, N_EXPERTS, D, D_FF), D ** -0.5),
        "w3": nrm(ks[14], (L, N_EXPERTS, D, D_FF), D ** -0.5),
        "w2": nrm(ks[15], (L, N_EXPERTS, D_FF, D), D_FF ** -0.5),
        "final_g": 1.0 + nrm(ks[16], (D,), 0.02),
    }


def reference(x, c, w_mod, b_mod, w_in, w_pool, pool_scale, w_gk_up, b_gk, gla_norm_g, w_out,
              w_router, b_router, w1, w3, w2, final_g):
    split_at = np.cumsum([D_POOL, GLA_HEADS * GLA_DK, GLA_HEADS * GLA_DK, D_GLA_V, D_GLA_V, GLA_RANK]).tolist()
    c_act = jax.nn.silu(c)
    for l in range(DEPTH):
        mod = (c_act @ w_mod[l] + b_mod[l])[:, None, :]
        sh1, sc1, g1, sh2, sc2, g2 = jnp.split(mod, 6, axis=-1)
        h = rms_norm(x) * (1.0 + sc1) + sh1
        z = h @ w_in[l]
        u_pool, q, k, v, g, r_f, r_b = jnp.split(z, split_at, axis=-1)
        y_pool = pool_mixer(u_pool, w_pool[l], pool_scale[l])
        y_gla = gla_mixer(q, k, v, g, r_f, r_b, w_gk_up[l], b_gk[l], gla_norm_g[l])
        mix = jnp.concatenate([y_pool, y_gla], axis=-1) @ w_out[l]
        x = x + g1 * mix
        h = rms_norm(x) * (1.0 + sc2) + sh2
        x = x + g2 * moe_ffn(h, w_router, b_router, w1[l], w3[l], w2[l])
    return rms_norm(x) * final_g
```

```cpp
#include <hip/hip_runtime.h>
#include <hip/hip_cooperative_groups.h>
#include <cstdio>
#include <cstdint>
namespace cg = cooperative_groups;

#ifndef MK_MASK
#define MK_MASK 0xFFF
#endif
#ifndef MK_MULTI
#define MK_MULTI 1
#endif

constexpr int DM = 1024, NB = 32, SEQ = 2048, T = NB * SEQ, DEPTH = 2;
constexpr int DIN = 2080, ZP = 2304;
constexpr int C_Q = 512, C_K = 768, C_V = 1024, C_G = 1536, C_RF = 2048;
constexpr int NE = 32, DFF = 512;
constexpr int HS_ROWS = 139264;
constexpr float EPS = 1e-6f;

constexpr size_t MiB = 1u << 20;
constexpr size_t WS_CTL = 0;
constexpr size_t WS_MOD = 1 * MiB;
constexpr size_t WS_BIASIN = 3 * MiB;
constexpr size_t WS_RSTD = 4 * MiB;
constexpr size_t WS_ROWSQ = 5 * MiB;
constexpr size_t WS_DEC = 9 * MiB;
constexpr size_t WS_TOK = 11 * MiB;
constexpr size_t WS_GWL = 19 * MiB;
constexpr size_t WS_WPT = 28 * MiB;
constexpr size_t WS_WOUT = 29 * MiB;
constexpr size_t WS_WIN = 33 * MiB;
constexpr size_t WS_W2 = 42 * MiB;
constexpr size_t WS_W13 = 106 * MiB;
constexpr size_t WS_ABUF = 234 * MiB;
constexpr size_t WS_R = 362 * MiB;
constexpr size_t WS_Z = WS_R;
constexpr size_t WS_ST = WS_R + 288 * MiB;
constexpr size_t WS_HS = WS_R;
constexpr size_t WS_Y2 = WS_R;
constexpr size_t WS_ACT = WS_R + 272 * MiB;
constexpr size_t WS_END = WS_R + 416 * MiB;
constexpr int LDS_BYTES = 147456;
constexpr int LDS_SPARE = 131072;

typedef unsigned short bf16;
typedef float f32x4 __attribute__((ext_vector_type(4)));
typedef float f32x16 __attribute__((ext_vector_type(16)));
typedef short bf16x8 __attribute__((ext_vector_type(8)));
typedef unsigned u32x4 __attribute__((ext_vector_type(4)));
typedef unsigned u32x2 __attribute__((ext_vector_type(2)));
typedef float f32x2_t __attribute__((ext_vector_type(2)));
typedef __bf16 bf16x2_t __attribute__((ext_vector_type(2)));

__device__ __forceinline__ unsigned cvtpk(float lo, float hi) { f32x2_t v = {lo, hi}; bf16x2_t b = __builtin_convertvector(v, bf16x2_t); return __builtin_bit_cast(unsigned, b); }
__device__ __forceinline__ unsigned short f2bf(float f) { return (unsigned short)(cvtpk(f, 0.f) & 0xffffu); }
__device__ __forceinline__ float bflo(unsigned u) { return __uint_as_float(u << 16); }
__device__ __forceinline__ float bfhi(unsigned u) { return __uint_as_float(u & 0xffff0000u); }
__device__ __forceinline__ float siluf(float x) { return x / (1.0f + __expf(-x)); }
__device__ __forceinline__ float wave_sum(float v) {
#pragma unroll
    for (int o = 1; o < 64; o <<= 1) v += __shfl_xor(v, o);
    return v;
}

namespace pg8 {
#define PG8_LAS __attribute__((address_space(3)))
typedef unsigned short bf16_t;
typedef short bf16x8 __attribute__((ext_vector_type(8)));
typedef float f32x4 __attribute__((ext_vector_type(4)));
typedef unsigned u32x4 __attribute__((ext_vector_type(4)));
constexpr int BM = 256, BK = 64, HALF = 128, HTB = HALF * BK * 2  , STAGE_BYTES = 8 * HTB, NXCD = 8, WGM = 8;

__host__ __device__ __forceinline__ int lds_byte(int r, int c) { const int st = (r >> 4) * 2 + (c >> 5), rr = r & 15, cc = c & 31, ob = rr * 64 + cc * 2; return st * 1024 + (ob ^ (((ob >> 9) & 1) << 5)); }
__host__ __device__ __forceinline__ void stage_rc(int b, int& R, int& C) { const int st = b / 1024, sb = b % 1024, swz = sb ^ (((sb >> 9) & 1) << 5); R = (st >> 1) * 16 + swz / 64; C = (st & 1) * 32 + (swz % 64) / 2; }
__host__ __device__ __forceinline__ int perm32(int rho) { const int n = rho >> 4, i = rho & 15; return 8 * (i >> 2) + 4 * n + (i & 3); }

struct Unit { int pm, pn, x0, x1; };
struct Gemm { const bf16_t* A; const bf16_t* Bt; int M, N, K; };

struct StaticOrder {
    int nM, nN, nwg, G, c;
    __host__ __device__ void init(int M, int N, int G_, int c_) { nM = M / BM; nN = N / BM; nwg = nM * nN; G = G_; c = c_; }
    __host__ __device__ bool next(int i, Unit& u) const {
        const long L = (long)i * G + c; if (L >= nwg) return false;
        int wgid = (int)L; { const int q = nwg / NXCD, r = nwg % NXCD, xcd = wgid % NXCD, off = wgid / NXCD; wgid = (xcd < r ? xcd * (q + 1) : r * (q + 1) + (xcd - r) * q) + off; }
        const int nig = WGM * nN, gid = wgid / nig, fm = gid * WGM, gsz = (nM - fm) < WGM ? (nM - fm) : WGM;
        u.pm = fm + ((wgid % nig) % gsz); u.pn = (wgid % nig) / gsz; return true;
    }
    __device__ __forceinline__ void a_ready(const Unit&) const {}
    __device__ __forceinline__ void done(const Unit&) const {}
};


__device__ __forceinline__ unsigned pk2(float lo, float hi) { typedef float v2f __attribute__((ext_vector_type(2))); typedef __bf16 v2b __attribute__((ext_vector_type(2))); v2f v = {lo, hi}; v2b b = __builtin_convertvector(v, v2b); return __builtin_bit_cast(unsigned, b); }
struct EpiZ {
    static constexpr bool PERM = true, AFTER_DRAIN = false;
    bf16_t* Z; const float* rstd; const float* bias; int zp;
    __device__ __forceinline__ void operator()(const f32x4 (&acc)[2][2][4][2], const Unit& u, int wr, int wc, int fr, int fq) const {
        const int row0 = u.pm * BM + wr * 64 + fr, col0 = u.pn * BM + wc * 32 + 8 * fq;
        const float* bp = bias + (size_t)((u.pm * BM) >> 11) * zp + col0;
        f32x4 bv[2][2];
#pragma unroll
        for (int bj = 0; bj < 2; ++bj)
#pragma unroll
            for (int n = 0; n < 2; ++n) bv[bj][n] = *(const f32x4*)(bp + bj * HALF + 4 * n);
#pragma unroll
        for (int ai = 0; ai < 2; ++ai)
#pragma unroll
            for (int m = 0; m < 4; ++m) { const int row = row0 + ai * HALF + m * 16; const float rs = rstd[row]; bf16_t* rowp = Z + (size_t)row * zp + col0;
#pragma unroll
                for (int bj = 0; bj < 2; ++bj) { const f32x4 v0 = acc[ai][bj][m][0] * rs + bv[bj][0], v1 = acc[ai][bj][m][1] * rs + bv[bj][1];
                    u32x4 w; w.x = pk2(v0[0], v0[1]); w.y = pk2(v0[2], v0[3]); w.z = pk2(v1[0], v1[1]); w.w = pk2(v1[2], v1[3]);
                    *(u32x4*)(rowp + bj * HALF) = w; } }
    }
};
struct EpiRes {
    static constexpr bool PERM = false, AFTER_DRAIN = false;
    const float* xres; float* out; const float* g1; float* rowsq;
    __device__ __forceinline__ void operator()(const f32x4 (&acc)[2][2][4][2], const Unit& u, int wr, int wc, int fr, int fq) const {
        const int row0 = u.pm * BM + wr * 64 + fr, col0 = u.pn * BM + wc * 32 + 4 * fq;
        const float* gp = g1 + (size_t)((u.pm * BM) >> 11) * 6144 + col0;
        f32x4 gv[2][2];
#pragma unroll
        for (int bj = 0; bj < 2; ++bj)
#pragma unroll
            for (int n = 0; n < 2; ++n) gv[bj][n] = *(const f32x4*)(gp + bj * HALF + n * 16);
#pragma unroll
        for (int ai = 0; ai < 2; ++ai)
#pragma unroll
            for (int m = 0; m < 4; ++m) { const int row = row0 + ai * HALF + m * 16; const size_t off = (size_t)row * 1024 + col0; float s = 0.f;
#pragma unroll
                for (int bj = 0; bj < 2; ++bj)
#pragma unroll
                    for (int n = 0; n < 2; ++n) { const f32x4 xr = *(const f32x4*)(xres + off + bj * HALF + n * 16); const f32x4 o = xr + gv[bj][n] * acc[ai][bj][m][n];
                        *(f32x4*)(out + off + bj * HALF + n * 16) = o; s += (o[0] * o[0] + o[1] * o[1]) + (o[2] * o[2] + o[3] * o[3]); }
                s += __shfl_xor(s, 16); s += __shfl_xor(s, 32);
                if (fq == 0) rowsq[(size_t)row * 16 + u.pn * 4 + wc] = s; }
    }
};
struct EpiAct {
    static constexpr bool PERM = true, AFTER_DRAIN = false;
    bf16_t* ACT;
    __device__ __forceinline__ void operator()(const f32x4 (&acc)[2][2][4][2], const Unit& u, int wr, int wc, int fr, int fq) const {
        if (!(u.x0 >> 8)) return;
        const int ct = u.pn & 3, row0 = u.pm * BM + wr * 64 + fr, col0 = ct * 128 + wc * 32 + 8 * fq;
#pragma unroll
        for (int ai = 0; ai < 2; ++ai)
#pragma unroll
            for (int m = 0; m < 4; ++m) { bf16_t* rowp = ACT + (size_t)(row0 + ai * HALF + m * 16) * 512 + col0;
                float v[8];
#pragma unroll
                for (int n = 0; n < 2; ++n)
#pragma unroll
                    for (int i = 0; i < 4; ++i) { const float a = acc[ai][0][m][n][i], b = acc[ai][1][m][n][i]; v[n * 4 + i] = a / (1.0f + __expf(-a)) * b; }
                u32x4 w; w.x = pk2(v[0], v[1]); w.y = pk2(v[2], v[3]); w.z = pk2(v[4], v[5]); w.w = pk2(v[6], v[7]);
                *(u32x4*)rowp = w; }
    }
};
struct EpiY {
    static constexpr bool PERM = true, AFTER_DRAIN = false;
    bf16_t* Y2; const int* tok; const float* gwl; const int* cnt;
    __device__ __forceinline__ void operator()(const f32x4 (&acc)[2][2][4][2], const Unit& u, int wr, int wc, int fr, int fq) const {
        if (!(u.x0 >> 8)) return;
        const int e = u.x0 & 0xff, ct = u.pn & 3, ne = cnt[e];
#pragma unroll
        for (int ai = 0; ai < 2; ++ai)
#pragma unroll
            for (int m = 0; m < 4; ++m) { const int r = u.x1 + ai * HALF + wr * 64 + m * 16 + fr;
                if (r < ne) { const int tk = tok[e * 65536 + r]; const float gw = gwl[e * 65536 + r];
                    bf16_t* dst = Y2 + (size_t)tk * 1024 + ct * 256 + wc * 32 + 8 * fq;
#pragma unroll
                    for (int bj = 0; bj < 2; ++bj) { const f32x4 v0 = acc[ai][bj][m][0] * gw, v1 = acc[ai][bj][m][1] * gw;
                        u32x4 w; w.x = pk2(v0[0], v0[1]); w.y = pk2(v0[2], v0[3]); w.z = pk2(v1[0], v1[1]); w.w = pk2(v1[2], v1[3]);
                        *(u32x4*)(dst + bj * HALF) = w; } } }
    }
};
struct MoeOrder {
    const PG8_LAS int* tab; int G, c;
    __device__ __forceinline__ bool next(int i, Unit& u) const {
        const int RTP = __builtin_amdgcn_readfirstlane(tab[1]), Rt = __builtin_amdgcn_readfirstlane(tab[0]), nwg = RTP * 4;
        const long L = (long)i * G + c; if (L >= nwg) return false;
        int wgid = (int)L; { const int q = nwg / NXCD, r = nwg % NXCD, xcd = wgid % NXCD, off = wgid / NXCD; wgid = (xcd < r ? xcd * (q + 1) : r * (q + 1) + (xcd - r) * q) + off; }
        const int gid = wgid / 32, w = wgid % 32, rt = 8 * gid + (w & 7), ct = w >> 3, valid = rt < Rt ? 1 : 0, rtc = valid ? rt : 0;
        const int e = __builtin_amdgcn_readfirstlane(tab[128 + rtc]), sb = __builtin_amdgcn_readfirstlane(tab[2 + e]);
        u.pm = rtc; u.pn = e * 4 + ct; u.x0 = e | (valid << 8); u.x1 = (rtc - sb) * 256; return true;
    }
    __device__ __forceinline__ void a_ready(const Unit&) const {}
    __device__ __forceinline__ void done(const Unit&) const {}
};

template <class Epi, class Sched, bool ALIGN_EPI = false, bool SP2 = false>
__device__ __forceinline__ void gemm_phase(PG8_LAS unsigned char* lds, const Gemm g, const Sched& S, const Epi& E) {
    int tid = threadIdx.x; asm volatile("" : "+v"(tid)); const int wid = __builtin_amdgcn_readfirstlane(tid >> 6), lane = tid & 63, wr = wid >> 2, wc = wid & 3, fr = lane & 15, fq = lane >> 4;
    const int K = g.K, nt = K / BK;
    unsigned voffA[2], voffB[2];
#pragma unroll
    for (int i = 0; i < 2; ++i) { int R, C; stage_rc(tid * 16 + i * 8192, R, C); const int Rb = Epi::PERM ? ((R & ~31) + perm32(R & 31)) : R;
        voffA[i] = (unsigned)(R * K + C) * 2u; voffB[i] = (unsigned)(Rb * K + C) * 2u; }
    const size_t kstep = (size_t)(BK * 2);
    const size_t hstep = (size_t)HALF * K * 2;
    const size_t tstep = 2 * hstep;
    const unsigned ldsw = (unsigned)wid * 1024u;
    const int aoff = lds_byte(wr * 64 + fr, fq * 8), boff = lds_byte(wc * 32 + fr, fq * 8);
#define PG8_SA(b, h) (((b) * 2 + (h)) * HTB)
#define PG8_SB(b, h) ((4 + (b) * 2 + (h)) * HTB)
#define PG8_STAGE(bufoff, gbase, voff) do { _Pragma("unroll") for (int _i = 0; _i < 2; ++_i) \
        __builtin_amdgcn_global_load_lds((const unsigned*)((const char*)(gbase) + (voff)[_i]), (PG8_LAS unsigned*)(lds + (bufoff) + ldsw + _i * 8192), 16, 0, 0); } while (0)
#define PG8_LDA(dst, b, h) do { _Pragma("unroll") for (int m = 0; m < 4; ++m) _Pragma("unroll") for (int k = 0; k < 2; ++k) dst[m][k] = *(const PG8_LAS bf16x8*)(lds + PG8_SA(b, h) + aoff + m * 2048 + k * 1024); } while (0)
#define PG8_LDB(dst, b, h) do { _Pragma("unroll") for (int n = 0; n < 2; ++n) _Pragma("unroll") for (int k = 0; k < 2; ++k) dst[n][k] = *(const PG8_LAS bf16x8*)(lds + PG8_SB(b, h) + boff + n * 2048 + k * 1024); } while (0)
#define PG8_MMA(ai, bj, At, Bt) do { __builtin_amdgcn_s_setprio(1); _Pragma("unroll") for (int m = 0; m < 4; ++m) _Pragma("unroll") for (int n = 0; n < 2; ++n) _Pragma("unroll") for (int k = 0; k < 2; ++k) \
        acc[ai][bj][m][n] = __builtin_amdgcn_mfma_f32_16x16x32_bf16(Bt[n][k], At[m][k], acc[ai][bj][m][n], 0, 0, 0); __builtin_amdgcn_s_setprio(0); } while (0)
#define PG8_WAIT_V(n) asm volatile("s_waitcnt vmcnt(" #n ")" ::: "memory")
#define PG8_WAIT_L(n) asm volatile("s_waitcnt lgkmcnt(" #n ")" ::: "memory")
#define PG8_BAR __builtin_amdgcn_s_barrier()
#define PG8_SCHED __builtin_amdgcn_sched_barrier(0)
    Unit cur, nxt; int ui = 0;
    if (!S.next(0, cur)) return;
    f32x4 acc[2][2][4][2];
#pragma unroll
    for (int a = 0; a < 2; ++a)
#pragma unroll
        for (int b = 0; b < 2; ++b)
#pragma unroll
            for (int m = 0; m < 4; ++m)
#pragma unroll
                for (int n = 0; n < 2; ++n) acc[a][b][m][n] = (f32x4){0.f, 0.f, 0.f, 0.f};
    bf16x8 At[4][2], B0[2][2], B1[2][2];
    const char* cA = (const char*)g.A + (size_t)cur.pm * tstep; const char* cB = (const char*)g.Bt + (size_t)cur.pn * tstep;
    S.a_ready(cur);
    if constexpr (SP2) {
        PG8_STAGE(PG8_SB(0, 0), cB, voffB); PG8_STAGE(PG8_SB(0, 1), cB + hstep, voffB); PG8_STAGE(PG8_SA(0, 0), cA, voffA); PG8_STAGE(PG8_SA(0, 1), cA + hstep, voffA);
        if (wr == 1) PG8_BAR;
        PG8_WAIT_V(2); PG8_BAR;
        PG8_STAGE(PG8_SB(1, 0), cB + kstep, voffB); PG8_STAGE(PG8_SA(1, 0), cA + kstep, voffA); PG8_STAGE(PG8_SB(1, 1), cB + hstep + kstep, voffB);
        PG8_WAIT_V(6); PG8_BAR;
    } else {
        PG8_STAGE(PG8_SB(0, 0), cB, voffB); PG8_STAGE(PG8_SA(0, 0), cA, voffA); PG8_STAGE(PG8_SB(0, 1), cB + hstep, voffB); PG8_STAGE(PG8_SA(0, 1), cA + hstep, voffA);
        if (wr == 1) PG8_BAR;
        PG8_WAIT_V(4); PG8_BAR;
        PG8_STAGE(PG8_SB(1, 0), cB + kstep, voffB); PG8_STAGE(PG8_SA(1, 0), cA + kstep, voffA); PG8_STAGE(PG8_SB(1, 1), cB + hstep + kstep, voffB);
        PG8_WAIT_V(6); PG8_BAR;
    }
    for (;;) {
        const bool has_next = S.next(ui + 1, nxt);
        const char* nA = has_next ? (const char*)g.A + (size_t)nxt.pm * tstep : cA; const char* nB = has_next ? (const char*)g.Bt + (size_t)nxt.pn * tstep : cB;
        for (int t = 0; t < nt; t += 2) {
            const bool last = (t == nt - 2);
            const char* a1 = cA + (size_t)(t + 1) * kstep;
            const char* a2 = last ? nA : cA + (size_t)(t + 2) * kstep; const char* b2 = last ? nB : cB + (size_t)(t + 2) * kstep;
            const char* a3 = a2 + kstep; const char* b3 = b2 + kstep;
            if (last && has_next) S.a_ready(nxt);
            if constexpr (SP2) {
            PG8_LDB(B0, 0, 0); PG8_LDB(B1, 0, 1); PG8_SCHED; PG8_LDA(At, 0, 0); PG8_STAGE(PG8_SA(1, 1), a1 + hstep, voffA);
            PG8_WAIT_V(8); PG8_WAIT_L(0); PG8_BAR; PG8_MMA(0, 0, At, B0); PG8_MMA(0, 1, At, B1); PG8_BAR; PG8_SCHED;
            PG8_LDA(At, 0, 1); PG8_STAGE(PG8_SB(0, 0), b2, voffB); PG8_STAGE(PG8_SB(0, 1), b2 + hstep, voffB); PG8_STAGE(PG8_SA(0, 0), a2, voffA);
            PG8_WAIT_V(8); PG8_WAIT_L(0); PG8_BAR; PG8_MMA(1, 0, At, B0); PG8_MMA(1, 1, At, B1); PG8_BAR; PG8_SCHED;
            PG8_LDB(B0, 1, 0); PG8_LDB(B1, 1, 1); PG8_SCHED; PG8_LDA(At, 1, 0); PG8_STAGE(PG8_SA(0, 1), a2 + hstep, voffA);
            PG8_WAIT_V(8); PG8_WAIT_L(0); PG8_BAR; PG8_MMA(0, 0, At, B0); PG8_MMA(0, 1, At, B1); PG8_BAR; PG8_SCHED;
            PG8_LDA(At, 1, 1); PG8_STAGE(PG8_SB(1, 0), b3, voffB); PG8_STAGE(PG8_SB(1, 1), b3 + hstep, voffB); PG8_STAGE(PG8_SA(1, 0), a3, voffA);
            PG8_WAIT_V(8); PG8_WAIT_L(0); PG8_BAR; PG8_MMA(1, 0, At, B0); PG8_MMA(1, 1, At, B1); PG8_BAR; PG8_SCHED;
            } else {
            PG8_LDB(B0, 0, 0); PG8_SCHED; PG8_LDA(At, 0, 0); PG8_STAGE(PG8_SA(1, 1), a1 + hstep, voffA);
            PG8_WAIT_L(8); PG8_BAR; PG8_WAIT_L(0); PG8_MMA(0, 0, At, B0); PG8_BAR; PG8_SCHED;
            PG8_LDB(B1, 0, 1); PG8_STAGE(PG8_SB(0, 0), b2, voffB);
            PG8_BAR; PG8_WAIT_L(0); PG8_MMA(0, 1, At, B1); PG8_BAR;
            PG8_LDA(At, 0, 1); PG8_STAGE(PG8_SA(0, 0), a2, voffA);
            PG8_BAR; PG8_WAIT_L(0); PG8_MMA(1, 0, At, B0); PG8_BAR; PG8_SCHED;
            PG8_STAGE(PG8_SB(0, 1), b2 + hstep, voffB);
            PG8_WAIT_V(6); PG8_BAR; PG8_MMA(1, 1, At, B1); PG8_BAR;
            PG8_LDB(B0, 1, 0); PG8_SCHED; PG8_LDA(At, 1, 0); PG8_STAGE(PG8_SA(0, 1), a2 + hstep, voffA);
            PG8_WAIT_L(8); PG8_BAR; PG8_WAIT_L(0); PG8_MMA(0, 0, At, B0); PG8_BAR; PG8_SCHED;
            PG8_LDB(B1, 1, 1); PG8_STAGE(PG8_SB(1, 0), b3, voffB);
            PG8_BAR; PG8_WAIT_L(0); PG8_MMA(0, 1, At, B1); PG8_BAR;
            PG8_LDA(At, 1, 1); PG8_STAGE(PG8_SA(1, 0), a3, voffA);
            PG8_BAR; PG8_WAIT_L(0); PG8_MMA(1, 0, At, B0); PG8_BAR; PG8_SCHED;
            PG8_STAGE(PG8_SB(1, 1), b3 + hstep, voffB);
            PG8_WAIT_V(6); PG8_BAR; PG8_MMA(1, 1, At, B1); PG8_BAR;
            }
        }
        if constexpr (ALIGN_EPI) { if (wr == 0) PG8_BAR; }
        if constexpr (!Epi::AFTER_DRAIN) { E(acc, cur, wr, wc, fr, fq); S.done(cur); }
        if (!has_next) break;
#pragma unroll
        for (int a = 0; a < 2; ++a)
#pragma unroll
            for (int b = 0; b < 2; ++b)
#pragma unroll
                for (int m = 0; m < 4; ++m)
#pragma unroll
                    for (int n = 0; n < 2; ++n) acc[a][b][m][n] = (f32x4){0.f, 0.f, 0.f, 0.f};
        cur = nxt; cA = nA; cB = nB; ++ui;
        if constexpr (ALIGN_EPI) { if (wr == 1) PG8_BAR; }
    }
    PG8_WAIT_V(0);
    if constexpr (!ALIGN_EPI) { if (wr == 0) PG8_BAR; }
    PG8_BAR;
    if constexpr (Epi::AFTER_DRAIN) { E.fused(acc, cur, wr, wc, fr, fq, lds, wid, lane); S.done(cur); }
#undef PG8_SA
#undef PG8_SB
#undef PG8_STAGE
#undef PG8_LDA
#undef PG8_LDB
#undef PG8_MMA
#undef PG8_WAIT_V
#undef PG8_WAIT_L
#undef PG8_BAR
#undef PG8_SCHED
}
}

struct Params {
    const float *x, *c, *w_mod, *b_mod, *w_in, *w_pool, *pool_scale, *w_gk_up, *b_gk, *gla_norm_g, *w_out, *w_router, *b_router, *w1, *w3, *w2, *final_g;
    float* out; unsigned char* ws; int ph_lo, ph_hi;
};
typedef const __attribute__((address_space(4))) Params* CP;
#define LDSF(off) ((float*)(lds + (off)))

__device__ __forceinline__ void p0_transpose_item(const float* W, int K, int N, bf16* WT, int imode, float* scr, int item, int lane) {
    const int nblk = N / 32, kb = item / nblk, nb = item % nblk, k0 = 64 * kb, n0 = 32 * nb;
    const int rbase = imode == 0 ? n0 : (256 * (n0 >> 7) + (n0 & 127) + (imode == 2 ? 128 : 0));
#pragma unroll 8
    for (int i = 0; i < 32; ++i) { const int kk = 2 * i + (lane >> 5); scr[kk * 33 + (lane & 31)] = W[(size_t)(k0 + kk) * N + n0 + (lane & 31)]; }
    asm volatile("s_waitcnt lgkmcnt(0)" ::: "memory");
    const int c = lane & 7;
#pragma unroll
    for (int j = 0; j < 4; ++j) { const int n = (lane >> 3) + 8 * j; const float* s = scr + (8 * c) * 33 + n;
        u32x4 o; o.x = cvtpk(s[0 * 33], s[1 * 33]); o.y = cvtpk(s[2 * 33], s[3 * 33]); o.z = cvtpk(s[4 * 33], s[5 * 33]); o.w = cvtpk(s[6 * 33], s[7 * 33]);
        *(u32x4*)(WT + (size_t)(rbase + n) * K + k0 + 8 * c) = o; }
    asm volatile("s_waitcnt lgkmcnt(0)" ::: "memory");
}
__device__ __forceinline__ void gemv32_item(unsigned char* lds, const float* in, int ld_in, bool act, const float* W, int ldw, int N, int NP, int n0, const float* bias, float* out, int ldo, int tid) {
    float* INT = (float*)lds;
    __syncthreads();
    for (int idx = tid; idx < 32768; idx += 512) { const int b = idx >> 10, k = idx & 1023; float v = in[(size_t)b * ld_in + k]; if (act) v = siluf(v); INT[k * 32 + b] = v; }
    __syncthreads();
    const int n = n0 + tid;
    if (n < N) {
        float acc[32];
#pragma unroll
        for (int b = 0; b < 32; ++b) acc[b] = 0.f;
#pragma unroll 4
        for (int k = 0; k < 1024; ++k) { const float w = W[(size_t)k * ldw + n]; const f32x4* iv = (const f32x4*)(INT + k * 32);
#pragma unroll
            for (int q = 0; q < 8; ++q) { const f32x4 v = iv[q]; acc[4 * q + 0] += v[0] * w; acc[4 * q + 1] += v[1] * w; acc[4 * q + 2] += v[2] * w; acc[4 * q + 3] += v[3] * w; } }
        const float bb = bias ? bias[n] : 0.f;
#pragma unroll
        for (int b = 0; b < 32; ++b) out[(size_t)b * ldo + n] = acc[b] + bb;
    } else if (n < NP) {
#pragma unroll
        for (int b = 0; b < 32; ++b) out[(size_t)b * ldo + n] = 0.f;
    }
    __syncthreads();
}
__device__ __forceinline__ void row_prep(const float* xrow, const float* sc, bf16* xs, float* rstd_out, int lane) {
    const f32x4* xr = (const f32x4*)xrow + lane; const f32x4* sr = (const f32x4*)sc + lane;
    f32x4 v[4]; float s = 0.f;
#pragma unroll
    for (int j = 0; j < 4; ++j) { v[j] = xr[64 * j]; s += (v[j][0] * v[j][0] + v[j][1] * v[j][1]) + (v[j][2] * v[j][2] + v[j][3] * v[j][3]); }
    s = wave_sum(s);
    if (lane == 0) *rstd_out = 1.0f / sqrtf(s * (1.f / 1024.f) + EPS);
    u32x2* o = (u32x2*)xs + lane;
#pragma unroll
    for (int j = 0; j < 4; ++j) { const f32x4 w = v[j] * (sr[64 * j] + 1.0f); u32x2 q; q.x = cvtpk(w[0], w[1]); q.y = cvtpk(w[2], w[3]); o[64 * j] = q; }
}

constexpr int GL_R = 0;
constexpr int GL_QT = 8192;
constexpr int GL_BL = 10240;
constexpr int GL_BC = 10752;
constexpr int GL_VT = 43520;
constexpr int GL_KDT = 61952;
constexpr int GL_QE = 61952;
constexpr int GL_KE = 80384;
constexpr int GL_OL = 98816;
constexpr int PL_UT = 0;
constexpr int PL_PL = 21760;
static_assert(GL_OL + 64 * 132 * 4 <= LDS_BYTES, "mixer LDS map");

__device__ __forceinline__ float logsig(float x) { return fminf(x, 0.f) - __logf(1.0f + __expf(-fabsf(x))); }

__device__ __forceinline__ void gla_gates(unsigned char* lds, const bf16* Z, size_t row0, const float* wup  , const float* bgk  , int h, int tid) {
    float* R = LDSF(GL_R); float* QT = LDSF(GL_QT); float* BL = LDSF(GL_BL); float* BC = LDSF(GL_BC);
    { const int tok = tid >> 3, c4 = tid & 7; const u32x2 rv = *(const u32x2*)(Z + (row0 + tok) * ZP + C_RF + 4 * c4);
      f32x4 f = {bflo(rv.x), bfhi(rv.x), bflo(rv.y), bfhi(rv.y)}; *(f32x4*)(R + ((c4 >> 2) * 64 + tok) * 16 + 4 * (c4 & 3)) = f; }
    const int dir = tid >> 8, d = tid & 63, tq = (tid >> 6) & 3;
    float wv[16];
#pragma unroll
    for (int kk = 0; kk < 16; ++kk) wv[kk] = wup[(dir * 16 + kk) * 256 + h * 64 + d];
    const float bias = bgk[dir * 256 + h * 64 + d];
    __syncthreads();
    float g[16];
#pragma unroll
    for (int j = 0; j < 16; ++j) { const f32x4* rr = (const f32x4*)(R + (dir * 64 + 16 * tq + j) * 16); float x = bias;
#pragma unroll
        for (int q = 0; q < 4; ++q) { const f32x4 r4 = rr[q]; x += r4[0] * wv[4 * q] + r4[1] * wv[4 * q + 1] + r4[2] * wv[4 * q + 2] + r4[3] * wv[4 * q + 3]; }
        g[j] = logsig(x) * 0.0625f; }
    float run = 0.f;
    if (dir == 0) {
#pragma unroll
        for (int j = 0; j < 16; ++j) { run += g[j]; g[j] = run; }
    } else {
#pragma unroll
        for (int j = 15; j >= 0; --j) { run += g[j]; g[j] = run; }
    }
    QT[(dir * 4 + tq) * 64 + d] = run;
    __syncthreads();
    float off = 0.f, tot = 0.f;
#pragma unroll
    for (int q = 0; q < 4; ++q) { const float t = QT[(dir * 4 + q) * 64 + d]; tot += t; if (dir == 0 ? (q < tq) : (q > tq)) off += t; }
#pragma unroll
    for (int j = 0; j < 16; ++j) BC[(dir * 64 + 16 * tq + j) * 64 + d] = g[j] + off;
    if (tq == 0) BL[dir * 64 + d] = tot;
    __syncthreads();
}
__device__ __forceinline__ void gla_stage_vt(unsigned char* lds, const u32x4& v0, const u32x4& v1, int tid) {
    bf16* VT = (bf16*)(lds + GL_VT); const int tok = tid >> 3, vg = tid & 7;
    const unsigned w[8] = {v0.x, v0.y, v0.z, v0.w, v1.x, v1.y, v1.z, v1.w};
#pragma unroll
    for (int j = 0; j < 8; ++j) { VT[(16 * vg + 2 * j) * 72 + tok] = (bf16)(w[j] & 0xffffu); VT[(16 * vg + 2 * j + 1) * 72 + tok] = (bf16)(w[j] >> 16); }
}
__device__ __forceinline__ void gla_stepA_unit(unsigned char* lds, CP p, int l, int unit, int tid, int lane, int wave) {
    const bf16* Z = (const bf16*)(p->ws + WS_Z); bf16* ST = (bf16*)(p->ws + WS_ST); float* DEC = (float*)(p->ws + WS_DEC);
    const int n = unit & 31, h = (unit >> 5) & 3, b = unit >> 7, bh = b * 4 + h;
    const size_t row0 = (size_t)b * SEQ + n * 64;
    const int tok = tid >> 3, dg = tid & 7;
    const u32x4 k8 = *(const u32x4*)(Z + (row0 + tok) * ZP + C_K + h * 64 + 8 * dg);
    const u32x4 va = *(const u32x4*)(Z + (row0 + tok) * ZP + C_V + h * 128 + 16 * dg), vb2 = *(const u32x4*)(Z + (row0 + tok) * ZP + C_V + h * 128 + 16 * dg + 8);
    gla_gates(lds, Z, row0, p->w_gk_up + (size_t)l * 2 * 16 * 256, p->b_gk + (size_t)l * 2 * 256, h, tid);
    const float* BL = LDSF(GL_BL); const float* BC = LDSF(GL_BC); bf16* KDT = (bf16*)(lds + GL_KDT);
    const float kf[8] = {bflo(k8.x), bfhi(k8.x), bflo(k8.y), bfhi(k8.y), bflo(k8.z), bfhi(k8.z), bflo(k8.w), bfhi(k8.w)};
#pragma unroll
    for (int dir = 0; dir < 2; ++dir) {
        const f32x4 c0 = *(const f32x4*)(BC + (dir * 64 + tok) * 64 + 8 * dg), c1 = *(const f32x4*)(BC + (dir * 64 + tok) * 64 + 8 * dg + 4);
        const f32x4 l0 = *(const f32x4*)(BL + dir * 64 + 8 * dg), l1 = *(const f32x4*)(BL + dir * 64 + 8 * dg + 4);
#pragma unroll
        for (int j = 0; j < 8; ++j) { const float bc = j < 4 ? c0[j & 3] : c1[j & 3], bl = j < 4 ? l0[j & 3] : l1[j & 3];
            KDT[(dir * 64 + 8 * dg + j) * 72 + tok] = f2bf(kf[j] * __expf(bl - bc)); }
    }
    gla_stage_vt(lds, va, vb2, tid);
    if (tid < 128) DEC[((size_t)((tid >> 6) * 128 + bh) * 32 + n) * 64 + (tid & 63)] = __expf(BL[tid]);
    __syncthreads();
    {
        const int dir = wave >> 2, vb = wave & 3, r32 = lane & 31, hi = lane >> 5;
        const bf16* VT = (const bf16*)(lds + GL_VT);
        bf16* dst = ST + ((size_t)((dir * 128 + bh) * 32 + n)) * 8192;
#pragma unroll
        for (int db = 0; db < 2; ++db) {
            f32x16 acc = {};
#pragma unroll
            for (int s = 0; s < 4; ++s) {
                const bf16x8 a = *(const bf16x8*)(VT + (32 * vb + r32) * 72 + 16 * s + 8 * hi);
                const bf16x8 bb = *(const bf16x8*)(KDT + (dir * 64 + 32 * db + r32) * 72 + 16 * s + 8 * hi);
                acc = __builtin_amdgcn_mfma_f32_32x32x16_bf16(a, bb, acc, 0, 0, 0);
            }
#pragma unroll
            for (int r = 0; r < 16; ++r) { const int v = 32 * vb + (r & 3) + 8 * (r >> 2) + 4 * hi; dst[v * 64 + 32 * db + r32] = f2bf(acc[r]); }
        }
    }
    __syncthreads();
}
__device__ __forceinline__ void mixer_store(unsigned char* lds, bf16* dstbase  , bool gla, const bf16* gbase  , const float* ng, int tid) {
    const float* OL = LDSF(GL_OL); const int tok = tid >> 3, vg = tid & 7;
    float o[16];
#pragma unroll
    for (int q = 0; q < 4; ++q) { const f32x4 t = *(const f32x4*)(OL + tok * 132 + 16 * vg + 4 * q); o[4 * q] = t[0]; o[4 * q + 1] = t[1]; o[4 * q + 2] = t[2]; o[4 * q + 3] = t[3]; }
    if (gla) {
        float ss = 0.f;
#pragma unroll
        for (int j = 0; j < 16; ++j) ss += o[j] * o[j];
        ss += __shfl_xor(ss, 1); ss += __shfl_xor(ss, 2); ss += __shfl_xor(ss, 4);
        const float rstd = 1.0f / sqrtf(ss * (1.f / 128.f) + EPS);
        const u32x4 g0 = *(const u32x4*)(gbase + (size_t)tok * ZP + 16 * vg), g1 = *(const u32x4*)(gbase + (size_t)tok * ZP + 16 * vg + 8);
        const unsigned gw[8] = {g0.x, g0.y, g0.z, g0.w, g1.x, g1.y, g1.z, g1.w};
#pragma unroll
        for (int j = 0; j < 8; ++j) { const float ga = bflo(gw[j]), gb = bfhi(gw[j]);
            o[2 * j] = o[2 * j] * rstd * ng[16 * vg + 2 * j] * siluf(ga); o[2 * j + 1] = o[2 * j + 1] * rstd * ng[16 * vg + 2 * j + 1] * siluf(gb); }
    }
    u32x4 w0, w1;
    w0.x = cvtpk(o[0], o[1]); w0.y = cvtpk(o[2], o[3]); w0.z = cvtpk(o[4], o[5]); w0.w = cvtpk(o[6], o[7]);
    w1.x = cvtpk(o[8], o[9]); w1.y = cvtpk(o[10], o[11]); w1.z = cvtpk(o[12], o[13]); w1.w = cvtpk(o[14], o[15]);
    bf16* dp = dstbase + (size_t)tok * 1024 + 16 * vg;
    *(u32x4*)dp = w0; *(u32x4*)(dp + 8) = w1;
}
__device__ __forceinline__ void gla_stepC_unit(unsigned char* lds, CP p, int l, int unit, int tid, int lane, int wave) {
    const bf16* Z = (const bf16*)(p->ws + WS_Z); const bf16* ST = (const bf16*)(p->ws + WS_ST); bf16* AB = (bf16*)(p->ws + WS_ABUF);
    const int n = unit & 31, h = (unit >> 5) & 3, b = unit >> 7, bh = b * 4 + h;
    const size_t row0 = (size_t)b * SEQ + n * 64;
    const int tok = tid >> 3, dg = tid & 7;
    const u32x4 q8 = *(const u32x4*)(Z + (row0 + tok) * ZP + C_Q + h * 64 + 8 * dg);
    const u32x4 k8 = *(const u32x4*)(Z + (row0 + tok) * ZP + C_K + h * 64 + 8 * dg);
    const u32x4 va = *(const u32x4*)(Z + (row0 + tok) * ZP + C_V + h * 128 + 16 * dg), vb2 = *(const u32x4*)(Z + (row0 + tok) * ZP + C_V + h * 128 + 16 * dg + 8);
    gla_gates(lds, Z, row0, p->w_gk_up + (size_t)l * 2 * 16 * 256, p->b_gk + (size_t)l * 2 * 256, h, tid);
    const float* BC = LDSF(GL_BC); bf16* QE = (bf16*)(lds + GL_QE); bf16* KE = (bf16*)(lds + GL_KE);
    const float qf[8] = {bflo(q8.x), bfhi(q8.x), bflo(q8.y), bfhi(q8.y), bflo(q8.z), bfhi(q8.z), bflo(q8.w), bfhi(q8.w)};
    const float kf[8] = {bflo(k8.x), bfhi(k8.x), bflo(k8.y), bfhi(k8.y), bflo(k8.z), bfhi(k8.z), bflo(k8.w), bfhi(k8.w)};
#pragma unroll
    for (int dir = 0; dir < 2; ++dir) {
        const f32x4 c0 = *(const f32x4*)(BC + (dir * 64 + tok) * 64 + 8 * dg), c1 = *(const f32x4*)(BC + (dir * 64 + tok) * 64 + 8 * dg + 4);
        float qe[8], ke[8];
#pragma unroll
        for (int j = 0; j < 8; ++j) { const float bc = j < 4 ? c0[j & 3] : c1[j & 3]; const float e = __expf(bc); qe[j] = qf[j] * e * 0.125f; ke[j] = kf[j] * __expf(-bc); }
        u32x4 wq, wk;
        wq.x = cvtpk(qe[0], qe[1]); wq.y = cvtpk(qe[2], qe[3]); wq.z = cvtpk(qe[4], qe[5]); wq.w = cvtpk(qe[6], qe[7]);
        wk.x = cvtpk(ke[0], ke[1]); wk.y = cvtpk(ke[2], ke[3]); wk.z = cvtpk(ke[4], ke[5]); wk.w = cvtpk(ke[6], ke[7]);
        *(u32x4*)(QE + (dir * 64 + tok) * 72 + 8 * dg) = wq; *(u32x4*)(KE + (dir * 64 + tok) * 72 + 8 * dg) = wk;
    }
    gla_stage_vt(lds, va, vb2, tid);
    __syncthreads();
    {
        const int ib = wave >> 2, vb = wave & 3, r32 = lane & 31, hi = lane >> 5;
        const bf16* VT = (const bf16*)(lds + GL_VT);
        f32x16 o = {};
#pragma unroll
        for (int dir = 0; dir < 2; ++dir) {
            bf16x8 qfr[4];
#pragma unroll
            for (int s = 0; s < 4; ++s) qfr[s] = *(const bf16x8*)(QE + (dir * 64 + 32 * ib + r32) * 72 + 16 * s + 8 * hi);
            const bf16* Sg = ST + ((size_t)((dir * 128 + bh) * 32 + n)) * 8192 + (size_t)(32 * vb + r32) * 64 + 8 * hi;
#pragma unroll
            for (int s = 0; s < 4; ++s) { const bf16x8 sf = *(const bf16x8*)(Sg + 16 * s); o = __builtin_amdgcn_mfma_f32_32x32x16_bf16(qfr[s], sf, o, 0, 0, 0); }
#pragma unroll
            for (int jb = 0; jb < 2; ++jb) {
                f32x16 x = {};
#pragma unroll
                for (int s = 0; s < 4; ++s) { const bf16x8 a = *(const bf16x8*)(KE + (dir * 64 + 32 * jb + r32) * 72 + 16 * s + 8 * hi); x = __builtin_amdgcn_mfma_f32_32x32x16_bf16(a, qfr[s], x, 0, 0, 0); }
                const int i = 32 * ib + r32;
#pragma unroll
                for (int r = 0; r < 16; ++r) { const int j = 32 * jb + (r & 3) + 8 * (r >> 2) + 4 * hi; const bool keep = dir == 0 ? (j <= i) : (j > i); if (!keep) x[r] = 0.f; }
#pragma unroll
                for (int s2 = 0; s2 < 2; ++s2) {
                    u32x4 pa; pa.x = cvtpk(x[8 * s2], x[8 * s2 + 1]); pa.y = cvtpk(x[8 * s2 + 2], x[8 * s2 + 3]); pa.z = cvtpk(x[8 * s2 + 4], x[8 * s2 + 5]); pa.w = cvtpk(x[8 * s2 + 6], x[8 * s2 + 7]);
                    const bf16* vp = VT + (32 * vb + r32) * 72 + 32 * jb + 16 * s2 + 4 * hi;
                    const u32x2 b0 = *(const u32x2*)vp, b1 = *(const u32x2*)(vp + 8);
                    u32x4 pb; pb.x = b0.x; pb.y = b0.y; pb.z = b1.x; pb.w = b1.y;
                    o = __builtin_amdgcn_mfma_f32_32x32x16_bf16(__builtin_bit_cast(bf16x8, pa), __builtin_bit_cast(bf16x8, pb), o, 0, 0, 0);
                }
            }
        }
        float* OL = LDSF(GL_OL);
#pragma unroll
        for (int r = 0; r < 16; ++r) OL[(32 * ib + (r & 3) + 8 * (r >> 2) + 4 * hi) * 132 + 32 * vb + r32] = o[r];
    }
    __syncthreads();
    mixer_store(lds, AB + row0 * 1024 + 512 + h * 128, true, Z + row0 * ZP + C_G + h * 128, p->gla_norm_g + l * 128, tid);
    __syncthreads();
}
__device__ __forceinline__ void pool_unit(unsigned char* lds, CP p, int l, int unit, int tid, int lane, int wave) {
    const bf16* Z = (const bf16*)(p->ws + WS_Z); bf16* AB = (bf16*)(p->ws + WS_ABUF); const bf16* WPT = (const bf16*)(p->ws + WS_WPT);
    const int g = unit & 3, tt = (unit >> 2) & 31, b = unit >> 7, t0 = tt * 64;
    bf16* UT = (bf16*)(lds + PL_UT); bf16* PL = (bf16*)(lds + PL_PL);
    for (int idx = tid; idx < 80 * 16; idx += 512) { const int rr = idx >> 4, ch = idx & 15, t = t0 - 8 + rr;
        u32x4 v = {0u, 0u, 0u, 0u}; if (t >= 0 && t < SEQ) v = *(const u32x4*)(Z + ((size_t)b * SEQ + t) * ZP + g * 128 + 8 * ch);
        *(u32x4*)(UT + rr * 136 + 8 * ch) = v; }
    __syncthreads();
    { const int c = tid & 127, tq = tid >> 7, w = 2 << g, half = w >> 1;
#define U(rr) __uint_as_float(((unsigned)UT[(rr) * 136 + c]) << 16)
      int t = t0 + 16 * tq; float s = 0.f;
      for (int j = 0; j < w; ++j) s += U(t - half + j - t0 + 8);
      for (int j = 0; j < 16; ++j, ++t) {
          const int lo = max(t - half, 0), hi = min(t - half + w - 1, SEQ - 1);
          const float pooled = s / (float)(hi - lo + 1) - U(t - t0 + 8);
          PL[(16 * tq + j) * 136 + c] = f2bf(pooled);
          s += U(t + 1 - half + w - 1 - t0 + 8) - U(t - half - t0 + 8);
      }
#undef U
    }
    __syncthreads();
    { const int ib = wave >> 2, nb = wave & 3, r32 = lane & 31, hi = lane >> 5;
      const bf16* wp = WPT + ((size_t)(l * 4 + g) * 128 + 32 * nb + r32) * 128 + 8 * hi;
      f32x16 acc = {};
#pragma unroll
      for (int s = 0; s < 8; ++s) { const bf16x8 a = *(const bf16x8*)(PL + (32 * ib + r32) * 136 + 16 * s + 8 * hi); const bf16x8 bb = *(const bf16x8*)(wp + 16 * s);
          acc = __builtin_amdgcn_mfma_f32_32x32x16_bf16(a, bb, acc, 0, 0, 0); }
      const float sc = p->pool_scale[l * 512 + g * 128 + 32 * nb + r32];
      float* OL = LDSF(GL_OL);
#pragma unroll
      for (int r = 0; r < 16; ++r) OL[(32 * ib + (r & 3) + 8 * (r >> 2) + 4 * hi) * 132 + 32 * nb + r32] = acc[r] * sc; }
    __syncthreads();
    mixer_store(lds, AB + ((size_t)b * SEQ + t0) * 1024 + g * 128, false, nullptr, nullptr, tid);
    __syncthreads();
}

__device__ __forceinline__ void gla_scan(CP p, int gtid, int gthreads) {
    bf16* ST = (bf16*)(p->ws + WS_ST); const float* DEC = (const float*)(p->ws + WS_DEC);
    for (int ch = gtid; ch < 2 * 128 * 1024; ch += gthreads) {
        const int eg = ch & 1023, dbh = ch >> 10, dir = dbh >> 7;
        bf16* base = ST + (size_t)dbh * 32 * 8192 + 8 * eg; const float* dbase = DEC + (size_t)dbh * 32 * 64 + ((8 * eg) & 63);
        float s[8];
#pragma unroll
        for (int j = 0; j < 8; ++j) s[j] = 0.f;
#pragma unroll 4
        for (int it = 0; it < 32; ++it) {
            const int n = dir == 0 ? it : 31 - it;
            const u32x4 u = *(const u32x4*)(base + (size_t)n * 8192);
            const f32x4 d0 = *(const f32x4*)(dbase + n * 64), d1 = *(const f32x4*)(dbase + n * 64 + 4);
            u32x4 o; o.x = cvtpk(s[0], s[1]); o.y = cvtpk(s[2], s[3]); o.z = cvtpk(s[4], s[5]); o.w = cvtpk(s[6], s[7]);
            *(u32x4*)(base + (size_t)n * 8192) = o;
            s[0] = d0[0] * s[0] + bflo(u.x); s[1] = d0[1] * s[1] + bfhi(u.x); s[2] = d0[2] * s[2] + bflo(u.y); s[3] = d0[3] * s[3] + bfhi(u.y);
            s[4] = d1[0] * s[4] + bflo(u.z); s[5] = d1[1] * s[5] + bfhi(u.z); s[6] = d1[2] * s[6] + bflo(u.w); s[7] = d1[3] * s[7] + bfhi(u.w);
        }
    }
}

constexpr int RT_XS = 0;
constexpr int RT_H = 69632;
__device__ __forceinline__ void router_tile(unsigned char* lds, CP p, int l, int tile, int tid, int lane, int wave) {
    const float* X1 = p->out; const float* ROWSQ = (const float*)(p->ws + WS_ROWSQ); bf16* AB = (bf16*)(p->ws + WS_ABUF);
    int* CNT = (int*)(p->ws + WS_CTL) + 64 + l * 64; int* TOK = (int*)(p->ws + WS_TOK); float* GWL = (float*)(p->ws + WS_GWL);
    float* XS = LDSF(RT_XS + wave * 8704); int* H = (int*)(lds + RT_H); int* HB = H + 32;
    if (tid < 32) H[tid] = 0;
    const int tb = tile * 256 + wave * 32, b = tb >> 11;
    const float* sc2 = (const float*)(p->ws + WS_MOD) + ((size_t)(l * 32 + b) * 6144) + 4 * 1024; const float* sh2 = sc2 - 1024;
    const int rsub = lane >> 4, c4 = lane & 15, r32 = lane & 31, hi = lane >> 5;
    float rs[8];
#pragma unroll
    for (int it = 0; it < 8; ++it) { const f32x4* q = (const f32x4*)(ROWSQ + (size_t)(tb + 4 * it + rsub) * 16); const f32x4 a = q[0], bq = q[1], c = q[2], d = q[3];
        const float s = ((a[0] + a[1]) + (a[2] + a[3])) + ((bq[0] + bq[1]) + (bq[2] + bq[3])) + ((c[0] + c[1]) + (c[2] + c[3])) + ((d[0] + d[1]) + (d[2] + d[3]));
        rs[it] = 1.0f / sqrtf(s * (1.f / 1024.f) + EPS); }
    f32x16 acc = {};
    for (int k0 = 0; k0 < 1024; k0 += 64) {
        const f32x4 scv = *(const f32x4*)(sc2 + k0 + 4 * c4) + 1.0f, shv = *(const f32x4*)(sh2 + k0 + 4 * c4);
#pragma unroll
        for (int it = 0; it < 8; ++it) { const int row = 4 * it + rsub; const f32x4 xv = *(const f32x4*)(X1 + (size_t)(tb + row) * 1024 + k0 + 4 * c4);
            const f32x4 hv = xv * rs[it] * scv + shv; *(f32x4*)(XS + row * 68 + 4 * c4) = hv;
            u32x2 w; w.x = cvtpk(hv[0], hv[1]); w.y = cvtpk(hv[2], hv[3]); *(u32x2*)(AB + (size_t)(tb + row) * 1024 + k0 + 4 * c4) = w; }
        asm volatile("s_waitcnt lgkmcnt(0)" ::: "memory");
#pragma unroll
        for (int q = 0; q < 8; ++q) { const f32x4 av = *(const f32x4*)(XS + r32 * 68 + 8 * q + 4 * hi);
#pragma unroll
            for (int j = 0; j < 4; ++j) { const float bw = p->w_router[(size_t)(k0 + 8 * q + 4 * hi + j) * 32 + r32]; acc = __builtin_amdgcn_mfma_f32_32x32x2f32(av[j], bw, acc, 0, 0, 0); } }
        asm volatile("s_waitcnt lgkmcnt(0)" ::: "memory");
    }
#pragma unroll
    for (int r = 0; r < 16; ++r) XS[((r & 3) + 8 * (r >> 2) + 4 * hi) * 33 + r32] = acc[r];
    asm volatile("s_waitcnt lgkmcnt(0)" ::: "memory");
    int e1 = 0, e2 = 0, rk1 = 0, rk2 = 0; float gw1 = 0.f, gw2 = 0.f;
    if (lane < 32) {
        float s[32], sel[32];
#pragma unroll
        for (int e = 0; e < 32; ++e) { const float lg = XS[lane * 33 + e]; s[e] = 1.0f / (1.0f + __expf(-lg)); sel[e] = s[e] + p->b_router[e]; }
        float best = 0.f; int gi = 0;
#pragma unroll
        for (int g = 0; g < 4; ++g) { float m1 = -INFINITY, m2 = -INFINITY;
#pragma unroll
            for (int j = 0; j < 8; ++j) { const float v = sel[8 * g + j]; if (v > m1) { m2 = m1; m1 = v; } else if (v > m2) m2 = v; }
            const float gs = m1 + m2; if (g == 0 || gs > best) { best = gs; gi = g; } }
        float ig[8], sg[8];
#pragma unroll
        for (int j = 0; j < 8; ++j) { ig[j] = gi == 0 ? sel[j] : gi == 1 ? sel[8 + j] : gi == 2 ? sel[16 + j] : sel[24 + j]; sg[j] = gi == 0 ? s[j] : gi == 1 ? s[8 + j] : gi == 2 ? s[16 + j] : s[24 + j]; }
        int l1 = 0; float v1 = ig[0], w1 = sg[0];
#pragma unroll
        for (int j = 1; j < 8; ++j) if (ig[j] > v1) { v1 = ig[j]; l1 = j; w1 = sg[j]; }
        int l2 = l1 ^ 1; float v2 = -INFINITY, w2 = 0.f;
#pragma unroll
        for (int j = 0; j < 8; ++j) if (j != l1 && (ig[j] > v2 || (j == (l1 ^ 1) && v2 == -INFINITY))) { v2 = ig[j]; l2 = j; w2 = sg[j]; }
        e1 = 8 * gi + l1; e2 = 8 * gi + l2; const float inv = 1.0f / (w1 + w2); gw1 = w1 * inv; gw2 = w2 * inv;
    }
    __syncthreads();
    if (lane < 32) { rk1 = atomicAdd(&H[e1], 1); rk2 = atomicAdd(&H[e2], 1); }
    __syncthreads();
    if (tid < 32) HB[tid] = atomicAdd(&CNT[tid], H[tid]);
    __syncthreads();
    if (lane < 32) { const int t = tb + lane; const int p1 = HB[e1] + rk1, p2 = HB[e2] + rk2;
        TOK[e1 * 65536 + p1] = 2 * t; GWL[e1 * 65536 + p1] = gw1; TOK[e2 * 65536 + p2] = 2 * t + 1; GWL[e2 * 65536 + p2] = gw2; }
    __syncthreads();
}
__device__ __forceinline__ void moe_tables(unsigned char* lds, CP p, int l, int tid) {
    int* tab = (int*)(lds + LDS_SPARE); const int* CNT = (const int*)(p->ws + WS_CTL) + 64 + l * 64;
    __syncthreads();
    if (tid == 0) { int acc = 0; for (int e = 0; e < 32; ++e) { const int c = CNT[e]; tab[2 + e] = acc; tab[34 + e] = c; acc += (c + 255) >> 8; } tab[0] = acc; tab[1] = (acc + 7) & ~7; }
    __syncthreads();
    const int Rt = tab[0];
    for (int rt = tid; rt < Rt; rt += 512) { int e = 0;
#pragma unroll 1
        for (int q = 1; q < 32; ++q) if (tab[2 + q] <= rt) e = q;
        tab[128 + rt] = e; }
    __syncthreads();
}
__device__ __forceinline__ void moe_permute(unsigned char* lds, CP p, int gw, int NGW, int lane) {
    const int* tab = (const int*)(lds + LDS_SPARE); const int* TOK = (const int*)(p->ws + WS_TOK);
    const bf16* AB = (const bf16*)(p->ws + WS_ABUF); bf16* HS = (bf16*)(p->ws + WS_HS);
    const int nslots = tab[0] * 256;
    for (int s = gw; s < nslots; s += NGW) {
        const int rt = s >> 8, e = tab[128 + rt], pos = s - tab[2 + e] * 256;
        if (pos < tab[34 + e]) { const int t = TOK[e * 65536 + pos] >> 1;
            const u32x4* src = (const u32x4*)(AB + (size_t)t * 1024) + lane; u32x4* dst = (u32x4*)(HS + (size_t)s * 1024) + lane;
            const u32x4 a = src[0], bq = src[64]; dst[0] = a; dst[64] = bq; }
    }
}
__device__ __forceinline__ void combine_row(CP p, int l, int t, int lane) {
    const float* mod = (const float*)(p->ws + WS_MOD) + (size_t)(l * 32 + (t >> 11)) * 6144;
    const bf16* Y2 = (const bf16*)(p->ws + WS_Y2) + (size_t)t * 2048;
    f32x4* xr = (f32x4*)(p->out + (size_t)t * 1024) + lane; const f32x4* g2 = (const f32x4*)(mod + 5 * 1024) + lane;
    f32x4 v[4]; float s = 0.f;
#pragma unroll
    for (int j = 0; j < 4; ++j) { const u32x2 y0 = ((const u32x2*)Y2)[lane + 64 * j], y1 = ((const u32x2*)(Y2 + 1024))[lane + 64 * j];
        f32x4 ys = {bflo(y0.x) + bflo(y1.x), bfhi(y0.x) + bfhi(y1.x), bflo(y0.y) + bflo(y1.y), bfhi(y0.y) + bfhi(y1.y)};
        if (!((MK_MASK >> 10) & 1)) ys = (f32x4){0.f, 0.f, 0.f, 0.f};
        v[j] = xr[64 * j] + g2[64 * j] * ys; s += (v[j][0] * v[j][0] + v[j][1] * v[j][1]) + (v[j][2] * v[j][2] + v[j][3] * v[j][3]); }
    s = wave_sum(s);
    const float rstd = 1.0f / sqrtf(s * (1.f / 1024.f) + EPS);
    if (l + 1 < DEPTH) {
        const f32x4* sc = (const f32x4*)((const float*)(p->ws + WS_MOD) + (size_t)((l + 1) * 32 + (t >> 11)) * 6144 + 1024) + lane;
        u32x2* o = (u32x2*)((bf16*)(p->ws + WS_ABUF) + (size_t)t * 1024) + lane;
#pragma unroll
        for (int j = 0; j < 4; ++j) { xr[64 * j] = v[j]; const f32x4 w = v[j] * (sc[64 * j] + 1.0f); u32x2 q; q.x = cvtpk(w[0], w[1]); q.y = cvtpk(w[2], w[3]); o[64 * j] = q; }
        if (lane == 0) ((float*)(p->ws + WS_RSTD))[t] = rstd;
    } else {
        const f32x4* fg = (const f32x4*)p->final_g + lane;
#pragma unroll
        for (int j = 0; j < 4; ++j) xr[64 * j] = v[j] * rstd * fg[64 * j];
    }
}

constexpr int NPHASE = 2 + 10 * DEPTH;
__global__ void __launch_bounds__(512, 2) fwd_kernel(Params p0) {
    extern __shared__ __attribute__((aligned(16))) unsigned char lds[];
    cg::grid_group grid = cg::this_grid();
#pragma unroll 1
    for (int ph = p0.ph_lo; ph < p0.ph_hi; ++ph) {
        CP p = (CP)__builtin_amdgcn_kernarg_segment_ptr(); asm volatile("" : "+s"(p));
        int tid = threadIdx.x; asm volatile("" : "+v"(tid));
        const int lane = tid & 63, wave = __builtin_amdgcn_readfirstlane(tid >> 6);
        const int G = gridDim.x, bx = blockIdx.x, vcu = (G % 8 == 0) ? (bx % 8) * (G / 8) + bx / 8 : bx;
        const int gw = vcu * 8 + wave, NGW = G * 8;
        unsigned char* ws = p->ws;
        float* MOD = (float*)(ws + WS_MOD);
        const int l = ph < 2 ? 0 : (ph - 2) / 10, cls = ph < 2 ? ph : 2 + (ph - 2) % 10;
        switch (cls) {
        case 0: if ((MK_MASK >> 0) & 1) {
            if (vcu < 24) { const int l2 = vcu / 12, n0 = (vcu % 12) * 512;
                gemv32_item(lds, p->c, 1024, true, p->w_mod + (size_t)l2 * 1024 * 6144, 6144, 6144, 6144, n0, p->b_mod + l2 * 6144, MOD + (size_t)l2 * 32 * 6144, 6144, tid); }
            { u32x4* z = (u32x4*)(ws + WS_WIN); const u32x4 zero = {0u, 0u, 0u, 0u};
              for (int i = bx * 512 + tid; i < 2 * 224 * 128; i += G * 512) { const int l2 = i / (224 * 128), r = i % (224 * 128); z[(size_t)l2 * 2304 * 128 + 2080 * 128 + r] = zero; } }
            float* scr = (float*)(lds + wave * 16384);
            constexpr int I_IN = 16 * 65, I_OUT = 16 * 32, I_PL = 8, I_W1 = 16 * 16, I_W2 = 8 * 32;
            constexpr int N_IN = 2 * I_IN, N_OUT = 2 * I_OUT, N_PL = 8 * I_PL, N_W1 = 64 * I_W1, N_W2 = 64 * I_W2;
            for (int it = gw; it < N_IN + N_OUT + N_PL + 2 * N_W1 + N_W2; it += NGW) {
                int r = it;
                if (r < N_IN) { const int l2 = r / I_IN; p0_transpose_item(p->w_in + (size_t)l2 * 1024 * DIN, 1024, DIN, (bf16*)(ws + WS_WIN) + (size_t)l2 * ZP * 1024, 0, scr, r % I_IN, lane); continue; } r -= N_IN;
                if (r < N_OUT) { const int l2 = r / I_OUT; p0_transpose_item(p->w_out + (size_t)l2 * 1024 * 1024, 1024, 1024, (bf16*)(ws + WS_WOUT) + (size_t)l2 * 1024 * 1024, 0, scr, r % I_OUT, lane); continue; } r -= N_OUT;
                if (r < N_PL) { const int lg = r / I_PL; p0_transpose_item(p->w_pool + (size_t)lg * 128 * 128, 128, 128, (bf16*)(ws + WS_WPT) + (size_t)lg * 128 * 128, 0, scr, r % I_PL, lane); continue; } r -= N_PL;
                if (r < N_W1) { const int le = r / I_W1; p0_transpose_item(p->w1 + (size_t)le * 1024 * 512, 1024, 512, (bf16*)(ws + WS_W13) + (size_t)le * 1024 * 1024, 1, scr, r % I_W1, lane); continue; } r -= N_W1;
                if (r < N_W1) { const int le = r / I_W1; p0_transpose_item(p->w3 + (size_t)le * 1024 * 512, 1024, 512, (bf16*)(ws + WS_W13) + (size_t)le * 1024 * 1024, 2, scr, r % I_W1, lane); continue; } r -= N_W1;
                { const int le = r / I_W2; p0_transpose_item(p->w2 + (size_t)le * 512 * 1024, 512, 1024, (bf16*)(ws + WS_W2) + (size_t)le * 1024 * 512, 0, scr, r % I_W2, lane); }
            }
        } break;
        case 1: if ((MK_MASK >> 1) & 1) {
            if (vcu < 10) { const int l2 = vcu / 5, n0 = (vcu % 5) * 512;
                gemv32_item(lds, MOD + (size_t)l2 * 32 * 6144, 6144, false, p->w_in + (size_t)l2 * 1024 * DIN, DIN, DIN, ZP, n0, nullptr, (float*)(ws + WS_BIASIN) + (size_t)l2 * 32 * ZP, ZP, tid); }
            for (int t = gw; t < T; t += NGW) row_prep(p->x + (size_t)t * 1024, MOD + (size_t)(t >> 11) * 6144 + 1024, (bf16*)(ws + WS_ABUF) + (size_t)t * 1024, (float*)(ws + WS_RSTD) + t, lane);
        } break;
        case 2: if ((MK_MASK >> 2) & 1) {
            pg8::Gemm g{(const bf16*)(ws + WS_ABUF), (const bf16*)(ws + WS_WIN) + (size_t)l * ZP * 1024, T, ZP, 1024}; pg8::StaticOrder S; S.init(T, ZP, G, bx);
            pg8::EpiZ E{(bf16*)(ws + WS_Z), (const float*)(ws + WS_RSTD), (const float*)(ws + WS_BIASIN) + (size_t)l * 32 * ZP, ZP};
            pg8::gemm_phase<pg8::EpiZ, pg8::StaticOrder, true, true>((PG8_LAS unsigned char*)lds, g, S, E);
        } break;
        case 3: if ((MK_MASK >> 3) & 1) {
            for (int u = vcu; u < 8192; u += G) { if (u < 4096) gla_stepA_unit(lds, p, l, u, tid, lane, wave); else pool_unit(lds, p, l, u - 4096, tid, lane, wave); }
        } break;
        case 4: if ((MK_MASK >> 4) & 1) gla_scan(p, vcu * 512 + tid, G * 512); break;
        case 5: if ((MK_MASK >> 5) & 1) { for (int u = vcu; u < 4096; u += G) gla_stepC_unit(lds, p, l, u, tid, lane, wave); } break;
        case 6: if ((MK_MASK >> 6) & 1) {
            pg8::Gemm g{(const bf16*)(ws + WS_ABUF), (const bf16*)(ws + WS_WOUT) + (size_t)l * 1024 * 1024, T, 1024, 1024}; pg8::StaticOrder S; S.init(T, 1024, G, bx);
            pg8::EpiRes E{l == 0 ? p->x : p->out, p->out, MOD + (size_t)l * 32 * 6144 + 2 * 1024, (float*)(ws + WS_ROWSQ)};
            pg8::gemm_phase<pg8::EpiRes, pg8::StaticOrder, true, true>((PG8_LAS unsigned char*)lds, g, S, E);
        } break;
        case 7: if ((MK_MASK >> 7) & 1) { for (int tile = vcu; tile < T / 256; tile += G) router_tile(lds, p, l, tile, tid, lane, wave); } break;
        case 8: if ((MK_MASK >> 8) & 1) { moe_tables(lds, p, l, tid); moe_permute(lds, p, gw, NGW, lane); } break;
        case 9: if ((MK_MASK >> 9) & 1) {
            moe_tables(lds, p, l, tid);
            pg8::Gemm g{(const bf16*)(ws + WS_HS), (const bf16*)(ws + WS_W13) + (size_t)l * 32 * 1024 * 1024, HS_ROWS, 32 * 1024, 1024};
            pg8::MoeOrder S{(const PG8_LAS int*)(lds + LDS_SPARE), G, bx}; pg8::EpiAct E{(bf16*)(ws + WS_ACT)};
            pg8::gemm_phase<pg8::EpiAct, pg8::MoeOrder, true, true>((PG8_LAS unsigned char*)lds, g, S, E);
        } break;
        case 10: if ((MK_MASK >> 10) & 1) {
            moe_tables(lds, p, l, tid);
            pg8::Gemm g{(const bf16*)(ws + WS_ACT), (const bf16*)(ws + WS_W2) + (size_t)l * 32 * 1024 * 512, HS_ROWS, 32 * 1024, 512};
            pg8::MoeOrder S{(const PG8_LAS int*)(lds + LDS_SPARE), G, bx};
            pg8::EpiY E{(bf16*)(ws + WS_Y2), (const int*)(ws + WS_TOK), (const float*)(ws + WS_GWL), (const int*)(ws + WS_CTL) + 64 + l * 64};
            pg8::gemm_phase<pg8::EpiY, pg8::MoeOrder, true, true>((PG8_LAS unsigned char*)lds, g, S, E);
        } break;
        default: if ((MK_MASK >> 11) & 1) { for (int t = gw; t < T; t += NGW) combine_row(p, l, t, lane); } break;
        }
        if (ph + 1 < p0.ph_hi) grid.sync();
    }
}

extern "C" void kernel_launch(void* const* d_in, const int* in_sizes, int n_in, void* d_out, int out_size, void* d_ws, size_t ws_size, hipStream_t stream) {
    static int grid = 0;
    if (grid == 0) {
        if (n_in != 17 || out_size != T * DM || ws_size < WS_END) { fprintf(stderr, "kernel_launch: unexpected shapes: n_in %d out %d ws %zu (need %zu)\n", n_in, out_size, ws_size, (size_t)WS_END); grid = -1; return; }
        int dev = 0, cus = 0, per_cu = 0;
        (void)hipGetDevice(&dev); (void)hipDeviceGetAttribute(&cus, hipDeviceAttributeMultiprocessorCount, dev);
        (void)hipFuncSetAttribute((const void*)fwd_kernel, hipFuncAttributeMaxDynamicSharedMemorySize, LDS_BYTES);
        (void)hipOccupancyMaxActiveBlocksPerMultiprocessor(&per_cu, (const void*)fwd_kernel, 512, LDS_BYTES);
        if (per_cu < 1) { fprintf(stderr, "kernel_launch: occupancy query says %d blocks per CU\n", per_cu); grid = -1; return; }
        grid = cus;
    }
    if (grid < 0) return;
    (void)hipMemsetAsync((char*)d_ws + WS_CTL, 0, 1 * MiB, stream);
    Params p{};
    const float** pp = (const float**)&p;
    for (int i = 0; i < 17; ++i) pp[i] = (const float*)d_in[i];
    p.out = (float*)d_out; p.ws = (unsigned char*)d_ws;
#if MK_MULTI
    for (int k = 0; k < NPHASE; ++k) { p.ph_lo = k; p.ph_hi = k + 1; void* args[] = {&p};
        hipError_t e = hipLaunchCooperativeKernel((const void*)fwd_kernel, dim3(grid), dim3(512), args, LDS_BYTES, stream);
        if (e != hipSuccess) { fprintf(stderr, "launch of phase %d failed: %s\n", k, hipGetErrorString(e)); break; } }
#else
    p.ph_lo = 0; p.ph_hi = NPHASE; void* args[] = {&p};
    hipError_t e = hipLaunchCooperativeKernel((const void*)fwd_kernel, dim3(grid), dim3(512), args, LDS_BYTES, stream);
    if (e != hipSuccess) fprintf(stderr, "cooperative launch failed: %s (grid %d)\n", hipGetErrorString(e), grid);
#endif
}
```

```cpp
#include <hip/hip_runtime.h>
#include <hip/hip_cooperative_groups.h>
#include <cstdio>
#include <cstdint>
namespace cg = cooperative_groups;

#ifndef MK_MASK
#define MK_MASK 0xFFF
#endif
#ifndef MK_MULTI
#define MK_MULTI 0
#endif

constexpr int DM = 1024, NB = 32, SEQ = 2048, T = NB * SEQ, DEPTH = 2;
constexpr int DIN = 2080, ZP = 2304;
constexpr int C_Q = 512, C_K = 768, C_V = 1024, C_G = 1536, C_RF = 2048;
constexpr int NE = 32, DFF = 512;
constexpr int HS_ROWS = 139264;
constexpr float EPS = 1e-6f;

constexpr size_t MiB = 1u << 20;
constexpr size_t WS_CTL = 0;
constexpr size_t WS_MOD = 1 * MiB;
constexpr size_t WS_BIASIN = 3 * MiB;
constexpr size_t WS_RSTD = 4 * MiB;
constexpr size_t WS_ROWSQ = 5 * MiB;
constexpr size_t WS_DEC = 9 * MiB;
constexpr size_t WS_TOK = 11 * MiB;
constexpr size_t WS_GWL = 19 * MiB;
constexpr size_t WS_WPT = 28 * MiB;
constexpr size_t WS_WOUT = 29 * MiB;
constexpr size_t WS_WIN = 33 * MiB;
constexpr size_t WS_W2 = 42 * MiB;
constexpr size_t WS_W13 = 106 * MiB;
constexpr size_t WS_ABUF = 234 * MiB;
constexpr size_t WS_R = 362 * MiB;
constexpr size_t WS_Z = WS_R;
constexpr size_t WS_ST = WS_R + 288 * MiB;
constexpr size_t WS_HS = WS_R;
constexpr size_t WS_Y2 = WS_R;
constexpr size_t WS_ACT = WS_R + 272 * MiB;
constexpr size_t WS_END = WS_R + 416 * MiB;
constexpr int LDS_BYTES = 147456;
constexpr int LDS_SPARE = 131072;

typedef unsigned short bf16;
typedef float f32x4 __attribute__((ext_vector_type(4)));
typedef float f32x16 __attribute__((ext_vector_type(16)));
typedef short bf16x8 __attribute__((ext_vector_type(8)));
typedef unsigned u32x4 __attribute__((ext_vector_type(4)));
typedef unsigned u32x2 __attribute__((ext_vector_type(2)));
typedef float f32x2_t __attribute__((ext_vector_type(2)));
typedef __bf16 bf16x2_t __attribute__((ext_vector_type(2)));

__device__ __forceinline__ unsigned cvtpk(float lo, float hi) { f32x2_t v = {lo, hi}; bf16x2_t b = __builtin_convertvector(v, bf16x2_t); return __builtin_bit_cast(unsigned, b); }
__device__ __forceinline__ unsigned short f2bf(float f) { return (unsigned short)(cvtpk(f, 0.f) & 0xffffu); }
__device__ __forceinline__ float bflo(unsigned u) { return __uint_as_float(u << 16); }
__device__ __forceinline__ float bfhi(unsigned u) { return __uint_as_float(u & 0xffff0000u); }
__device__ __forceinline__ float siluf(float x) { return x / (1.0f + __expf(-x)); }
__device__ __forceinline__ float wave_sum(float v) {
#pragma unroll
    for (int o = 1; o < 64; o <<= 1) v += __shfl_xor(v, o);
    return v;
}

namespace pg8 {
#define PG8_LAS __attribute__((address_space(3)))
typedef unsigned short bf16_t;
typedef short bf16x8 __attribute__((ext_vector_type(8)));
typedef float f32x4 __attribute__((ext_vector_type(4)));
typedef unsigned u32x4 __attribute__((ext_vector_type(4)));
constexpr int BM = 256, BK = 64, HALF = 128, HTB = HALF * BK * 2  , STAGE_BYTES = 8 * HTB, NXCD = 8, WGM = 8;

__host__ __device__ __forceinline__ int lds_byte(int r, int c) { const int st = (r >> 4) * 2 + (c >> 5), rr = r & 15, cc = c & 31, ob = rr * 64 + cc * 2; return st * 1024 + (ob ^ (((ob >> 9) & 1) << 5)); }
__host__ __device__ __forceinline__ void stage_rc(int b, int& R, int& C) { const int st = b / 1024, sb = b % 1024, swz = sb ^ (((sb >> 9) & 1) << 5); R = (st >> 1) * 16 + swz / 64; C = (st & 1) * 32 + (swz % 64) / 2; }
__host__ __device__ __forceinline__ int perm32(int rho) { const int n = rho >> 4, i = rho & 15; return 8 * (i >> 2) + 4 * n + (i & 3); }

struct Unit { int pm, pn, x0, x1; };
struct Gemm { const bf16_t* A; const bf16_t* Bt; int M, N, K; };

struct StaticOrder {
    int nM, nN, nwg, G, c;
    __host__ __device__ void init(int M, int N, int G_, int c_) { nM = M / BM; nN = N / BM; nwg = nM * nN; G = G_; c = c_; }
    __host__ __device__ bool next(int i, Unit& u) const {
        const long L = (long)i * G + c; if (L >= nwg) return false;
        int wgid = (int)L; { const int q = nwg / NXCD, r = nwg % NXCD, xcd = wgid % NXCD, off = wgid / NXCD; wgid = (xcd < r ? xcd * (q + 1) : r * (q + 1) + (xcd - r) * q) + off; }
        const int nig = WGM * nN, gid = wgid / nig, fm = gid * WGM, gsz = (nM - fm) < WGM ? (nM - fm) : WGM;
        u.pm = fm + ((wgid % nig) % gsz); u.pn = (wgid % nig) / gsz; return true;
    }
    __device__ __forceinline__ void a_ready(const Unit&) const {}
    __device__ __forceinline__ void done(const Unit&) const {}
};


__device__ __forceinline__ unsigned pk2(float lo, float hi) { typedef float v2f __attribute__((ext_vector_type(2))); typedef __bf16 v2b __attribute__((ext_vector_type(2))); v2f v = {lo, hi}; v2b b = __builtin_convertvector(v, v2b); return __builtin_bit_cast(unsigned, b); }
struct EpiZ {
    static constexpr bool PERM = true, AFTER_DRAIN = false;
    bf16_t* Z; const float* rstd; const float* bias; int zp;
    __device__ __forceinline__ void operator()(const f32x4 (&acc)[2][2][4][2], const Unit& u, int wr, int wc, int fr, int fq) const {
        const int row0 = u.pm * BM + wr * 64 + fr, col0 = u.pn * BM + wc * 32 + 8 * fq;
        const float* bp = bias + (size_t)((u.pm * BM) >> 11) * zp + col0;
        f32x4 bv[2][2];
#pragma unroll
        for (int bj = 0; bj < 2; ++bj)
#pragma unroll
            for (int n = 0; n < 2; ++n) bv[bj][n] = *(const f32x4*)(bp + bj * HALF + 4 * n);
#pragma unroll
        for (int ai = 0; ai < 2; ++ai)
#pragma unroll
            for (int m = 0; m < 4; ++m) { const int row = row0 + ai * HALF + m * 16; const float rs = rstd[row]; bf16_t* rowp = Z + (size_t)row * zp + col0;
#pragma unroll
                for (int bj = 0; bj < 2; ++bj) { const f32x4 v0 = acc[ai][bj][m][0] * rs + bv[bj][0], v1 = acc[ai][bj][m][1] * rs + bv[bj][1];
                    u32x4 w; w.x = pk2(v0[0], v0[1]); w.y = pk2(v0[2], v0[3]); w.z = pk2(v1[0], v1[1]); w.w = pk2(v1[2], v1[3]);
                    *(u32x4*)(rowp + bj * HALF) = w; } }
    }
};
struct EpiRes {
    static constexpr bool PERM = false, AFTER_DRAIN = false;
    const float* xres; float* out; const float* g1; float* rowsq;
    __device__ __forceinline__ void operator()(const f32x4 (&acc)[2][2][4][2], const Unit& u, int wr, int wc, int fr, int fq) const {
        const int row0 = u.pm * BM + wr * 64 + fr, col0 = u.pn * BM + wc * 32 + 4 * fq;
        const float* gp = g1 + (size_t)((u.pm * BM) >> 11) * 6144 + col0;
        f32x4 gv[2][2];
#pragma unroll
        for (int bj = 0; bj < 2; ++bj)
#pragma unroll
            for (int n = 0; n < 2; ++n) gv[bj][n] = *(const f32x4*)(gp + bj * HALF + n * 16);
#pragma unroll
        for (int ai = 0; ai < 2; ++ai)
#pragma unroll
            for (int m = 0; m < 4; ++m) { const int row = row0 + ai * HALF + m * 16; const size_t off = (size_t)row * 1024 + col0; float s = 0.f;
#pragma unroll
                for (int bj = 0; bj < 2; ++bj)
#pragma unroll
                    for (int n = 0; n < 2; ++n) { const f32x4 xr = *(const f32x4*)(xres + off + bj * HALF + n * 16); const f32x4 o = xr + gv[bj][n] * acc[ai][bj][m][n];
                        *(f32x4*)(out + off + bj * HALF + n * 16) = o; s += (o[0] * o[0] + o[1] * o[1]) + (o[2] * o[2] + o[3] * o[3]); }
                s += __shfl_xor(s, 16); s += __shfl_xor(s, 32);
                if (fq == 0) rowsq[(size_t)row * 16 + u.pn * 4 + wc] = s; }
    }
};
struct EpiAct {
    static constexpr bool PERM = true, AFTER_DRAIN = false;
    bf16_t* ACT;
    __device__ __forceinline__ void operator()(const f32x4 (&acc)[2][2][4][2], const Unit& u, int wr, int wc, int fr, int fq) const {
        if (!(u.x0 >> 8)) return;
        const int ct = u.pn & 3, row0 = u.pm * BM + wr * 64 + fr, col0 = ct * 128 + wc * 32 + 8 * fq;
#pragma unroll
        for (int ai = 0; ai < 2; ++ai)
#pragma unroll
            for (int m = 0; m < 4; ++m) { bf16_t* rowp = ACT + (size_t)(row0 + ai * HALF + m * 16) * 512 + col0;
                float v[8];
#pragma unroll
                for (int n = 0; n < 2; ++n)
#pragma unroll
                    for (int i = 0; i < 4; ++i) { const float a = acc[ai][0][m][n][i], b = acc[ai][1][m][n][i]; v[n * 4 + i] = a / (1.0f + __expf(-a)) * b; }
                u32x4 w; w.x = pk2(v[0], v[1]); w.y = pk2(v[2], v[3]); w.z = pk2(v[4], v[5]); w.w = pk2(v[6], v[7]);
                *(u32x4*)rowp = w; }
    }
};
struct EpiY {
    static constexpr bool PERM = true, AFTER_DRAIN = false;
    bf16_t* Y2; const int* tok; const float* gwl; const int* cnt;
    __device__ __forceinline__ void operator()(const f32x4 (&acc)[2][2][4][2], const Unit& u, int wr, int wc, int fr, int fq) const {
        if (!(u.x0 >> 8)) return;
        const int e = u.x0 & 0xff, ct = u.pn & 3, ne = cnt[e];
#pragma unroll
        for (int ai = 0; ai < 2; ++ai)
#pragma unroll
            for (int m = 0; m < 4; ++m) { const int r = u.x1 + ai * HALF + wr * 64 + m * 16 + fr;
                if (r < ne) { const int tk = tok[e * 65536 + r]; const float gw = gwl[e * 65536 + r];
                    bf16_t* dst = Y2 + (size_t)tk * 1024 + ct * 256 + wc * 32 + 8 * fq;
#pragma unroll
                    for (int bj = 0; bj < 2; ++bj) { const f32x4 v0 = acc[ai][bj][m][0] * gw, v1 = acc[ai][bj][m][1] * gw;
                        u32x4 w; w.x = pk2(v0[0], v0[1]); w.y = pk2(v0[2], v0[3]); w.z = pk2(v1[0], v1[1]); w.w = pk2(v1[2], v1[3]);
                        *(u32x4*)(dst + bj * HALF) = w; } } }
    }
};
struct MoeOrder {
    const PG8_LAS int* tab; int G, c;
    __device__ __forceinline__ bool next(int i, Unit& u) const {
        const int RTP = __builtin_amdgcn_readfirstlane(tab[1]), Rt = __builtin_amdgcn_readfirstlane(tab[0]), nwg = RTP * 4;
        const long L = (long)i * G + c; if (L >= nwg) return false;
        int wgid = (int)L; { const int q = nwg / NXCD, r = nwg % NXCD, xcd = wgid % NXCD, off = wgid / NXCD; wgid = (xcd < r ? xcd * (q + 1) : r * (q + 1) + (xcd - r) * q) + off; }
        const int gid = wgid / 32, w = wgid % 32, rt = 8 * gid + (w & 7), ct = w >> 3, valid = rt < Rt ? 1 : 0, rtc = valid ? rt : 0;
        const int e = __builtin_amdgcn_readfirstlane(tab[128 + rtc]), sb = __builtin_amdgcn_readfirstlane(tab[2 + e]);
        u.pm = rtc; u.pn = e * 4 + ct; u.x0 = e | (valid << 8); u.x1 = (rtc - sb) * 256; return true;
    }
    __device__ __forceinline__ void a_ready(const Unit&) const {}
    __device__ __forceinline__ void done(const Unit&) const {}
};

template <class Epi, class Sched, bool ALIGN_EPI = false, bool SP2 = false>
__device__ __forceinline__ void gemm_phase(PG8_LAS unsigned char* lds, const Gemm g, const Sched& S, const Epi& E) {
    int tid = threadIdx.x; asm volatile("" : "+v"(tid)); const int wid = __builtin_amdgcn_readfirstlane(tid >> 6), lane = tid & 63, wr = wid >> 2, wc = wid & 3, fr = lane & 15, fq = lane >> 4;
    const int K = g.K, nt = K / BK;
    unsigned voffA[2], voffB[2];
#pragma unroll
    for (int i = 0; i < 2; ++i) { int R, C; stage_rc(tid * 16 + i * 8192, R, C); const int Rb = Epi::PERM ? ((R & ~31) + perm32(R & 31)) : R;
        voffA[i] = (unsigned)(R * K + C) * 2u; voffB[i] = (unsigned)(Rb * K + C) * 2u; }
    const size_t kstep = (size_t)(BK * 2);
    const size_t hstep = (size_t)HALF * K * 2;
    const size_t tstep = 2 * hstep;
    const unsigned ldsw = (unsigned)wid * 1024u;
    const int aoff = lds_byte(wr * 64 + fr, fq * 8), boff = lds_byte(wc * 32 + fr, fq * 8);
#define PG8_SA(b, h) (((b) * 2 + (h)) * HTB)
#define PG8_SB(b, h) ((4 + (b) * 2 + (h)) * HTB)
#define PG8_STAGE(bufoff, gbase, voff) do { _Pragma("unroll") for (int _i = 0; _i < 2; ++_i) \
        __builtin_amdgcn_global_load_lds((const unsigned*)((const char*)(gbase) + (voff)[_i]), (PG8_LAS unsigned*)(lds + (bufoff) + ldsw + _i * 8192), 16, 0, 0); } while (0)
#define PG8_LDA(dst, b, h) do { _Pragma("unroll") for (int m = 0; m < 4; ++m) _Pragma("unroll") for (int k = 0; k < 2; ++k) dst[m][k] = *(const PG8_LAS bf16x8*)(lds + PG8_SA(b, h) + aoff + m * 2048 + k * 1024); } while (0)
#define PG8_LDB(dst, b, h) do { _Pragma("unroll") for (int n = 0; n < 2; ++n) _Pragma("unroll") for (int k = 0; k < 2; ++k) dst[n][k] = *(const PG8_LAS bf16x8*)(lds + PG8_SB(b, h) + boff + n * 2048 + k * 1024); } while (0)
#define PG8_MMA(ai, bj, At, Bt) do { __builtin_amdgcn_s_setprio(1); _Pragma("unroll") for (int m = 0; m < 4; ++m) _Pragma("unroll") for (int n = 0; n < 2; ++n) _Pragma("unroll") for (int k = 0; k < 2; ++k) \
        acc[ai][bj][m][n] = __builtin_amdgcn_mfma_f32_16x16x32_bf16(Bt[n][k], At[m][k], acc[ai][bj][m][n], 0, 0, 0); __builtin_amdgcn_s_setprio(0); } while (0)
#define PG8_WAIT_V(n) asm volatile("s_waitcnt vmcnt(" #n ")" ::: "memory")
#define PG8_WAIT_L(n) asm volatile("s_waitcnt lgkmcnt(" #n ")" ::: "memory")
#define PG8_BAR __builtin_amdgcn_s_barrier()
#define PG8_SCHED __builtin_amdgcn_sched_barrier(0)
    Unit cur, nxt; int ui = 0;
    if (!S.next(0, cur)) return;
    f32x4 acc[2][2][4][2];
#pragma unroll
    for (int a = 0; a < 2; ++a)
#pragma unroll
        for (int b = 0; b < 2; ++b)
#pragma unroll
            for (int m = 0; m < 4; ++m)
#pragma unroll
                for (int n = 0; n < 2; ++n) acc[a][b][m][n] = (f32x4){0.f, 0.f, 0.f, 0.f};
    bf16x8 At[4][2], B0[2][2], B1[2][2];
    const char* cA = (const char*)g.A + (size_t)cur.pm * tstep; const char* cB = (const char*)g.Bt + (size_t)cur.pn * tstep;
    S.a_ready(cur);
    if constexpr (SP2) {
        PG8_STAGE(PG8_SB(0, 0), cB, voffB); PG8_STAGE(PG8_SB(0, 1), cB + hstep, voffB); PG8_STAGE(PG8_SA(0, 0), cA, voffA); PG8_STAGE(PG8_SA(0, 1), cA + hstep, voffA);
        if (wr == 1) PG8_BAR;
        PG8_WAIT_V(2); PG8_BAR;
        PG8_STAGE(PG8_SB(1, 0), cB + kstep, voffB); PG8_STAGE(PG8_SA(1, 0), cA + kstep, voffA); PG8_STAGE(PG8_SB(1, 1), cB + hstep + kstep, voffB);
        PG8_WAIT_V(6); PG8_BAR;
    } else {
        PG8_STAGE(PG8_SB(0, 0), cB, voffB); PG8_STAGE(PG8_SA(0, 0), cA, voffA); PG8_STAGE(PG8_SB(0, 1), cB + hstep, voffB); PG8_STAGE(PG8_SA(0, 1), cA + hstep, voffA);
        if (wr == 1) PG8_BAR;
        PG8_WAIT_V(4); PG8_BAR;
        PG8_STAGE(PG8_SB(1, 0), cB + kstep, voffB); PG8_STAGE(PG8_SA(1, 0), cA + kstep, voffA); PG8_STAGE(PG8_SB(1, 1), cB + hstep + kstep, voffB);
        PG8_WAIT_V(6); PG8_BAR;
    }
    for (;;) {
        const bool has_next = S.next(ui + 1, nxt);
        const char* nA = has_next ? (const char*)g.A + (size_t)nxt.pm * tstep : cA; const char* nB = has_next ? (const char*)g.Bt + (size_t)nxt.pn * tstep : cB;
        for (int t = 0; t < nt; t += 2) {
            const bool last = (t == nt - 2);
            const char* a1 = cA + (size_t)(t + 1) * kstep;
            const char* a2 = last ? nA : cA + (size_t)(t + 2) * kstep; const char* b2 = last ? nB : cB + (size_t)(t + 2) * kstep;
            const char* a3 = a2 + kstep; const char* b3 = b2 + kstep;
            if (last && has_next) S.a_ready(nxt);
            if constexpr (SP2) {
            PG8_LDB(B0, 0, 0); PG8_LDB(B1, 0, 1); PG8_SCHED; PG8_LDA(At, 0, 0); PG8_STAGE(PG8_SA(1, 1), a1 + hstep, voffA);
            PG8_WAIT_V(8); PG8_WAIT_L(0); PG8_BAR; PG8_MMA(0, 0, At, B0); PG8_MMA(0, 1, At, B1); PG8_BAR; PG8_SCHED;
            PG8_LDA(At, 0, 1); PG8_STAGE(PG8_SB(0, 0), b2, voffB); PG8_STAGE(PG8_SB(0, 1), b2 + hstep, voffB); PG8_STAGE(PG8_SA(0, 0), a2, voffA);
            PG8_WAIT_V(8); PG8_WAIT_L(0); PG8_BAR; PG8_MMA(1, 0, At, B0); PG8_MMA(1, 1, At, B1); PG8_BAR; PG8_SCHED;
            PG8_LDB(B0, 1, 0); PG8_LDB(B1, 1, 1); PG8_SCHED; PG8_LDA(At, 1, 0); PG8_STAGE(PG8_SA(0, 1), a2 + hstep, voffA);
            PG8_WAIT_V(8); PG8_WAIT_L(0); PG8_BAR; PG8_MMA(0, 0, At, B0); PG8_MMA(0, 1, At, B1); PG8_BAR; PG8_SCHED;
            PG8_LDA(At, 1, 1); PG8_STAGE(PG8_SB(1, 0), b3, voffB); PG8_STAGE(PG8_SB(1, 1), b3 + hstep, voffB); PG8_STAGE(PG8_SA(1, 0), a3, voffA);
            PG8_WAIT_V(8); PG8_WAIT_L(0); PG8_BAR; PG8_MMA(1, 0, At, B0); PG8_MMA(1, 1, At, B1); PG8_BAR; PG8_SCHED;
            } else {
            PG8_LDB(B0, 0, 0); PG8_SCHED; PG8_LDA(At, 0, 0); PG8_STAGE(PG8_SA(1, 1), a1 + hstep, voffA);
            PG8_WAIT_L(8); PG8_BAR; PG8_WAIT_L(0); PG8_MMA(0, 0, At, B0); PG8_BAR; PG8_SCHED;
            PG8_LDB(B1, 0, 1); PG8_STAGE(PG8_SB(0, 0), b2, voffB);
            PG8_BAR; PG8_WAIT_L(0); PG8_MMA(0, 1, At, B1); PG8_BAR;
            PG8_LDA(At, 0, 1); PG8_STAGE(PG8_SA(0, 0), a2, voffA);
            PG8_BAR; PG8_WAIT_L(0); PG8_MMA(1, 0, At, B0); PG8_BAR; PG8_SCHED;
            PG8_STAGE(PG8_SB(0, 1), b2 + hstep, voffB);
            PG8_WAIT_V(6); PG8_BAR; PG8_MMA(1, 1, At, B1); PG8_BAR;
            PG8_LDB(B0, 1, 0); PG8_SCHED; PG8_LDA(At, 1, 0); PG8_STAGE(PG8_SA(0, 1), a2 + hstep, voffA);
            PG8_WAIT_L(8); PG8_BAR; PG8_WAIT_L(0); PG8_MMA(0, 0, At, B0); PG8_BAR; PG8_SCHED;
            PG8_LDB(B1, 1, 1); PG8_STAGE(PG8_SB(1, 0), b3, voffB);
            PG8_BAR; PG8_WAIT_L(0); PG8_MMA(0, 1, At, B1); PG8_BAR;
            PG8_LDA(At, 1, 1); PG8_STAGE(PG8_SA(1, 0), a3, voffA);
            PG8_BAR; PG8_WAIT_L(0); PG8_MMA(1, 0, At, B0); PG8_BAR; PG8_SCHED;
            PG8_STAGE(PG8_SB(1, 1), b3 + hstep, voffB);
            PG8_WAIT_V(6); PG8_BAR; PG8_MMA(1, 1, At, B1); PG8_BAR;
            }
        }
        if constexpr (ALIGN_EPI) { if (wr == 0) PG8_BAR; }
        if constexpr (!Epi::AFTER_DRAIN) { E(acc, cur, wr, wc, fr, fq); S.done(cur); }
        if (!has_next) break;
#pragma unroll
        for (int a = 0; a < 2; ++a)
#pragma unroll
            for (int b = 0; b < 2; ++b)
#pragma unroll
                for (int m = 0; m < 4; ++m)
#pragma unroll
                    for (int n = 0; n < 2; ++n) acc[a][b][m][n] = (f32x4){0.f, 0.f, 0.f, 0.f};
        cur = nxt; cA = nA; cB = nB; ++ui;
        if constexpr (ALIGN_EPI) { if (wr == 1) PG8_BAR; }
    }
    PG8_WAIT_V(0);
    if constexpr (!ALIGN_EPI) { if (wr == 0) PG8_BAR; }
    PG8_BAR;
    if constexpr (Epi::AFTER_DRAIN) { E.fused(acc, cur, wr, wc, fr, fq, lds, wid, lane); S.done(cur); }
#undef PG8_SA
#undef PG8_SB
#undef PG8_STAGE
#undef PG8_LDA
#undef PG8_LDB
#undef PG8_MMA
#undef PG8_WAIT_V
#undef PG8_WAIT_L
#undef PG8_BAR
#undef PG8_SCHED
}
}

struct Params {
    const float *x, *c, *w_mod, *b_mod, *w_in, *w_pool, *pool_scale, *w_gk_up, *b_gk, *gla_norm_g, *w_out, *w_router, *b_router, *w1, *w3, *w2, *final_g;
    float* out; unsigned char* ws; int ph_lo, ph_hi;
};
typedef const __attribute__((address_space(4))) Params* CP;
#define LDSF(off) ((float*)(lds + (off)))

__device__ __forceinline__ void p0_transpose_item(const float* W, int K, int N, bf16* WT, int imode, float* scr, int item, int lane) {
    const int nblk = N / 32, kb = item / nblk, nb = item % nblk, k0 = 64 * kb, n0 = 32 * nb;
    const int rbase = imode == 0 ? n0 : (256 * (n0 >> 7) + (n0 & 127) + (imode == 2 ? 128 : 0));
#pragma unroll 8
    for (int i = 0; i < 32; ++i) { const int kk = 2 * i + (lane >> 5); scr[kk * 33 + (lane & 31)] = W[(size_t)(k0 + kk) * N + n0 + (lane & 31)]; }
    asm volatile("s_waitcnt lgkmcnt(0)" ::: "memory");
    const int c = lane & 7;
#pragma unroll
    for (int j = 0; j < 4; ++j) { const int n = (lane >> 3) + 8 * j; const float* s = scr + (8 * c) * 33 + n;
        u32x4 o; o.x = cvtpk(s[0 * 33], s[1 * 33]); o.y = cvtpk(s[2 * 33], s[3 * 33]); o.z = cvtpk(s[4 * 33], s[5 * 33]); o.w = cvtpk(s[6 * 33], s[7 * 33]);
        *(u32x4*)(WT + (size_t)(rbase + n) * K + k0 + 8 * c) = o; }
    asm volatile("s_waitcnt lgkmcnt(0)" ::: "memory");
}
__device__ __forceinline__ void gemv32_item(unsigned char* lds, const float* in, int ld_in, bool act, const float* W, int ldw, int N, int NP, int n0, const float* bias, float* out, int ldo, int tid) {
    float* INT = (float*)lds;
    __syncthreads();
    for (int idx = tid; idx < 32768; idx += 512) { const int b = idx >> 10, k = idx & 1023; float v = in[(size_t)b * ld_in + k]; if (act) v = siluf(v); INT[k * 32 + b] = v; }
    __syncthreads();
    const int n = n0 + tid;
    if (n < N) {
        float acc[32];
#pragma unroll
        for (int b = 0; b < 32; ++b) acc[b] = 0.f;
#pragma unroll 4
        for (int k = 0; k < 1024; ++k) { const float w = W[(size_t)k * ldw + n]; const f32x4* iv = (const f32x4*)(INT + k * 32);
#pragma unroll
            for (int q = 0; q < 8; ++q) { const f32x4 v = iv[q]; acc[4 * q + 0] += v[0] * w; acc[4 * q + 1] += v[1] * w; acc[4 * q + 2] += v[2] * w; acc[4 * q + 3] += v[3] * w; } }
        const float bb = bias ? bias[n] : 0.f;
#pragma unroll
        for (int b = 0; b < 32; ++b) out[(size_t)b * ldo + n] = acc[b] + bb;
    } else if (n < NP) {
#pragma unroll
        for (int b = 0; b < 32; ++b) out[(size_t)b * ldo + n] = 0.f;
    }
    __syncthreads();
}
__device__ __forceinline__ void row_prep(const float* xrow, const float* sc, bf16* xs, float* rstd_out, int lane) {
    const f32x4* xr = (const f32x4*)xrow + lane; const f32x4* sr = (const f32x4*)sc + lane;
    f32x4 v[4]; float s = 0.f;
#pragma unroll
    for (int j = 0; j < 4; ++j) { v[j] = xr[64 * j]; s += (v[j][0] * v[j][0] + v[j][1] * v[j][1]) + (v[j][2] * v[j][2] + v[j][3] * v[j][3]); }
    s = wave_sum(s);
    if (lane == 0) *rstd_out = 1.0f / sqrtf(s * (1.f / 1024.f) + EPS);
    u32x2* o = (u32x2*)xs + lane;
#pragma unroll
    for (int j = 0; j < 4; ++j) { const f32x4 w = v[j] * (sr[64 * j] + 1.0f); u32x2 q; q.x = cvtpk(w[0], w[1]); q.y = cvtpk(w[2], w[3]); o[64 * j] = q; }
}

constexpr int GL_R = 0;
constexpr int GL_QT = 8192;
constexpr int GL_BL = 10240;
constexpr int GL_BC = 10752;
constexpr int GL_VT = 43520;
constexpr int GL_KDT = 61952;
constexpr int GL_QE = 61952;
constexpr int GL_KE = 80384;
constexpr int GL_OL = 98816;
constexpr int PL_UT = 0;
constexpr int PL_PL = 21760;
static_assert(GL_OL + 64 * 132 * 4 <= LDS_BYTES, "mixer LDS map");

__device__ __forceinline__ float logsig(float x) { return fminf(x, 0.f) - __logf(1.0f + __expf(-fabsf(x))); }

__device__ __forceinline__ void gla_gates(unsigned char* lds, const bf16* Z, size_t row0, const float* wup  , const float* bgk  , int h, int tid) {
    float* R = LDSF(GL_R); float* QT = LDSF(GL_QT); float* BL = LDSF(GL_BL); float* BC = LDSF(GL_BC);
    { const int tok = tid >> 3, c4 = tid & 7; const u32x2 rv = *(const u32x2*)(Z + (row0 + tok) * ZP + C_RF + 4 * c4);
      f32x4 f = {bflo(rv.x), bfhi(rv.x), bflo(rv.y), bfhi(rv.y)}; *(f32x4*)(R + ((c4 >> 2) * 64 + tok) * 16 + 4 * (c4 & 3)) = f; }
    const int dir = tid >> 8, d = tid & 63, tq = (tid >> 6) & 3;
    float wv[16];
#pragma unroll
    for (int kk = 0; kk < 16; ++kk) wv[kk] = wup[(dir * 16 + kk) * 256 + h * 64 + d];
    const float bias = bgk[dir * 256 + h * 64 + d];
    __syncthreads();
    float g[16];
#pragma unroll
    for (int j = 0; j < 16; ++j) { const f32x4* rr = (const f32x4*)(R + (dir * 64 + 16 * tq + j) * 16); float x = bias;
#pragma unroll
        for (int q = 0; q < 4; ++q) { const f32x4 r4 = rr[q]; x += r4[0] * wv[4 * q] + r4[1] * wv[4 * q + 1] + r4[2] * wv[4 * q + 2] + r4[3] * wv[4 * q + 3]; }
        g[j] = logsig(x) * 0.0625f; }
    float run = 0.f;
    if (dir == 0) {
#pragma unroll
        for (int j = 0; j < 16; ++j) { run += g[j]; g[j] = run; }
    } else {
#pragma unroll
        for (int j = 15; j >= 0; --j) { run += g[j]; g[j] = run; }
    }
    QT[(dir * 4 + tq) * 64 + d] = run;
    __syncthreads();
    float off = 0.f, tot = 0.f;
#pragma unroll
    for (int q = 0; q < 4; ++q) { const float t = QT[(dir * 4 + q) * 64 + d]; tot += t; if (dir == 0 ? (q < tq) : (q > tq)) off += t; }
#pragma unroll
    for (int j = 0; j < 16; ++j) BC[(dir * 64 + 16 * tq + j) * 64 + d] = g[j] + off;
    if (tq == 0) BL[dir * 64 + d] = tot;
    __syncthreads();
}
__device__ __forceinline__ void gla_stage_vt(unsigned char* lds, const u32x4& v0, const u32x4& v1, int tid) {
    bf16* VT = (bf16*)(lds + GL_VT); const int tok = tid >> 3, vg = tid & 7;
    const unsigned w[8] = {v0.x, v0.y, v0.z, v0.w, v1.x, v1.y, v1.z, v1.w};
#pragma unroll
    for (int j = 0; j < 8; ++j) { VT[(16 * vg + 2 * j) * 72 + tok] = (bf16)(w[j] & 0xffffu); VT[(16 * vg + 2 * j + 1) * 72 + tok] = (bf16)(w[j] >> 16); }
}
__device__ __forceinline__ void gla_stepA_unit(unsigned char* lds, CP p, int l, int unit, int tid, int lane, int wave) {
    const bf16* Z = (const bf16*)(p->ws + WS_Z); bf16* ST = (bf16*)(p->ws + WS_ST); float* DEC = (float*)(p->ws + WS_DEC);
    const int n = unit & 31, h = (unit >> 5) & 3, b = unit >> 7, bh = b * 4 + h;
    const size_t row0 = (size_t)b * SEQ + n * 64;
    const int tok = tid >> 3, dg = tid & 7;
    const u32x4 k8 = *(const u32x4*)(Z + (row0 + tok) * ZP + C_K + h * 64 + 8 * dg);
    const u32x4 va = *(const u32x4*)(Z + (row0 + tok) * ZP + C_V + h * 128 + 16 * dg), vb2 = *(const u32x4*)(Z + (row0 + tok) * ZP + C_V + h * 128 + 16 * dg + 8);
    gla_gates(lds, Z, row0, p->w_gk_up + (size_t)l * 2 * 16 * 256, p->b_gk + (size_t)l * 2 * 256, h, tid);
    const float* BL = LDSF(GL_BL); const float* BC = LDSF(GL_BC); bf16* KDT = (bf16*)(lds + GL_KDT);
    const float kf[8] = {bflo(k8.x), bfhi(k8.x), bflo(k8.y), bfhi(k8.y), bflo(k8.z), bfhi(k8.z), bflo(k8.w), bfhi(k8.w)};
#pragma unroll
    for (int dir = 0; dir < 2; ++dir) {
        const f32x4 c0 = *(const f32x4*)(BC + (dir * 64 + tok) * 64 + 8 * dg), c1 = *(const f32x4*)(BC + (dir * 64 + tok) * 64 + 8 * dg + 4);
        const f32x4 l0 = *(const f32x4*)(BL + dir * 64 + 8 * dg), l1 = *(const f32x4*)(BL + dir * 64 + 8 * dg + 4);
#pragma unroll
        for (int j = 0; j < 8; ++j) { const float bc = j < 4 ? c0[j & 3] : c1[j & 3], bl = j < 4 ? l0[j & 3] : l1[j & 3];
            KDT[(dir * 64 + 8 * dg + j) * 72 + tok] = f2bf(kf[j] * __expf(bl - bc)); }
    }
    gla_stage_vt(lds, va, vb2, tid);
    if (tid < 128) DEC[((size_t)((tid >> 6) * 128 + bh) * 32 + n) * 64 + (tid & 63)] = __expf(BL[tid]);
    __syncthreads();
    {
        const int dir = wave >> 2, vb = wave & 3, r32 = lane & 31, hi = lane >> 5;
        const bf16* VT = (const bf16*)(lds + GL_VT);
        bf16* dst = ST + ((size_t)((dir * 128 + bh) * 32 + n)) * 8192;
#pragma unroll
        for (int db = 0; db < 2; ++db) {
            f32x16 acc = {};
#pragma unroll
            for (int s = 0; s < 4; ++s) {
                const bf16x8 a = *(const bf16x8*)(VT + (32 * vb + r32) * 72 + 16 * s + 8 * hi);
                const bf16x8 bb = *(const bf16x8*)(KDT + (dir * 64 + 32 * db + r32) * 72 + 16 * s + 8 * hi);
                acc = __builtin_amdgcn_mfma_f32_32x32x16_bf16(a, bb, acc, 0, 0, 0);
            }
#pragma unroll
            for (int r = 0; r < 16; ++r) { const int v = 32 * vb + (r & 3) + 8 * (r >> 2) + 4 * hi; dst[v * 64 + 32 * db + r32] = f2bf(acc[r]); }
        }
    }
    __syncthreads();
}
__device__ __forceinline__ void mixer_store(unsigned char* lds, bf16* dstbase  , bool gla, const bf16* gbase  , const float* ng, int tid) {
    const float* OL = LDSF(GL_OL); const int tok = tid >> 3, vg = tid & 7;
    float o[16];
#pragma unroll
    for (int q = 0; q < 4; ++q) { const f32x4 t = *(const f32x4*)(OL + tok * 132 + 16 * vg + 4 * q); o[4 * q] = t[0]; o[4 * q + 1] = t[1]; o[4 * q + 2] = t[2]; o[4 * q + 3] = t[3]; }
    if (gla) {
        float ss = 0.f;
#pragma unroll
        for (int j = 0; j < 16; ++j) ss += o[j] * o[j];
        ss += __shfl_xor(ss, 1); ss += __shfl_xor(ss, 2); ss += __shfl_xor(ss, 4);
        const float rstd = 1.0f / sqrtf(ss * (1.f / 128.f) + EPS);
        const u32x4 g0 = *(const u32x4*)(gbase + (size_t)tok * ZP + 16 * vg), g1 = *(const u32x4*)(gbase + (size_t)tok * ZP + 16 * vg + 8);
        const unsigned gw[8] = {g0.x, g0.y, g0.z, g0.w, g1.x, g1.y, g1.z, g1.w};
#pragma unroll
        for (int j = 0; j < 8; ++j) { const float ga = bflo(gw[j]), gb = bfhi(gw[j]);
            o[2 * j] = o[2 * j] * rstd * ng[16 * vg + 2 * j] * siluf(ga); o[2 * j + 1] = o[2 * j + 1] * rstd * ng[16 * vg + 2 * j + 1] * siluf(gb); }
    }
    u32x4 w0, w1;
    w0.x = cvtpk(o[0], o[1]); w0.y = cvtpk(o[2], o[3]); w0.z = cvtpk(o[4], o[5]); w0.w = cvtpk(o[6], o[7]);
    w1.x = cvtpk(o[8], o[9]); w1.y = cvtpk(o[10], o[11]); w1.z = cvtpk(o[12], o[13]); w1.w = cvtpk(o[14], o[15]);
    bf16* dp = dstbase + (size_t)tok * 1024 + 16 * vg;
    *(u32x4*)dp = w0; *(u32x4*)(dp + 8) = w1;
}
__device__ __forceinline__ void gla_stepC_unit(unsigned char* lds, CP p, int l, int unit, int tid, int lane, int wave) {
    const bf16* Z = (const bf16*)(p->ws + WS_Z); const bf16* ST = (const bf16*)(p->ws + WS_ST); bf16* AB = (bf16*)(p->ws + WS_ABUF);
    const int n = unit & 31, h = (unit >> 5) & 3, b = unit >> 7, bh = b * 4 + h;
    const size_t row0 = (size_t)b * SEQ + n * 64;
    const int tok = tid >> 3, dg = tid & 7;
    const u32x4 q8 = *(const u32x4*)(Z + (row0 + tok) * ZP + C_Q + h * 64 + 8 * dg);
    const u32x4 k8 = *(const u32x4*)(Z + (row0 + tok) * ZP + C_K + h * 64 + 8 * dg);
    const u32x4 va = *(const u32x4*)(Z + (row0 + tok) * ZP + C_V + h * 128 + 16 * dg), vb2 = *(const u32x4*)(Z + (row0 + tok) * ZP + C_V + h * 128 + 16 * dg + 8);
    gla_gates(lds, Z, row0, p->w_gk_up + (size_t)l * 2 * 16 * 256, p->b_gk + (size_t)l * 2 * 256, h, tid);
    const float* BC = LDSF(GL_BC); bf16* QE = (bf16*)(lds + GL_QE); bf16* KE = (bf16*)(lds + GL_KE);
    const float qf[8] = {bflo(q8.x), bfhi(q8.x), bflo(q8.y), bfhi(q8.y), bflo(q8.z), bfhi(q8.z), bflo(q8.w), bfhi(q8.w)};
    const float kf[8] = {bflo(k8.x), bfhi(k8.x), bflo(k8.y), bfhi(k8.y), bflo(k8.z), bfhi(k8.z), bflo(k8.w), bfhi(k8.w)};
#pragma unroll
    for (int dir = 0; dir < 2; ++dir) {
        const f32x4 c0 = *(const f32x4*)(BC + (dir * 64 + tok) * 64 + 8 * dg), c1 = *(const f32x4*)(BC + (dir * 64 + tok) * 64 + 8 * dg + 4);
        float qe[8], ke[8];
#pragma unroll
        for (int j = 0; j < 8; ++j) { const float bc = j < 4 ? c0[j & 3] : c1[j & 3]; const float e = __expf(bc); qe[j] = qf[j] * e * 0.125f; ke[j] = kf[j] * __expf(-bc); }
        u32x4 wq, wk;
        wq.x = cvtpk(qe[0], qe[1]); wq.y = cvtpk(qe[2], qe[3]); wq.z = cvtpk(qe[4], qe[5]); wq.w = cvtpk(qe[6], qe[7]);
        wk.x = cvtpk(ke[0], ke[1]); wk.y = cvtpk(ke[2], ke[3]); wk.z = cvtpk(ke[4], ke[5]); wk.w = cvtpk(ke[6], ke[7]);
        *(u32x4*)(QE + (dir * 64 + tok) * 72 + 8 * dg) = wq; *(u32x4*)(KE + (dir * 64 + tok) * 72 + 8 * dg) = wk;
    }
    gla_stage_vt(lds, va, vb2, tid);
    __syncthreads();
    {
        const int ib = wave >> 2, vb = wave & 3, r32 = lane & 31, hi = lane >> 5;
        const bf16* VT = (const bf16*)(lds + GL_VT);
        f32x16 o = {};
#pragma unroll
        for (int dir = 0; dir < 2; ++dir) {
            bf16x8 qfr[4];
#pragma unroll
            for (int s = 0; s < 4; ++s) qfr[s] = *(const bf16x8*)(QE + (dir * 64 + 32 * ib + r32) * 72 + 16 * s + 8 * hi);
            const bf16* Sg = ST + ((size_t)((dir * 128 + bh) * 32 + n)) * 8192 + (size_t)(32 * vb + r32) * 64 + 8 * hi;
#pragma unroll
            for (int s = 0; s < 4; ++s) { const bf16x8 sf = *(const bf16x8*)(Sg + 16 * s); o = __builtin_amdgcn_mfma_f32_32x32x16_bf16(qfr[s], sf, o, 0, 0, 0); }
#pragma unroll
            for (int jb = 0; jb < 2; ++jb) {
                f32x16 x = {};
#pragma unroll
                for (int s = 0; s < 4; ++s) { const bf16x8 a = *(const bf16x8*)(KE + (dir * 64 + 32 * jb + r32) * 72 + 16 * s + 8 * hi); x = __builtin_amdgcn_mfma_f32_32x32x16_bf16(a, qfr[s], x, 0, 0, 0); }
                const int i = 32 * ib + r32;
#pragma unroll
                for (int r = 0; r < 16; ++r) { const int j = 32 * jb + (r & 3) + 8 * (r >> 2) + 4 * hi; const bool keep = dir == 0 ? (j <= i) : (j > i); if (!keep) x[r] = 0.f; }
#pragma unroll
                for (int s2 = 0; s2 < 2; ++s2) {
                    u32x4 pa; pa.x = cvtpk(x[8 * s2], x[8 * s2 + 1]); pa.y = cvtpk(x[8 * s2 + 2], x[8 * s2 + 3]); pa.z = cvtpk(x[8 * s2 + 4], x[8 * s2 + 5]); pa.w = cvtpk(x[8 * s2 + 6], x[8 * s2 + 7]);
                    const bf16* vp = VT + (32 * vb + r32) * 72 + 32 * jb + 16 * s2 + 4 * hi;
                    const u32x2 b0 = *(const u32x2*)vp, b1 = *(const u32x2*)(vp + 8);
                    u32x4 pb; pb.x = b0.x; pb.y = b0.y; pb.z = b1.x; pb.w = b1.y;
                    o = __builtin_amdgcn_mfma_f32_32x32x16_bf16(__builtin_bit_cast(bf16x8, pa), __builtin_bit_cast(bf16x8, pb), o, 0, 0, 0);
                }
            }
        }
        float* OL = LDSF(GL_OL);
#pragma unroll
        for (int r = 0; r < 16; ++r) OL[(32 * ib + (r & 3) + 8 * (r >> 2) + 4 * hi) * 132 + 32 * vb + r32] = o[r];
    }
    __syncthreads();
    mixer_store(lds, AB + row0 * 1024 + 512 + h * 128, true, Z + row0 * ZP + C_G + h * 128, p->gla_norm_g + l * 128, tid);
    __syncthreads();
}
__device__ __forceinline__ void pool_unit(unsigned char* lds, CP p, int l, int unit, int tid, int lane, int wave) {
    const bf16* Z = (const bf16*)(p->ws + WS_Z); bf16* AB = (bf16*)(p->ws + WS_ABUF); const bf16* WPT = (const bf16*)(p->ws + WS_WPT);
    const int g = unit & 3, tt = (unit >> 2) & 31, b = unit >> 7, t0 = tt * 64;
    bf16* UT = (bf16*)(lds + PL_UT); bf16* PL = (bf16*)(lds + PL_PL);
    for (int idx = tid; idx < 80 * 16; idx += 512) { const int rr = idx >> 4, ch = idx & 15, t = t0 - 8 + rr;
        u32x4 v = {0u, 0u, 0u, 0u}; if (t >= 0 && t < SEQ) v = *(const u32x4*)(Z + ((size_t)b * SEQ + t) * ZP + g * 128 + 8 * ch);
        *(u32x4*)(UT + rr * 136 + 8 * ch) = v; }
    __syncthreads();
    { const int c = tid & 127, tq = tid >> 7, w = 2 << g, half = w >> 1;
#define U(rr) __uint_as_float(((unsigned)UT[(rr) * 136 + c]) << 16)
      int t = t0 + 16 * tq; float s = 0.f;
      for (int j = 0; j < w; ++j) s += U(t - half + j - t0 + 8);
      for (int j = 0; j < 16; ++j, ++t) {
          const int lo = max(t - half, 0), hi = min(t - half + w - 1, SEQ - 1);
          const float pooled = s / (float)(hi - lo + 1) - U(t - t0 + 8);
          PL[(16 * tq + j) * 136 + c] = f2bf(pooled);
          s += U(t + 1 - half + w - 1 - t0 + 8) - U(t - half - t0 + 8);
      }
#undef U
    }
    __syncthreads();
    { const int ib = wave >> 2, nb = wave & 3, r32 = lane & 31, hi = lane >> 5;
      const bf16* wp = WPT + ((size_t)(l * 4 + g) * 128 + 32 * nb + r32) * 128 + 8 * hi;
      f32x16 acc = {};
#pragma unroll
      for (int s = 0; s < 8; ++s) { const bf16x8 a = *(const bf16x8*)(PL + (32 * ib + r32) * 136 + 16 * s + 8 * hi); const bf16x8 bb = *(const bf16x8*)(wp + 16 * s);
          acc = __builtin_amdgcn_mfma_f32_32x32x16_bf16(a, bb, acc, 0, 0, 0); }
      const float sc = p->pool_scale[l * 512 + g * 128 + 32 * nb + r32];
      float* OL = LDSF(GL_OL);
#pragma unroll
      for (int r = 0; r < 16; ++r) OL[(32 * ib + (r & 3) + 8 * (r >> 2) + 4 * hi) * 132 + 32 * nb + r32] = acc[r] * sc; }
    __syncthreads();
    mixer_store(lds, AB + ((size_t)b * SEQ + t0) * 1024 + g * 128, false, nullptr, nullptr, tid);
    __syncthreads();
}

__device__ __forceinline__ void gla_scan(CP p, int gtid, int gthreads) {
    bf16* ST = (bf16*)(p->ws + WS_ST); const float* DEC = (const float*)(p->ws + WS_DEC);
    for (int ch = gtid; ch < 2 * 128 * 1024; ch += gthreads) {
        const int eg = ch & 1023, dbh = ch >> 10, dir = dbh >> 7;
        bf16* base = ST + (size_t)dbh * 32 * 8192 + 8 * eg; const float* dbase = DEC + (size_t)dbh * 32 * 64 + ((8 * eg) & 63);
        float s[8];
#pragma unroll
        for (int j = 0; j < 8; ++j) s[j] = 0.f;
#pragma unroll 4
        for (int it = 0; it < 32; ++it) {
            const int n = dir == 0 ? it : 31 - it;
            const u32x4 u = *(const u32x4*)(base + (size_t)n * 8192);
            const f32x4 d0 = *(const f32x4*)(dbase + n * 64), d1 = *(const f32x4*)(dbase + n * 64 + 4);
            u32x4 o; o.x = cvtpk(s[0], s[1]); o.y = cvtpk(s[2], s[3]); o.z = cvtpk(s[4], s[5]); o.w = cvtpk(s[6], s[7]);
            *(u32x4*)(base + (size_t)n * 8192) = o;
            s[0] = d0[0] * s[0] + bflo(u.x); s[1] = d0[1] * s[1] + bfhi(u.x); s[2] = d0[2] * s[2] + bflo(u.y); s[3] = d0[3] * s[3] + bfhi(u.y);
            s[4] = d1[0] * s[4] + bflo(u.z); s[5] = d1[1] * s[5] + bfhi(u.z); s[6] = d1[2] * s[6] + bflo(u.w); s[7] = d1[3] * s[7] + bfhi(u.w);
        }
    }
}

constexpr int RT_XS = 0;
constexpr int RT_H = 69632;
__device__ __forceinline__ void router_tile(unsigned char* lds, CP p, int l, int tile, int tid, int lane, int wave) {
    const float* X1 = p->out; const float* ROWSQ = (const float*)(p->ws + WS_ROWSQ); bf16* AB = (bf16*)(p->ws + WS_ABUF);
    int* CNT = (int*)(p->ws + WS_CTL) + 64 + l * 64; int* TOK = (int*)(p->ws + WS_TOK); float* GWL = (float*)(p->ws + WS_GWL);
    float* XS = LDSF(RT_XS + wave * 8704); int* H = (int*)(lds + RT_H); int* HB = H + 32;
    if (tid < 32) H[tid] = 0;
    const int tb = tile * 256 + wave * 32, b = tb >> 11;
    const float* sc2 = (const float*)(p->ws + WS_MOD) + ((size_t)(l * 32 + b) * 6144) + 4 * 1024; const float* sh2 = sc2 - 1024;
    const int rsub = lane >> 4, c4 = lane & 15, r32 = lane & 31, hi = lane >> 5;
    float rs[8];
#pragma unroll
    for (int it = 0; it < 8; ++it) { const f32x4* q = (const f32x4*)(ROWSQ + (size_t)(tb + 4 * it + rsub) * 16); const f32x4 a = q[0], bq = q[1], c = q[2], d = q[3];
        const float s = ((a[0] + a[1]) + (a[2] + a[3])) + ((bq[0] + bq[1]) + (bq[2] + bq[3])) + ((c[0] + c[1]) + (c[2] + c[3])) + ((d[0] + d[1]) + (d[2] + d[3]));
        rs[it] = 1.0f / sqrtf(s * (1.f / 1024.f) + EPS); }
    f32x16 acc = {};
    for (int k0 = 0; k0 < 1024; k0 += 64) {
        const f32x4 scv = *(const f32x4*)(sc2 + k0 + 4 * c4) + 1.0f, shv = *(const f32x4*)(sh2 + k0 + 4 * c4);
#pragma unroll
        for (int it = 0; it < 8; ++it) { const int row = 4 * it + rsub; const f32x4 xv = *(const f32x4*)(X1 + (size_t)(tb + row) * 1024 + k0 + 4 * c4);
            const f32x4 hv = xv * rs[it] * scv + shv; *(f32x4*)(XS + row * 68 + 4 * c4) = hv;
            u32x2 w; w.x = cvtpk(hv[0], hv[1]); w.y = cvtpk(hv[2], hv[3]); *(u32x2*)(AB + (size_t)(tb + row) * 1024 + k0 + 4 * c4) = w; }
        asm volatile("s_waitcnt lgkmcnt(0)" ::: "memory");
#pragma unroll
        for (int q = 0; q < 8; ++q) { const f32x4 av = *(const f32x4*)(XS + r32 * 68 + 8 * q + 4 * hi);
#pragma unroll
            for (int j = 0; j < 4; ++j) { const float bw = p->w_router[(size_t)(k0 + 8 * q + 4 * hi + j) * 32 + r32]; acc = __builtin_amdgcn_mfma_f32_32x32x2f32(av[j], bw, acc, 0, 0, 0); } }
        asm volatile("s_waitcnt lgkmcnt(0)" ::: "memory");
    }
#pragma unroll
    for (int r = 0; r < 16; ++r) XS[((r & 3) + 8 * (r >> 2) + 4 * hi) * 33 + r32] = acc[r];
    asm volatile("s_waitcnt lgkmcnt(0)" ::: "memory");
    int e1 = 0, e2 = 0, rk1 = 0, rk2 = 0; float gw1 = 0.f, gw2 = 0.f;
    if (lane < 32) {
        float s[32], sel[32];
#pragma unroll
        for (int e = 0; e < 32; ++e) { const float lg = XS[lane * 33 + e]; s[e] = 1.0f / (1.0f + __expf(-lg)); sel[e] = s[e] + p->b_router[e]; }
        float best = 0.f; int gi = 0;
#pragma unroll
        for (int g = 0; g < 4; ++g) { float m1 = -INFINITY, m2 = -INFINITY;
#pragma unroll
            for (int j = 0; j < 8; ++j) { const float v = sel[8 * g + j]; if (v > m1) { m2 = m1; m1 = v; } else if (v > m2) m2 = v; }
            const float gs = m1 + m2; if (g == 0 || gs > best) { best = gs; gi = g; } }
        float ig[8], sg[8];
#pragma unroll
        for (int j = 0; j < 8; ++j) { ig[j] = gi == 0 ? sel[j] : gi == 1 ? sel[8 + j] : gi == 2 ? sel[16 + j] : sel[24 + j]; sg[j] = gi == 0 ? s[j] : gi == 1 ? s[8 + j] : gi == 2 ? s[16 + j] : s[24 + j]; }
        int l1 = 0; float v1 = ig[0], w1 = sg[0];
#pragma unroll
        for (int j = 1; j < 8; ++j) if (ig[j] > v1) { v1 = ig[j]; l1 = j; w1 = sg[j]; }
        int l2 = l1 ^ 1; float v2 = -INFINITY, w2 = 0.f;
#pragma unroll
        for (int j = 0; j < 8; ++j) if (j != l1 && (ig[j] > v2 || (j == (l1 ^ 1) && v2 == -INFINITY))) { v2 = ig[j]; l2 = j; w2 = sg[j]; }
        e1 = 8 * gi + l1; e2 = 8 * gi + l2; const float inv = 1.0f / (w1 + w2); gw1 = w1 * inv; gw2 = w2 * inv;
    }
    __syncthreads();
    if (lane < 32) { rk1 = atomicAdd(&H[e1], 1); rk2 = atomicAdd(&H[e2], 1); }
    __syncthreads();
    if (tid < 32) HB[tid] = atomicAdd(&CNT[tid], H[tid]);
    __syncthreads();
    if (lane < 32) { const int t = tb + lane; const int p1 = HB[e1] + rk1, p2 = HB[e2] + rk2;
        TOK[e1 * 65536 + p1] = 2 * t; GWL[e1 * 65536 + p1] = gw1; TOK[e2 * 65536 + p2] = 2 * t + 1; GWL[e2 * 65536 + p2] = gw2; }
    __syncthreads();
}
__device__ __forceinline__ void moe_tables(unsigned char* lds, CP p, int l, int tid) {
    int* tab = (int*)(lds + LDS_SPARE); const int* CNT = (const int*)(p->ws + WS_CTL) + 64 + l * 64;
    __syncthreads();
    if (tid == 0) { int acc = 0; for (int e = 0; e < 32; ++e) { const int c = CNT[e]; tab[2 + e] = acc; tab[34 + e] = c; acc += (c + 255) >> 8; } tab[0] = acc; tab[1] = (acc + 7) & ~7; }
    __syncthreads();
    const int Rt = tab[0];
    for (int rt = tid; rt < Rt; rt += 512) { int e = 0;
#pragma unroll 1
        for (int q = 1; q < 32; ++q) if (tab[2 + q] <= rt) e = q;
        tab[128 + rt] = e; }
    __syncthreads();
}
__device__ __forceinline__ void moe_permute(unsigned char* lds, CP p, int gw, int NGW, int lane) {
    const int* tab = (const int*)(lds + LDS_SPARE); const int* TOK = (const int*)(p->ws + WS_TOK);
    const bf16* AB = (const bf16*)(p->ws + WS_ABUF); bf16* HS = (bf16*)(p->ws + WS_HS);
    const int nslots = tab[0] * 256;
    for (int s = gw; s < nslots; s += NGW) {
        const int rt = s >> 8, e = tab[128 + rt], pos = s - tab[2 + e] * 256;
        if (pos < tab[34 + e]) { const int t = TOK[e * 65536 + pos] >> 1;
            const u32x4* src = (const u32x4*)(AB + (size_t)t * 1024) + lane; u32x4* dst = (u32x4*)(HS + (size_t)s * 1024) + lane;
            const u32x4 a = src[0], bq = src[64]; dst[0] = a; dst[64] = bq; }
    }
}
__device__ __forceinline__ void combine_row(CP p, int l, int t, int lane) {
    const float* mod = (const float*)(p->ws + WS_MOD) + (size_t)(l * 32 + (t >> 11)) * 6144;
    const bf16* Y2 = (const bf16*)(p->ws + WS_Y2) + (size_t)t * 2048;
    f32x4* xr = (f32x4*)(p->out + (size_t)t * 1024) + lane; const f32x4* g2 = (const f32x4*)(mod + 5 * 1024) + lane;
    f32x4 v[4]; float s = 0.f;
#pragma unroll
    for (int j = 0; j < 4; ++j) { const u32x2 y0 = ((const u32x2*)Y2)[lane + 64 * j], y1 = ((const u32x2*)(Y2 + 1024))[lane + 64 * j];
        f32x4 ys = {bflo(y0.x) + bflo(y1.x), bfhi(y0.x) + bfhi(y1.x), bflo(y0.y) + bflo(y1.y), bfhi(y0.y) + bfhi(y1.y)};
        if (!((MK_MASK >> 10) & 1)) ys = (f32x4){0.f, 0.f, 0.f, 0.f};
        v[j] = xr[64 * j] + g2[64 * j] * ys; s += (v[j][0] * v[j][0] + v[j][1] * v[j][1]) + (v[j][2] * v[j][2] + v[j][3] * v[j][3]); }
    s = wave_sum(s);
    const float rstd = 1.0f / sqrtf(s * (1.f / 1024.f) + EPS);
    if (l + 1 < DEPTH) {
        const f32x4* sc = (const f32x4*)((const float*)(p->ws + WS_MOD) + (size_t)((l + 1) * 32 + (t >> 11)) * 6144 + 1024) + lane;
        u32x2* o = (u32x2*)((bf16*)(p->ws + WS_ABUF) + (size_t)t * 1024) + lane;
#pragma unroll
        for (int j = 0; j < 4; ++j) { xr[64 * j] = v[j]; const f32x4 w = v[j] * (sc[64 * j] + 1.0f); u32x2 q; q.x = cvtpk(w[0], w[1]); q.y = cvtpk(w[2], w[3]); o[64 * j] = q; }
        if (lane == 0) ((float*)(p->ws + WS_RSTD))[t] = rstd;
    } else {
        const f32x4* fg = (const f32x4*)p->final_g + lane;
#pragma unroll
        for (int j = 0; j < 4; ++j) xr[64 * j] = v[j] * rstd * fg[64 * j];
    }
}

constexpr int NPHASE = 2 + 10 * DEPTH;
__global__ void __launch_bounds__(512, 2) fwd_kernel(Params p0) {
    extern __shared__ __attribute__((aligned(16))) unsigned char lds[];
    cg::grid_group grid = cg::this_grid();
#pragma unroll 1
    for (int ph = p0.ph_lo; ph < p0.ph_hi; ++ph) {
        CP p = (CP)__builtin_amdgcn_kernarg_segment_ptr(); asm volatile("" : "+s"(p));
        int tid = threadIdx.x; asm volatile("" : "+v"(tid));
        const int lane = tid & 63, wave = __builtin_amdgcn_readfirstlane(tid >> 6);
        const int G = gridDim.x, bx = blockIdx.x, vcu = (G % 8 == 0) ? (bx % 8) * (G / 8) + bx / 8 : bx;
        const int gw = vcu * 8 + wave, NGW = G * 8;
        unsigned char* ws = p->ws;
        float* MOD = (float*)(ws + WS_MOD);
        const int l = ph < 2 ? 0 : (ph - 2) / 10, cls = ph < 2 ? ph : 2 + (ph - 2) % 10;
        switch (cls) {
        case 0: if ((MK_MASK >> 0) & 1) {
            if (vcu < 24) { const int l2 = vcu / 12, n0 = (vcu % 12) * 512;
                gemv32_item(lds, p->c, 1024, true, p->w_mod + (size_t)l2 * 1024 * 6144, 6144, 6144, 6144, n0, p->b_mod + l2 * 6144, MOD + (size_t)l2 * 32 * 6144, 6144, tid); }
            { u32x4* z = (u32x4*)(ws + WS_WIN); const u32x4 zero = {0u, 0u, 0u, 0u};
              for (int i = bx * 512 + tid; i < 2 * 224 * 128; i += G * 512) { const int l2 = i / (224 * 128), r = i % (224 * 128); z[(size_t)l2 * 2304 * 128 + 2080 * 128 + r] = zero; } }
            float* scr = (float*)(lds + wave * 16384);
            constexpr int I_IN = 16 * 65, I_OUT = 16 * 32, I_PL = 8, I_W1 = 16 * 16, I_W2 = 8 * 32;
            constexpr int N_IN = 2 * I_IN, N_OUT = 2 * I_OUT, N_PL = 8 * I_PL, N_W1 = 64 * I_W1, N_W2 = 64 * I_W2;
            for (int it = gw; it < N_IN + N_OUT + N_PL + 2 * N_W1 + N_W2; it += NGW) {
                int r = it;
                if (r < N_IN) { const int l2 = r / I_IN; p0_transpose_item(p->w_in + (size_t)l2 * 1024 * DIN, 1024, DIN, (bf16*)(ws + WS_WIN) + (size_t)l2 * ZP * 1024, 0, scr, r % I_IN, lane); continue; } r -= N_IN;
                if (r < N_OUT) { const int l2 = r / I_OUT; p0_transpose_item(p->w_out + (size_t)l2 * 1024 * 1024, 1024, 1024, (bf16*)(ws + WS_WOUT) + (size_t)l2 * 1024 * 1024, 0, scr, r % I_OUT, lane); continue; } r -= N_OUT;
                if (r < N_PL) { const int lg = r / I_PL; p0_transpose_item(p->w_pool + (size_t)lg * 128 * 128, 128, 128, (bf16*)(ws + WS_WPT) + (size_t)lg * 128 * 128, 0, scr, r % I_PL, lane); continue; } r -= N_PL;
                if (r < N_W1) { const int le = r / I_W1; p0_transpose_item(p->w1 + (size_t)le * 1024 * 512, 1024, 512, (bf16*)(ws + WS_W13) + (size_t)le * 1024 * 1024, 1, scr, r % I_W1, lane); continue; } r -= N_W1;
                if (r < N_W1) { const int le = r / I_W1; p0_transpose_item(p->w3 + (size_t)le * 1024 * 512, 1024, 512, (bf16*)(ws + WS_W13) + (size_t)le * 1024 * 1024, 2, scr, r % I_W1, lane); continue; } r -= N_W1;
                { const int le = r / I_W2; p0_transpose_item(p->w2 + (size_t)le * 512 * 1024, 512, 1024, (bf16*)(ws + WS_W2) + (size_t)le * 1024 * 512, 0, scr, r % I_W2, lane); }
            }
        } break;
        case 1: if ((MK_MASK >> 1) & 1) {
            if (vcu < 10) { const int l2 = vcu / 5, n0 = (vcu % 5) * 512;
                gemv32_item(lds, MOD + (size_t)l2 * 32 * 6144, 6144, false, p->w_in + (size_t)l2 * 1024 * DIN, DIN, DIN, ZP, n0, nullptr, (float*)(ws + WS_BIASIN) + (size_t)l2 * 32 * ZP, ZP, tid); }
            for (int t = gw; t < T; t += NGW) row_prep(p->x + (size_t)t * 1024, MOD + (size_t)(t >> 11) * 6144 + 1024, (bf16*)(ws + WS_ABUF) + (size_t)t * 1024, (float*)(ws + WS_RSTD) + t, lane);
        } break;
        case 2: if ((MK_MASK >> 2) & 1) {
            pg8::Gemm g{(const bf16*)(ws + WS_ABUF), (const bf16*)(ws + WS_WIN) + (size_t)l * ZP * 1024, T, ZP, 1024}; pg8::StaticOrder S; S.init(T, ZP, G, bx);
            pg8::EpiZ E{(bf16*)(ws + WS_Z), (const float*)(ws + WS_RSTD), (const float*)(ws + WS_BIASIN) + (size_t)l * 32 * ZP, ZP};
            pg8::gemm_phase<pg8::EpiZ, pg8::StaticOrder, true, true>((PG8_LAS unsigned char*)lds, g, S, E);
        } break;
        case 3: if ((MK_MASK >> 3) & 1) {
            for (int u = vcu; u < 8192; u += G) { if (u < 4096) gla_stepA_unit(lds, p, l, u, tid, lane, wave); else pool_unit(lds, p, l, u - 4096, tid, lane, wave); }
        } break;
        case 4: if ((MK_MASK >> 4) & 1) gla_scan(p, vcu * 512 + tid, G * 512); break;
        case 5: if ((MK_MASK >> 5) & 1) { for (int u = vcu; u < 4096; u += G) gla_stepC_unit(lds, p, l, u, tid, lane, wave); } break;
        case 6: if ((MK_MASK >> 6) & 1) {
            pg8::Gemm g{(const bf16*)(ws + WS_ABUF), (const bf16*)(ws + WS_WOUT) + (size_t)l * 1024 * 1024, T, 1024, 1024}; pg8::StaticOrder S; S.init(T, 1024, G, bx);
            pg8::EpiRes E{l == 0 ? p->x : p->out, p->out, MOD + (size_t)l * 32 * 6144 + 2 * 1024, (float*)(ws + WS_ROWSQ)};
            pg8::gemm_phase<pg8::EpiRes, pg8::StaticOrder, true, true>((PG8_LAS unsigned char*)lds, g, S, E);
        } break;
        case 7: if ((MK_MASK >> 7) & 1) { for (int tile = vcu; tile < T / 256; tile += G) router_tile(lds, p, l, tile, tid, lane, wave); } break;
        case 8: if ((MK_MASK >> 8) & 1) { moe_tables(lds, p, l, tid); moe_permute(lds, p, gw, NGW, lane); } break;
        case 9: if ((MK_MASK >> 9) & 1) {
            moe_tables(lds, p, l, tid);
            pg8::Gemm g{(const bf16*)(ws + WS_HS), (const bf16*)(ws + WS_W13) + (size_t)l * 32 * 1024 * 1024, HS_ROWS, 32 * 1024, 1024};
            pg8::MoeOrder S{(const PG8_LAS int*)(lds + LDS_SPARE), G, bx}; pg8::EpiAct E{(bf16*)(ws + WS_ACT)};
            pg8::gemm_phase<pg8::EpiAct, pg8::MoeOrder, true, true>((PG8_LAS unsigned char*)lds, g, S, E);
        } break;
        case 10: if ((MK_MASK >> 10) & 1) {
            moe_tables(lds, p, l, tid);
            pg8::Gemm g{(const bf16*)(ws + WS_ACT), (const bf16*)(ws + WS_W2) + (size_t)l * 32 * 1024 * 512, HS_ROWS, 32 * 1024, 512};
            pg8::MoeOrder S{(const PG8_LAS int*)(lds + LDS_SPARE), G, bx};
            pg8::EpiY E{(bf16*)(ws + WS_Y2), (const int*)(ws + WS_TOK), (const float*)(ws + WS_GWL), (const int*)(ws + WS_CTL) + 64 + l * 64};
            pg8::gemm_phase<pg8::EpiY, pg8::MoeOrder, true, true>((PG8_LAS unsigned char*)lds, g, S, E);
        } break;
        default: if ((MK_MASK >> 11) & 1) { for (int t = gw; t < T; t += NGW) combine_row(p, l, t, lane); } break;
        }
        if (ph + 1 < p0.ph_hi) grid.sync();
    }
}

extern "C" void kernel_launch(void* const* d_in, const int* in_sizes, int n_in, void* d_out, int out_size, void* d_ws, size_t ws_size, hipStream_t stream) {
    static int grid = 0;
    if (grid == 0) {
        if (n_in != 17 || out_size != T * DM || ws_size < WS_END) { fprintf(stderr, "kernel_launch: unexpected shapes: n_in %d out %d ws %zu (need %zu)\n", n_in, out_size, ws_size, (size_t)WS_END); grid = -1; return; }
        int dev = 0, cus = 0, per_cu = 0;
        (void)hipGetDevice(&dev); (void)hipDeviceGetAttribute(&cus, hipDeviceAttributeMultiprocessorCount, dev);
        (void)hipFuncSetAttribute((const void*)fwd_kernel, hipFuncAttributeMaxDynamicSharedMemorySize, LDS_BYTES);
        (void)hipOccupancyMaxActiveBlocksPerMultiprocessor(&per_cu, (const void*)fwd_kernel, 512, LDS_BYTES);
        if (per_cu < 1) { fprintf(stderr, "kernel_launch: occupancy query says %d blocks per CU\n", per_cu); grid = -1; return; }
        grid = cus;
    }
    if (grid < 0) return;
    (void)hipMemsetAsync((char*)d_ws + WS_CTL, 0, 1 * MiB, stream);
    Params p{};
    const float** pp = (const float**)&p;
    for (int i = 0; i < 17; ++i) pp[i] = (const float*)d_in[i];
    p.out = (float*)d_out; p.ws = (unsigned char*)d_ws;
#if MK_MULTI
    for (int k = 0; k < NPHASE; ++k) { p.ph_lo = k; p.ph_hi = k + 1; void* args[] = {&p};
        hipError_t e = hipLaunchCooperativeKernel((const void*)fwd_kernel, dim3(grid), dim3(512), args, LDS_BYTES, stream);
        if (e != hipSuccess) { fprintf(stderr, "launch of phase %d failed: %s\n", k, hipGetErrorString(e)); break; } }
#else
    p.ph_lo = 0; p.ph_hi = NPHASE; void* args[] = {&p};
    hipError_t e = hipLaunchCooperativeKernel((const void*)fwd_kernel, dim3(grid), dim3(512), args, LDS_BYTES, stream);
    if (e != hipSuccess) fprintf(stderr, "cooperative launch failed: %s (grid %d)\n", hipGetErrorString(e), grid);
#endif
}
```

```cpp
#include <hip/hip_runtime.h>
#include <hip/hip_cooperative_groups.h>
#include <cstdio>
#include <cstdint>
namespace cg = cooperative_groups;

#ifndef MK_MASK
#define MK_MASK 0xFFF
#endif
#ifndef MK_REP
#define MK_REP 0
#endif
#ifndef MK_MULTI
#define MK_MULTI 0
#endif

constexpr int DM = 1024, NB = 32, SEQ = 2048, T = NB * SEQ, DEPTH = 2;
constexpr int DIN = 2080, ZP = 2304;
constexpr int C_Q = 512, C_K = 768, C_V = 1024, C_G = 1536, C_RF = 2048;
constexpr int NE = 32, DFF = 512;
constexpr int HS_ROWS = 139264;
constexpr float EPS = 1e-6f;

constexpr size_t MiB = 1u << 20;
constexpr size_t WS_CTL = 0;
constexpr size_t WS_MOD = 1 * MiB;
constexpr size_t WS_BIASIN = 3 * MiB;
constexpr size_t WS_RSTD = 4 * MiB;
constexpr size_t WS_ROWSQ = 5 * MiB;
constexpr size_t WS_DEC = 9 * MiB;
constexpr size_t WS_TOK = 11 * MiB;
constexpr size_t WS_GWL = 19 * MiB;
constexpr size_t WS_WPT = 28 * MiB;
constexpr size_t WS_WOUT = 29 * MiB;
constexpr size_t WS_WIN = 33 * MiB;
constexpr size_t WS_W2 = 42 * MiB;
constexpr size_t WS_W13 = 106 * MiB;
constexpr size_t WS_ABUF = 234 * MiB;
constexpr size_t WS_R = 362 * MiB;
constexpr size_t WS_Z = WS_R;
constexpr size_t WS_ST = WS_R + 288 * MiB;
constexpr size_t WS_HS = WS_R;
constexpr size_t WS_Y2 = WS_R;
constexpr size_t WS_ACT = WS_R + 272 * MiB;
constexpr size_t WS_END = WS_R + 416 * MiB;
constexpr int LDS_BYTES = 147456;
constexpr int LDS_SPARE = 131072;

typedef unsigned short bf16;
typedef float f32x4 __attribute__((ext_vector_type(4)));
typedef float f32x16 __attribute__((ext_vector_type(16)));
typedef short bf16x8 __attribute__((ext_vector_type(8)));
typedef unsigned u32x4 __attribute__((ext_vector_type(4)));
typedef unsigned u32x2 __attribute__((ext_vector_type(2)));
typedef float f32x2_t __attribute__((ext_vector_type(2)));
typedef __bf16 bf16x2_t __attribute__((ext_vector_type(2)));

__device__ __forceinline__ unsigned cvtpk(float lo, float hi) { f32x2_t v = {lo, hi}; bf16x2_t b = __builtin_convertvector(v, bf16x2_t); return __builtin_bit_cast(unsigned, b); }
__device__ __forceinline__ unsigned short f2bf(float f) { return (unsigned short)(cvtpk(f, 0.f) & 0xffffu); }
__device__ __forceinline__ float bflo(unsigned u) { return __uint_as_float(u << 16); }
__device__ __forceinline__ float bfhi(unsigned u) { return __uint_as_float(u & 0xffff0000u); }
__device__ __forceinline__ float siluf(float x) { return x / (1.0f + __expf(-x)); }
__device__ __forceinline__ float wave_sum(float v) {
#pragma unroll
    for (int o = 1; o < 64; o <<= 1) v += __shfl_xor(v, o);
    return v;
}

namespace pg8 {
#define PG8_LAS __attribute__((address_space(3)))
typedef unsigned short bf16_t;
typedef short bf16x8 __attribute__((ext_vector_type(8)));
typedef float f32x4 __attribute__((ext_vector_type(4)));
typedef unsigned u32x4 __attribute__((ext_vector_type(4)));
constexpr int BM = 256, BK = 64, HALF = 128, HTB = HALF * BK * 2  , STAGE_BYTES = 8 * HTB, NXCD = 8, WGM = 8;

__host__ __device__ __forceinline__ int lds_byte(int r, int c) { const int st = (r >> 4) * 2 + (c >> 5), rr = r & 15, cc = c & 31, ob = rr * 64 + cc * 2; return st * 1024 + (ob ^ (((ob >> 9) & 1) << 5)); }
__host__ __device__ __forceinline__ void stage_rc(int b, int& R, int& C) { const int st = b / 1024, sb = b % 1024, swz = sb ^ (((sb >> 9) & 1) << 5); R = (st >> 1) * 16 + swz / 64; C = (st & 1) * 32 + (swz % 64) / 2; }
__host__ __device__ __forceinline__ int perm32(int rho) { const int n = rho >> 4, i = rho & 15; return 8 * (i >> 2) + 4 * n + (i & 3); }

struct Unit { int pm, pn, x0, x1; };
struct Gemm { const bf16_t* A; const bf16_t* Bt; int M, N, K; };

struct StaticOrder {
    int nM, nN, nwg, G, c;
    __host__ __device__ void init(int M, int N, int G_, int c_) { nM = M / BM; nN = N / BM; nwg = nM * nN; G = G_; c = c_; }
    __host__ __device__ bool next(int i, Unit& u) const {
        const long L = (long)i * G + c; if (L >= nwg) return false;
        int wgid = (int)L; { const int q = nwg / NXCD, r = nwg % NXCD, xcd = wgid % NXCD, off = wgid / NXCD; wgid = (xcd < r ? xcd * (q + 1) : r * (q + 1) + (xcd - r) * q) + off; }
        const int nig = WGM * nN, gid = wgid / nig, fm = gid * WGM, gsz = (nM - fm) < WGM ? (nM - fm) : WGM;
        u.pm = fm + ((wgid % nig) % gsz); u.pn = (wgid % nig) / gsz; return true;
    }
    __device__ __forceinline__ void a_ready(const Unit&) const {}
    __device__ __forceinline__ void done(const Unit&) const {}
};


__device__ __forceinline__ unsigned pk2(float lo, float hi) { typedef float v2f __attribute__((ext_vector_type(2))); typedef __bf16 v2b __attribute__((ext_vector_type(2))); v2f v = {lo, hi}; v2b b = __builtin_convertvector(v, v2b); return __builtin_bit_cast(unsigned, b); }
struct EpiZ {
    static constexpr bool PERM = true, AFTER_DRAIN = false;
    bf16_t* Z; const float* rstd; const float* bias; int zp;
    __device__ __forceinline__ void operator()(const f32x4 (&acc)[2][2][4][2], const Unit& u, int wr, int wc, int fr, int fq) const {
        const int row0 = u.pm * BM + wr * 64 + fr, col0 = u.pn * BM + wc * 32 + 8 * fq;
        const float* bp = bias + (size_t)((u.pm * BM) >> 11) * zp + col0;
        f32x4 bv[2][2];
#pragma unroll
        for (int bj = 0; bj < 2; ++bj)
#pragma unroll
            for (int n = 0; n < 2; ++n) bv[bj][n] = *(const f32x4*)(bp + bj * HALF + 4 * n);
#pragma unroll
        for (int ai = 0; ai < 2; ++ai)
#pragma unroll
            for (int m = 0; m < 4; ++m) { const int row = row0 + ai * HALF + m * 16; const float rs = rstd[row]; bf16_t* rowp = Z + (size_t)row * zp + col0;
#pragma unroll
                for (int bj = 0; bj < 2; ++bj) { const f32x4 v0 = acc[ai][bj][m][0] * rs + bv[bj][0], v1 = acc[ai][bj][m][1] * rs + bv[bj][1];
                    u32x4 w; w.x = pk2(v0[0], v0[1]); w.y = pk2(v0[2], v0[3]); w.z = pk2(v1[0], v1[1]); w.w = pk2(v1[2], v1[3]);
                    *(u32x4*)(rowp + bj * HALF) = w; } }
    }
};
struct EpiRes {
    static constexpr bool PERM = false, AFTER_DRAIN = false;
    const float* xres; float* out; const float* g1; float* rowsq;
    __device__ __forceinline__ void operator()(const f32x4 (&acc)[2][2][4][2], const Unit& u, int wr, int wc, int fr, int fq) const {
        const int row0 = u.pm * BM + wr * 64 + fr, col0 = u.pn * BM + wc * 32 + 4 * fq;
        const float* gp = g1 + (size_t)((u.pm * BM) >> 11) * 6144 + col0;
        f32x4 gv[2][2];
#pragma unroll
        for (int bj = 0; bj < 2; ++bj)
#pragma unroll
            for (int n = 0; n < 2; ++n) gv[bj][n] = *(const f32x4*)(gp + bj * HALF + n * 16);
#pragma unroll
        for (int ai = 0; ai < 2; ++ai)
#pragma unroll
            for (int m = 0; m < 4; ++m) { const int row = row0 + ai * HALF + m * 16; const size_t off = (size_t)row * 1024 + col0; float s = 0.f;
#pragma unroll
                for (int bj = 0; bj < 2; ++bj)
#pragma unroll
                    for (int n = 0; n < 2; ++n) { const f32x4 xr = *(const f32x4*)(xres + off + bj * HALF + n * 16); const f32x4 o = xr + gv[bj][n] * acc[ai][bj][m][n];
                        *(f32x4*)(out + off + bj * HALF + n * 16) = o; s += (o[0] * o[0] + o[1] * o[1]) + (o[2] * o[2] + o[3] * o[3]); }
                s += __shfl_xor(s, 16); s += __shfl_xor(s, 32);
                if (fq == 0) rowsq[(size_t)row * 16 + u.pn * 4 + wc] = s; }
    }
};
struct EpiAct {
    static constexpr bool PERM = true, AFTER_DRAIN = false;
    bf16_t* ACT;
    __device__ __forceinline__ void operator()(const f32x4 (&acc)[2][2][4][2], const Unit& u, int wr, int wc, int fr, int fq) const {
        if (!(u.x0 >> 8)) return;
        const int ct = u.pn & 3, row0 = u.pm * BM + wr * 64 + fr, col0 = ct * 128 + wc * 32 + 8 * fq;
#pragma unroll
        for (int ai = 0; ai < 2; ++ai)
#pragma unroll
            for (int m = 0; m < 4; ++m) { bf16_t* rowp = ACT + (size_t)(row0 + ai * HALF + m * 16) * 512 + col0;
                float v[8];
#pragma unroll
                for (int n = 0; n < 2; ++n)
#pragma unroll
                    for (int i = 0; i < 4; ++i) { const float a = acc[ai][0][m][n][i], b = acc[ai][1][m][n][i]; v[n * 4 + i] = a / (1.0f + __expf(-a)) * b; }
                u32x4 w; w.x = pk2(v[0], v[1]); w.y = pk2(v[2], v[3]); w.z = pk2(v[4], v[5]); w.w = pk2(v[6], v[7]);
                *(u32x4*)rowp = w; }
    }
};
struct EpiY {
    static constexpr bool PERM = true, AFTER_DRAIN = false;
    bf16_t* Y2; const int* tok; const float* gwl; const int* cnt;
    __device__ __forceinline__ void operator()(const f32x4 (&acc)[2][2][4][2], const Unit& u, int wr, int wc, int fr, int fq) const {
        if (!(u.x0 >> 8)) return;
        const int e = u.x0 & 0xff, ct = u.pn & 3, ne = cnt[e];
#pragma unroll
        for (int ai = 0; ai < 2; ++ai)
#pragma unroll
            for (int m = 0; m < 4; ++m) { const int r = u.x1 + ai * HALF + wr * 64 + m * 16 + fr;
                if (r < ne) { const int tk = tok[e * 65536 + r]; const float gw = gwl[e * 65536 + r];
                    bf16_t* dst = Y2 + (size_t)tk * 1024 + ct * 256 + wc * 32 + 8 * fq;
#pragma unroll
                    for (int bj = 0; bj < 2; ++bj) { const f32x4 v0 = acc[ai][bj][m][0] * gw, v1 = acc[ai][bj][m][1] * gw;
                        u32x4 w; w.x = pk2(v0[0], v0[1]); w.y = pk2(v0[2], v0[3]); w.z = pk2(v1[0], v1[1]); w.w = pk2(v1[2], v1[3]);
                        *(u32x4*)(dst + bj * HALF) = w; } } }
    }
};
struct MoeOrder {
    const PG8_LAS int* tab; int G, c;
    __device__ __forceinline__ bool next(int i, Unit& u) const {
        const int RTP = __builtin_amdgcn_readfirstlane(tab[1]), Rt = __builtin_amdgcn_readfirstlane(tab[0]), nwg = RTP * 4;
        const long L = (long)i * G + c; if (L >= nwg) return false;
        int wgid = (int)L; { const int q = nwg / NXCD, r = nwg % NXCD, xcd = wgid % NXCD, off = wgid / NXCD; wgid = (xcd < r ? xcd * (q + 1) : r * (q + 1) + (xcd - r) * q) + off; }
        const int gid = wgid / 32, w = wgid % 32, rt = 8 * gid + (w & 7), ct = w >> 3, valid = rt < Rt ? 1 : 0, rtc = valid ? rt : 0;
        const int e = __builtin_amdgcn_readfirstlane(tab[128 + rtc]), sb = __builtin_amdgcn_readfirstlane(tab[2 + e]);
        u.pm = rtc; u.pn = e * 4 + ct; u.x0 = e | (valid << 8); u.x1 = (rtc - sb) * 256; return true;
    }
    __device__ __forceinline__ void a_ready(const Unit&) const {}
    __device__ __forceinline__ void done(const Unit&) const {}
};

template <class Epi, class Sched, bool ALIGN_EPI = false, bool SP2 = false>
__device__ __forceinline__ void gemm_phase(PG8_LAS unsigned char* lds, const Gemm g, const Sched& S, const Epi& E) {
    int tid = threadIdx.x; asm volatile("" : "+v"(tid)); const int wid = __builtin_amdgcn_readfirstlane(tid >> 6), lane = tid & 63, wr = wid >> 2, wc = wid & 3, fr = lane & 15, fq = lane >> 4;
    const int K = g.K, nt = K / BK;
    unsigned voffA[2], voffB[2];
#pragma unroll
    for (int i = 0; i < 2; ++i) { int R, C; stage_rc(tid * 16 + i * 8192, R, C); const int Rb = Epi::PERM ? ((R & ~31) + perm32(R & 31)) : R;
        voffA[i] = (unsigned)(R * K + C) * 2u; voffB[i] = (unsigned)(Rb * K + C) * 2u; }
    const size_t kstep = (size_t)(BK * 2);
    const size_t hstep = (size_t)HALF * K * 2;
    const size_t tstep = 2 * hstep;
    const unsigned ldsw = (unsigned)wid * 1024u;
    const int aoff = lds_byte(wr * 64 + fr, fq * 8), boff = lds_byte(wc * 32 + fr, fq * 8);
#define PG8_SA(b, h) (((b) * 2 + (h)) * HTB)
#define PG8_SB(b, h) ((4 + (b) * 2 + (h)) * HTB)
#define PG8_STAGE(bufoff, gbase, voff) do { _Pragma("unroll") for (int _i = 0; _i < 2; ++_i) \
        __builtin_amdgcn_global_load_lds((const unsigned*)((const char*)(gbase) + (voff)[_i]), (PG8_LAS unsigned*)(lds + (bufoff) + ldsw + _i * 8192), 16, 0, 0); } while (0)
#define PG8_LDA(dst, b, h) do { _Pragma("unroll") for (int m = 0; m < 4; ++m) _Pragma("unroll") for (int k = 0; k < 2; ++k) dst[m][k] = *(const PG8_LAS bf16x8*)(lds + PG8_SA(b, h) + aoff + m * 2048 + k * 1024); } while (0)
#define PG8_LDB(dst, b, h) do { _Pragma("unroll") for (int n = 0; n < 2; ++n) _Pragma("unroll") for (int k = 0; k < 2; ++k) dst[n][k] = *(const PG8_LAS bf16x8*)(lds + PG8_SB(b, h) + boff + n * 2048 + k * 1024); } while (0)
#define PG8_MMA(ai, bj, At, Bt) do { __builtin_amdgcn_s_setprio(1); _Pragma("unroll") for (int m = 0; m < 4; ++m) _Pragma("unroll") for (int n = 0; n < 2; ++n) _Pragma("unroll") for (int k = 0; k < 2; ++k) \
        acc[ai][bj][m][n] = __builtin_amdgcn_mfma_f32_16x16x32_bf16(Bt[n][k], At[m][k], acc[ai][bj][m][n], 0, 0, 0); __builtin_amdgcn_s_setprio(0); } while (0)
#define PG8_WAIT_V(n) asm volatile("s_waitcnt vmcnt(" #n ")" ::: "memory")
#define PG8_WAIT_L(n) asm volatile("s_waitcnt lgkmcnt(" #n ")" ::: "memory")
#define PG8_BAR __builtin_amdgcn_s_barrier()
#define PG8_SCHED __builtin_amdgcn_sched_barrier(0)
    Unit cur, nxt; int ui = 0;
    if (!S.next(0, cur)) return;
    f32x4 acc[2][2][4][2];
#pragma unroll
    for (int a = 0; a < 2; ++a)
#pragma unroll
        for (int b = 0; b < 2; ++b)
#pragma unroll
            for (int m = 0; m < 4; ++m)
#pragma unroll
                for (int n = 0; n < 2; ++n) acc[a][b][m][n] = (f32x4){0.f, 0.f, 0.f, 0.f};
    bf16x8 At[4][2], B0[2][2], B1[2][2];
    const char* cA = (const char*)g.A + (size_t)cur.pm * tstep; const char* cB = (const char*)g.Bt + (size_t)cur.pn * tstep;
    S.a_ready(cur);
    if constexpr (SP2) {
        PG8_STAGE(PG8_SB(0, 0), cB, voffB); PG8_STAGE(PG8_SB(0, 1), cB + hstep, voffB); PG8_STAGE(PG8_SA(0, 0), cA, voffA); PG8_STAGE(PG8_SA(0, 1), cA + hstep, voffA);
        if (wr == 1) PG8_BAR;
        PG8_WAIT_V(2); PG8_BAR;
        PG8_STAGE(PG8_SB(1, 0), cB + kstep, voffB); PG8_STAGE(PG8_SA(1, 0), cA + kstep, voffA); PG8_STAGE(PG8_SB(1, 1), cB + hstep + kstep, voffB);
        PG8_WAIT_V(6); PG8_BAR;
    } else {
        PG8_STAGE(PG8_SB(0, 0), cB, voffB); PG8_STAGE(PG8_SA(0, 0), cA, voffA); PG8_STAGE(PG8_SB(0, 1), cB + hstep, voffB); PG8_STAGE(PG8_SA(0, 1), cA + hstep, voffA);
        if (wr == 1) PG8_BAR;
        PG8_WAIT_V(4); PG8_BAR;
        PG8_STAGE(PG8_SB(1, 0), cB + kstep, voffB); PG8_STAGE(PG8_SA(1, 0), cA + kstep, voffA); PG8_STAGE(PG8_SB(1, 1), cB + hstep + kstep, voffB);
        PG8_WAIT_V(6); PG8_BAR;
    }
    for (;;) {
        const bool has_next = S.next(ui + 1, nxt);
        const char* nA = has_next ? (const char*)g.A + (size_t)nxt.pm * tstep : cA; const char* nB = has_next ? (const char*)g.Bt + (size_t)nxt.pn * tstep : cB;
        for (int t = 0; t < nt; t += 2) {
            const bool last = (t == nt - 2);
            const char* a1 = cA + (size_t)(t + 1) * kstep;
            const char* a2 = last ? nA : cA + (size_t)(t + 2) * kstep; const char* b2 = last ? nB : cB + (size_t)(t + 2) * kstep;
            const char* a3 = a2 + kstep; const char* b3 = b2 + kstep;
            if (last && has_next) S.a_ready(nxt);
            if constexpr (SP2) {
            PG8_LDB(B0, 0, 0); PG8_LDB(B1, 0, 1); PG8_SCHED; PG8_LDA(At, 0, 0); PG8_STAGE(PG8_SA(1, 1), a1 + hstep, voffA);
            PG8_WAIT_V(8); PG8_WAIT_L(0); PG8_BAR; PG8_MMA(0, 0, At, B0); PG8_MMA(0, 1, At, B1); PG8_BAR; PG8_SCHED;
            PG8_LDA(At, 0, 1); PG8_STAGE(PG8_SB(0, 0), b2, voffB); PG8_STAGE(PG8_SB(0, 1), b2 + hstep, voffB); PG8_STAGE(PG8_SA(0, 0), a2, voffA);
            PG8_WAIT_V(8); PG8_WAIT_L(0); PG8_BAR; PG8_MMA(1, 0, At, B0); PG8_MMA(1, 1, At, B1); PG8_BAR; PG8_SCHED;
            PG8_LDB(B0, 1, 0); PG8_LDB(B1, 1, 1); PG8_SCHED; PG8_LDA(At, 1, 0); PG8_STAGE(PG8_SA(0, 1), a2 + hstep, voffA);
            PG8_WAIT_V(8); PG8_WAIT_L(0); PG8_BAR; PG8_MMA(0, 0, At, B0); PG8_MMA(0, 1, At, B1); PG8_BAR; PG8_SCHED;
            PG8_LDA(At, 1, 1); PG8_STAGE(PG8_SB(1, 0), b3, voffB); PG8_STAGE(PG8_SB(1, 1), b3 + hstep, voffB); PG8_STAGE(PG8_SA(1, 0), a3, voffA);
            PG8_WAIT_V(8); PG8_WAIT_L(0); PG8_BAR; PG8_MMA(1, 0, At, B0); PG8_MMA(1, 1, At, B1); PG8_BAR; PG8_SCHED;
            } else {
            PG8_LDB(B0, 0, 0); PG8_SCHED; PG8_LDA(At, 0, 0); PG8_STAGE(PG8_SA(1, 1), a1 + hstep, voffA);
            PG8_WAIT_L(8); PG8_BAR; PG8_WAIT_L(0); PG8_MMA(0, 0, At, B0); PG8_BAR; PG8_SCHED;
            PG8_LDB(B1, 0, 1); PG8_STAGE(PG8_SB(0, 0), b2, voffB);
            PG8_BAR; PG8_WAIT_L(0); PG8_MMA(0, 1, At, B1); PG8_BAR;
            PG8_LDA(At, 0, 1); PG8_STAGE(PG8_SA(0, 0), a2, voffA);
            PG8_BAR; PG8_WAIT_L(0); PG8_MMA(1, 0, At, B0); PG8_BAR; PG8_SCHED;
            PG8_STAGE(PG8_SB(0, 1), b2 + hstep, voffB);
            PG8_WAIT_V(6); PG8_BAR; PG8_MMA(1, 1, At, B1); PG8_BAR;
            PG8_LDB(B0, 1, 0); PG8_SCHED; PG8_LDA(At, 1, 0); PG8_STAGE(PG8_SA(0, 1), a2 + hstep, voffA);
            PG8_WAIT_L(8); PG8_BAR; PG8_WAIT_L(0); PG8_MMA(0, 0, At, B0); PG8_BAR; PG8_SCHED;
            PG8_LDB(B1, 1, 1); PG8_STAGE(PG8_SB(1, 0), b3, voffB);
            PG8_BAR; PG8_WAIT_L(0); PG8_MMA(0, 1, At, B1); PG8_BAR;
            PG8_LDA(At, 1, 1); PG8_STAGE(PG8_SA(1, 0), a3, voffA);
            PG8_BAR; PG8_WAIT_L(0); PG8_MMA(1, 0, At, B0); PG8_BAR; PG8_SCHED;
            PG8_STAGE(PG8_SB(1, 1), b3 + hstep, voffB);
            PG8_WAIT_V(6); PG8_BAR; PG8_MMA(1, 1, At, B1); PG8_BAR;
            }
        }
        if constexpr (ALIGN_EPI) { if (wr == 0) PG8_BAR; }
        if constexpr (!Epi::AFTER_DRAIN) { E(acc, cur, wr, wc, fr, fq); S.done(cur); }
        if (!has_next) break;
#pragma unroll
        for (int a = 0; a < 2; ++a)
#pragma unroll
            for (int b = 0; b < 2; ++b)
#pragma unroll
                for (int m = 0; m < 4; ++m)
#pragma unroll
                    for (int n = 0; n < 2; ++n) acc[a][b][m][n] = (f32x4){0.f, 0.f, 0.f, 0.f};
        cur = nxt; cA = nA; cB = nB; ++ui;
        if constexpr (ALIGN_EPI) { if (wr == 1) PG8_BAR; }
    }
    PG8_WAIT_V(0);
    if constexpr (!ALIGN_EPI) { if (wr == 0) PG8_BAR; }
    PG8_BAR;
    if constexpr (Epi::AFTER_DRAIN) { E.fused(acc, cur, wr, wc, fr, fq, lds, wid, lane); S.done(cur); }
#undef PG8_SA
#undef PG8_SB
#undef PG8_STAGE
#undef PG8_LDA
#undef PG8_LDB
#undef PG8_MMA
#undef PG8_WAIT_V
#undef PG8_WAIT_L
#undef PG8_BAR
#undef PG8_SCHED
}
}

struct Params {
    const float *x, *c, *w_mod, *b_mod, *w_in, *w_pool, *pool_scale, *w_gk_up, *b_gk, *gla_norm_g, *w_out, *w_router, *b_router, *w1, *w3, *w2, *final_g;
    float* out; unsigned char* ws; int ph_lo, ph_hi;
};
typedef const __attribute__((address_space(4))) Params* CP;
#define LDSF(off) ((float*)(lds + (off)))

#define LAS __attribute__((address_space(3)))
#define XB_TMO      128
#define XB_XCNT(j)  (256  + 64 * (j))
#define XB_XSUB(j)  (1280 + 64 * (j))
#define XB_XGEN(j)  (2304 + 64 * (j))
#define XB_TOP      3328
#define XB_TOPGEN   3392
#define XCD_BAR_WORDS 3456
#define XB_SPIN_CAP (1u << 18)

__device__ __forceinline__ unsigned xb_ld(unsigned* p)              { return __hip_atomic_load(p, __ATOMIC_RELAXED, __HIP_MEMORY_SCOPE_AGENT); }
__device__ __forceinline__ unsigned xb_add(unsigned* p, unsigned v) { return __hip_atomic_fetch_add(p, v, __ATOMIC_RELAXED, __HIP_MEMORY_SCOPE_AGENT); }
__device__ __forceinline__ unsigned xb_xcc_id() { return (unsigned)__builtin_amdgcn_s_getreg((3 << 11) | 20) & 0xFu; }
#define XB_SPIN(cond, bar) do { unsigned _sp = 0; while (cond) { __builtin_amdgcn_s_sleep(1); \
    if ((++_sp & 255u) == 0u) { if (xb_ld(&(bar)[XB_TMO])) break; if (_sp > XB_SPIN_CAP) { atomicAdd(&(bar)[XB_TMO], 1u); break; } } } } while (0)

struct XcdBarrier {
    unsigned* bar; unsigned x;
    volatile LAS unsigned* st;
};

__device__ __forceinline__ XcdBarrier xcd_barrier_post(unsigned* bar, volatile LAS unsigned* st) {
    XcdBarrier b; b.bar = bar; b.x = xb_xcc_id(); b.st = st;
    if (threadIdx.x == 0) (void)xb_add(&bar[XB_XCNT(b.x)], 1u);
    return b;
}
__device__ __forceinline__ void xcd_barrier_complete(unsigned* bar, unsigned x, unsigned& nloc, unsigned& nx) {
    const unsigned G = gridDim.x * gridDim.y * gridDim.z;
    unsigned sum, cnt, mine, sp = 0u;
    for (;;) {
        sum = 0u; cnt = 0u; mine = 0u;
#pragma unroll
        for (unsigned j = 0; j < 16; ++j) { const unsigned c = xb_ld(&bar[XB_XCNT(j)]); sum += c; cnt += (c > 0u) ? 1u : 0u; mine = (j == x) ? c : mine; }
        if (sum == G) break;
        __builtin_amdgcn_s_sleep(1);
        if ((++sp & 255u) == 0u) { if (xb_ld(&bar[XB_TMO])) break; if (sp > XB_SPIN_CAP) { atomicAdd(&bar[XB_TMO], 1u); break; } }
    }
    nloc = mine > 0u ? mine : 1u; nx = cnt > 0u ? cnt : 1u;
}

__device__ __forceinline__ void xcd_barrier(const XcdBarrier& b) {
    asm volatile("s_waitcnt vmcnt(0)" ::: "memory");
    __syncthreads();
    if (threadIdx.x == 0) {
        unsigned* bar = b.bar;
        __builtin_amdgcn_s_waitcnt(0);
        unsigned nloc = b.st[0], nx = b.st[1];
        if (nloc == 0u) { xcd_barrier_complete(bar, b.x, nloc, nx); b.st[0] = nloc; b.st[1] = nx; }
        const unsigned old = xb_add(&bar[XB_XSUB(b.x)], 1u);
        const unsigned gen = old / nloc;
        if (old + 1u == (gen + 1u) * nloc) {
            __builtin_amdgcn_fence(__ATOMIC_RELEASE, "agent");
            asm volatile("s_waitcnt vmcnt(0)" ::: "memory");
            const unsigned og = xb_add(&bar[XB_TOP], 1u);
            const unsigned tg = og / nx;
            if (og + 1u == (tg + 1u) * nx) xb_add(&bar[XB_TOPGEN], 1u);
            else XB_SPIN(xb_ld(&bar[XB_TOPGEN]) == tg, bar);
            __builtin_amdgcn_fence(__ATOMIC_ACQUIRE, "agent");
            xb_add(&bar[XB_XGEN(b.x)], 1u);
            asm volatile("s_waitcnt vmcnt(0)" ::: "memory");
        } else {
            XB_SPIN(xb_ld(&bar[XB_XGEN(b.x)]) == gen, bar);
            __builtin_amdgcn_fence(__ATOMIC_ACQUIRE, "agent");
            asm volatile("s_waitcnt vmcnt(0)" ::: "memory");
        }
    }
    __syncthreads();
}

__device__ __forceinline__ void p0_transpose_item(const float* W, int K, int N, bf16* WT, int imode, float* scr, int item, int lane) {
    const int nblk = N / 32, kb = item / nblk, nb = item % nblk, k0 = 64 * kb, n0 = 32 * nb;
    const int rbase = imode == 0 ? n0 : (256 * (n0 >> 7) + (n0 & 127) + (imode == 2 ? 128 : 0));
#pragma unroll 32
    for (int i = 0; i < 32; ++i) { const int kk = 2 * i + (lane >> 5); scr[kk * 33 + (lane & 31)] = W[(size_t)(k0 + kk) * N + n0 + (lane & 31)]; }
    asm volatile("s_waitcnt lgkmcnt(0)" ::: "memory");
    const int c = lane & 7;
#pragma unroll
    for (int j = 0; j < 4; ++j) { const int n = (lane >> 3) + 8 * j; const float* s = scr + (8 * c) * 33 + n;
        u32x4 o; o.x = cvtpk(s[0 * 33], s[1 * 33]); o.y = cvtpk(s[2 * 33], s[3 * 33]); o.z = cvtpk(s[4 * 33], s[5 * 33]); o.w = cvtpk(s[6 * 33], s[7 * 33]);
        *(u32x4*)(WT + (size_t)(rbase + n) * K + k0 + 8 * c) = o; }
    asm volatile("s_waitcnt lgkmcnt(0)" ::: "memory");
}
__device__ __forceinline__ void gemv32_item(unsigned char* lds, const float* in, int ld_in, bool act, const float* W, int ldw, int N, int NP, int n0, const float* bias, float* out, int ldo, int tid, int lane, int wave) {
    float* INT = (float*)lds + wave * 4096;
    __syncthreads();
#pragma unroll 8
    for (int i = 0; i < 64; ++i) { const int idx = i * 64 + lane, b = idx >> 7, kk = idx & 127; float v = in[(size_t)b * ld_in + 128 * wave + kk]; if (act) v = siluf(v); INT[kk * 32 + b] = v; }
    asm volatile("s_waitcnt lgkmcnt(0)" ::: "memory");
    const int n = n0 + lane;
    float acc[32];
#pragma unroll
    for (int b = 0; b < 32; ++b) acc[b] = 0.f;
    if (n < N) {
        const float* wp = W + (size_t)(128 * wave) * ldw + n;
#pragma unroll 16
        for (int kk = 0; kk < 128; ++kk) { const float w = wp[(size_t)kk * ldw]; const f32x4* iv = (const f32x4*)(INT + kk * 32);
#pragma unroll
            for (int q = 0; q < 8; ++q) { const f32x4 v = iv[q]; acc[4 * q + 0] += v[0] * w; acc[4 * q + 1] += v[1] * w; acc[4 * q + 2] += v[2] * w; acc[4 * q + 3] += v[3] * w; } }
    }
    __syncthreads();
    float* RED = (float*)lds;
#pragma unroll
    for (int b = 0; b < 32; ++b) RED[(wave * 32 + b) * 64 + lane] = acc[b];
    __syncthreads();
#pragma unroll
    for (int q = 0; q < 4; ++q) { const int b = (tid >> 6) + 8 * q, col = tid & 63, nn = n0 + col; float sum = 0.f;
#pragma unroll
        for (int w = 0; w < 8; ++w) sum += RED[(w * 32 + b) * 64 + col];
        if (nn < N) out[(size_t)b * ldo + nn] = sum + (bias ? bias[nn] : 0.f); else if (nn < NP) out[(size_t)b * ldo + nn] = 0.f; }
    __syncthreads();
}
__device__ __forceinline__ void row_prep(const float* xrow, const float* sc, bf16* xs, float* rstd_out, int lane) {
    const f32x4* xr = (const f32x4*)xrow + lane; const f32x4* sr = (const f32x4*)sc + lane;
    f32x4 v[4]; float s = 0.f;
#pragma unroll
    for (int j = 0; j < 4; ++j) { v[j] = xr[64 * j]; s += (v[j][0] * v[j][0] + v[j][1] * v[j][1]) + (v[j][2] * v[j][2] + v[j][3] * v[j][3]); }
    s = wave_sum(s);
    if (lane == 0) *rstd_out = 1.0f / sqrtf(s * (1.f / 1024.f) + EPS);
    u32x2* o = (u32x2*)xs + lane;
#pragma unroll
    for (int j = 0; j < 4; ++j) { const f32x4 w = v[j] * (sr[64 * j] + 1.0f); u32x2 q; q.x = cvtpk(w[0], w[1]); q.y = cvtpk(w[2], w[3]); o[64 * j] = q; }
}

constexpr int GL_R = 0;
constexpr int GL_QT = 8192;
constexpr int GL_BL = 10240;
constexpr int GL_BC = 10752;
constexpr int GL_VT = 43520;
constexpr int GL_KDT = 61952;
constexpr int GL_QE = 61952;
constexpr int GL_KE = 80384;
constexpr int GL_OL = 98816;
constexpr int PL_UT = 0;
constexpr int PL_PL = 21760;
static_assert(GL_OL + 64 * 132 * 4 <= LDS_BYTES, "mixer LDS map");

__device__ __forceinline__ float logsig(float x) { return fminf(x, 0.f) - __logf(1.0f + __expf(-fabsf(x))); }

__device__ __forceinline__ void gla_gates(unsigned char* lds, const bf16* Z, size_t row0, const float* wup  , const float* bgk  , int h, int tid) {
    float* R = LDSF(GL_R); float* QT = LDSF(GL_QT); float* BL = LDSF(GL_BL); float* BC = LDSF(GL_BC);
    { const int tok = tid >> 3, c4 = tid & 7; const u32x2 rv = *(const u32x2*)(Z + (row0 + tok) * ZP + C_RF + 4 * c4);
      f32x4 f = {bflo(rv.x), bfhi(rv.x), bflo(rv.y), bfhi(rv.y)}; *(f32x4*)(R + ((c4 >> 2) * 64 + tok) * 16 + 4 * (c4 & 3)) = f; }
    const int dir = tid >> 8, d = tid & 63, tq = (tid >> 6) & 3;
    float wv[16];
#pragma unroll
    for (int kk = 0; kk < 16; ++kk) wv[kk] = wup[(dir * 16 + kk) * 256 + h * 64 + d];
    const float bias = bgk[dir * 256 + h * 64 + d];
    __syncthreads();
    float g[16];
#pragma unroll
    for (int j = 0; j < 16; ++j) { const f32x4* rr = (const f32x4*)(R + (dir * 64 + 16 * tq + j) * 16); float x = bias;
#pragma unroll
        for (int q = 0; q < 4; ++q) { const f32x4 r4 = rr[q]; x += r4[0] * wv[4 * q] + r4[1] * wv[4 * q + 1] + r4[2] * wv[4 * q + 2] + r4[3] * wv[4 * q + 3]; }
        g[j] = logsig(x) * 0.0625f; }
    float run = 0.f;
    if (dir == 0) {
#pragma unroll
        for (int j = 0; j < 16; ++j) { run += g[j]; g[j] = run; }
    } else {
#pragma unroll
        for (int j = 15; j >= 0; --j) { run += g[j]; g[j] = run; }
    }
    QT[(dir * 4 + tq) * 64 + d] = run;
    __syncthreads();
    float off = 0.f, tot = 0.f;
#pragma unroll
    for (int q = 0; q < 4; ++q) { const float t = QT[(dir * 4 + q) * 64 + d]; tot += t; if (dir == 0 ? (q < tq) : (q > tq)) off += t; }
#pragma unroll
    for (int j = 0; j < 16; ++j) BC[(dir * 64 + 16 * tq + j) * 64 + d] = g[j] + off;
    if (tq == 0) BL[dir * 64 + d] = tot;
    __syncthreads();
}
__device__ __forceinline__ void gla_stage_vt(unsigned char* lds, const u32x4& v0, const u32x4& v1, int tid) {
    bf16* VT = (bf16*)(lds + GL_VT); const int tok = tid >> 3, vg = tid & 7;
    const unsigned w[8] = {v0.x, v0.y, v0.z, v0.w, v1.x, v1.y, v1.z, v1.w};
#pragma unroll
    for (int j = 0; j < 8; ++j) { VT[(16 * vg + 2 * j) * 72 + tok] = (bf16)(w[j] & 0xffffu); VT[(16 * vg + 2 * j + 1) * 72 + tok] = (bf16)(w[j] >> 16); }
}
__device__ __forceinline__ void gla_stepA_unit(unsigned char* lds, CP p, int l, int unit, int tid, int lane, int wave) {
    const bf16* Z = (const bf16*)(p->ws + WS_Z); bf16* ST = (bf16*)(p->ws + WS_ST); float* DEC = (float*)(p->ws + WS_DEC);
    const int n = unit & 31, h = (unit >> 5) & 3, b = unit >> 7, bh = b * 4 + h;
    const size_t row0 = (size_t)b * SEQ + n * 64;
    const int tok = tid >> 3, dg = tid & 7;
    const u32x4 k8 = *(const u32x4*)(Z + (row0 + tok) * ZP + C_K + h * 64 + 8 * dg);
    const u32x4 va = *(const u32x4*)(Z + (row0 + tok) * ZP + C_V + h * 128 + 16 * dg), vb2 = *(const u32x4*)(Z + (row0 + tok) * ZP + C_V + h * 128 + 16 * dg + 8);
    gla_gates(lds, Z, row0, p->w_gk_up + (size_t)l * 2 * 16 * 256, p->b_gk + (size_t)l * 2 * 256, h, tid);
    const float* BL = LDSF(GL_BL); const float* BC = LDSF(GL_BC); bf16* KDT = (bf16*)(lds + GL_KDT);
    const float kf[8] = {bflo(k8.x), bfhi(k8.x), bflo(k8.y), bfhi(k8.y), bflo(k8.z), bfhi(k8.z), bflo(k8.w), bfhi(k8.w)};
#pragma unroll
    for (int dir = 0; dir < 2; ++dir) {
        const f32x4 c0 = *(const f32x4*)(BC + (dir * 64 + tok) * 64 + 8 * dg), c1 = *(const f32x4*)(BC + (dir * 64 + tok) * 64 + 8 * dg + 4);
        const f32x4 l0 = *(const f32x4*)(BL + dir * 64 + 8 * dg), l1 = *(const f32x4*)(BL + dir * 64 + 8 * dg + 4);
#pragma unroll
        for (int j = 0; j < 8; ++j) { const float bc = j < 4 ? c0[j & 3] : c1[j & 3], bl = j < 4 ? l0[j & 3] : l1[j & 3];
            KDT[(dir * 64 + 8 * dg + j) * 72 + tok] = f2bf(kf[j] * __expf(bl - bc)); }
    }
    gla_stage_vt(lds, va, vb2, tid);
    if (tid < 128) DEC[((size_t)((tid >> 6) * 128 + bh) * 32 + n) * 64 + (tid & 63)] = __expf(BL[tid]);
    __syncthreads();
    {
        const int dir = wave >> 2, vb = wave & 3, r32 = lane & 31, hi = lane >> 5;
        const bf16* VT = (const bf16*)(lds + GL_VT);
        bf16* dst = ST + ((size_t)((dir * 128 + bh) * 32 + n)) * 8192;
#pragma unroll
        for (int db = 0; db < 2; ++db) {
            f32x16 acc = {};
#pragma unroll
            for (int s = 0; s < 4; ++s) {
                const bf16x8 a = *(const bf16x8*)(VT + (32 * vb + r32) * 72 + 16 * s + 8 * hi);
                const bf16x8 bb = *(const bf16x8*)(KDT + (dir * 64 + 32 * db + r32) * 72 + 16 * s + 8 * hi);
                acc = __builtin_amdgcn_mfma_f32_32x32x16_bf16(a, bb, acc, 0, 0, 0);
            }
#pragma unroll
            for (int r = 0; r < 16; ++r) { const int v = 32 * vb + (r & 3) + 8 * (r >> 2) + 4 * hi; dst[v * 64 + 32 * db + r32] = f2bf(acc[r]); }
        }
    }
    __syncthreads();
}
__device__ __forceinline__ void mixer_store(unsigned char* lds, bf16* dstbase  , bool gla, const bf16* gbase  , const float* ng, int tid) {
    const float* OL = LDSF(GL_OL); const int tok = tid >> 3, vg = tid & 7;
    float o[16];
#pragma unroll
    for (int q = 0; q < 4; ++q) { const f32x4 t = *(const f32x4*)(OL + tok * 132 + 16 * vg + 4 * q); o[4 * q] = t[0]; o[4 * q + 1] = t[1]; o[4 * q + 2] = t[2]; o[4 * q + 3] = t[3]; }
    if (gla) {
        float ss = 0.f;
#pragma unroll
        for (int j = 0; j < 16; ++j) ss += o[j] * o[j];
        ss += __shfl_xor(ss, 1); ss += __shfl_xor(ss, 2); ss += __shfl_xor(ss, 4);
        const float rstd = 1.0f / sqrtf(ss * (1.f / 128.f) + EPS);
        const u32x4 g0 = *(const u32x4*)(gbase + (size_t)tok * ZP + 16 * vg), g1 = *(const u32x4*)(gbase + (size_t)tok * ZP + 16 * vg + 8);
        const unsigned gw[8] = {g0.x, g0.y, g0.z, g0.w, g1.x, g1.y, g1.z, g1.w};
#pragma unroll
        for (int j = 0; j < 8; ++j) { const float ga = bflo(gw[j]), gb = bfhi(gw[j]);
            o[2 * j] = o[2 * j] * rstd * ng[16 * vg + 2 * j] * siluf(ga); o[2 * j + 1] = o[2 * j + 1] * rstd * ng[16 * vg + 2 * j + 1] * siluf(gb); }
    }
    u32x4 w0, w1;
    w0.x = cvtpk(o[0], o[1]); w0.y = cvtpk(o[2], o[3]); w0.z = cvtpk(o[4], o[5]); w0.w = cvtpk(o[6], o[7]);
    w1.x = cvtpk(o[8], o[9]); w1.y = cvtpk(o[10], o[11]); w1.z = cvtpk(o[12], o[13]); w1.w = cvtpk(o[14], o[15]);
    bf16* dp = dstbase + (size_t)tok * 1024 + 16 * vg;
    *(u32x4*)dp = w0; *(u32x4*)(dp + 8) = w1;
}
__device__ __forceinline__ void gla_stepC_unit(unsigned char* lds, CP p, int l, int unit, int tid, int lane, int wave) {
    const bf16* Z = (const bf16*)(p->ws + WS_Z); const bf16* ST = (const bf16*)(p->ws + WS_ST); bf16* AB = (bf16*)(p->ws + WS_ABUF);
    const int n = unit & 31, h = (unit >> 5) & 3, b = unit >> 7, bh = b * 4 + h;
    const size_t row0 = (size_t)b * SEQ + n * 64;
    const int tok = tid >> 3, dg = tid & 7;
    const u32x4 q8 = *(const u32x4*)(Z + (row0 + tok) * ZP + C_Q + h * 64 + 8 * dg);
    const u32x4 k8 = *(const u32x4*)(Z + (row0 + tok) * ZP + C_K + h * 64 + 8 * dg);
    const u32x4 va = *(const u32x4*)(Z + (row0 + tok) * ZP + C_V + h * 128 + 16 * dg), vb2 = *(const u32x4*)(Z + (row0 + tok) * ZP + C_V + h * 128 + 16 * dg + 8);
    gla_gates(lds, Z, row0, p->w_gk_up + (size_t)l * 2 * 16 * 256, p->b_gk + (size_t)l * 2 * 256, h, tid);
    const float* BC = LDSF(GL_BC); bf16* QE = (bf16*)(lds + GL_QE); bf16* KE = (bf16*)(lds + GL_KE);
    const float qf[8] = {bflo(q8.x), bfhi(q8.x), bflo(q8.y), bfhi(q8.y), bflo(q8.z), bfhi(q8.z), bflo(q8.w), bfhi(q8.w)};
    const float kf[8] = {bflo(k8.x), bfhi(k8.x), bflo(k8.y), bfhi(k8.y), bflo(k8.z), bfhi(k8.z), bflo(k8.w), bfhi(k8.w)};
#pragma unroll
    for (int dir = 0; dir < 2; ++dir) {
        const f32x4 c0 = *(const f32x4*)(BC + (dir * 64 + tok) * 64 + 8 * dg), c1 = *(const f32x4*)(BC + (dir * 64 + tok) * 64 + 8 * dg + 4);
        float qe[8], ke[8];
#pragma unroll
        for (int j = 0; j < 8; ++j) { const float bc = j < 4 ? c0[j & 3] : c1[j & 3]; const float e = __expf(bc); qe[j] = qf[j] * e * 0.125f; ke[j] = kf[j] * __expf(-bc); }
        u32x4 wq, wk;
        wq.x = cvtpk(qe[0], qe[1]); wq.y = cvtpk(qe[2], qe[3]); wq.z = cvtpk(qe[4], qe[5]); wq.w = cvtpk(qe[6], qe[7]);
        wk.x = cvtpk(ke[0], ke[1]); wk.y = cvtpk(ke[2], ke[3]); wk.z = cvtpk(ke[4], ke[5]); wk.w = cvtpk(ke[6], ke[7]);
        *(u32x4*)(QE + (dir * 64 + tok) * 72 + 8 * dg) = wq; *(u32x4*)(KE + (dir * 64 + tok) * 72 + 8 * dg) = wk;
    }
    gla_stage_vt(lds, va, vb2, tid);
    __syncthreads();
    {
        const int ib = wave >> 2, vb = wave & 3, r32 = lane & 31, hi = lane >> 5;
        const bf16* VT = (const bf16*)(lds + GL_VT);
        f32x16 o = {};
#pragma unroll
        for (int dir = 0; dir < 2; ++dir) {
            bf16x8 qfr[4];
#pragma unroll
            for (int s = 0; s < 4; ++s) qfr[s] = *(const bf16x8*)(QE + (dir * 64 + 32 * ib + r32) * 72 + 16 * s + 8 * hi);
            const bf16* Sg = ST + ((size_t)((dir * 128 + bh) * 32 + n)) * 8192 + (size_t)(32 * vb + r32) * 64 + 8 * hi;
#pragma unroll
            for (int s = 0; s < 4; ++s) { const bf16x8 sf = *(const bf16x8*)(Sg + 16 * s); o = __builtin_amdgcn_mfma_f32_32x32x16_bf16(qfr[s], sf, o, 0, 0, 0); }
#pragma unroll
            for (int jb = 0; jb < 2; ++jb) {
                f32x16 x = {};
#pragma unroll
                for (int s = 0; s < 4; ++s) { const bf16x8 a = *(const bf16x8*)(KE + (dir * 64 + 32 * jb + r32) * 72 + 16 * s + 8 * hi); x = __builtin_amdgcn_mfma_f32_32x32x16_bf16(a, qfr[s], x, 0, 0, 0); }
                const int i = 32 * ib + r32;
#pragma unroll
                for (int r = 0; r < 16; ++r) { const int j = 32 * jb + (r & 3) + 8 * (r >> 2) + 4 * hi; const bool keep = dir == 0 ? (j <= i) : (j > i); if (!keep) x[r] = 0.f; }
#pragma unroll
                for (int s2 = 0; s2 < 2; ++s2) {
                    u32x4 pa; pa.x = cvtpk(x[8 * s2], x[8 * s2 + 1]); pa.y = cvtpk(x[8 * s2 + 2], x[8 * s2 + 3]); pa.z = cvtpk(x[8 * s2 + 4], x[8 * s2 + 5]); pa.w = cvtpk(x[8 * s2 + 6], x[8 * s2 + 7]);
                    const bf16* vp = VT + (32 * vb + r32) * 72 + 32 * jb + 16 * s2 + 4 * hi;
                    const u32x2 b0 = *(const u32x2*)vp, b1 = *(const u32x2*)(vp + 8);
                    u32x4 pb; pb.x = b0.x; pb.y = b0.y; pb.z = b1.x; pb.w = b1.y;
                    o = __builtin_amdgcn_mfma_f32_32x32x16_bf16(__builtin_bit_cast(bf16x8, pa), __builtin_bit_cast(bf16x8, pb), o, 0, 0, 0);
                }
            }
        }
        float* OL = LDSF(GL_OL);
#pragma unroll
        for (int r = 0; r < 16; ++r) OL[(32 * ib + (r & 3) + 8 * (r >> 2) + 4 * hi) * 132 + 32 * vb + r32] = o[r];
    }
    __syncthreads();
    mixer_store(lds, AB + row0 * 1024 + 512 + h * 128, true, Z + row0 * ZP + C_G + h * 128, p->gla_norm_g + l * 128, tid);
    __syncthreads();
}
__device__ __forceinline__ void pool_unit(unsigned char* lds, CP p, int l, int unit, int tid, int lane, int wave) {
    const bf16* Z = (const bf16*)(p->ws + WS_Z); bf16* AB = (bf16*)(p->ws + WS_ABUF); const bf16* WPT = (const bf16*)(p->ws + WS_WPT);
    const int g = unit & 3, tt = (unit >> 2) & 31, b = unit >> 7, t0 = tt * 64;
    bf16* UT = (bf16*)(lds + PL_UT); bf16* PL = (bf16*)(lds + PL_PL);
    for (int idx = tid; idx < 80 * 16; idx += 512) { const int rr = idx >> 4, ch = idx & 15, t = t0 - 8 + rr;
        u32x4 v = {0u, 0u, 0u, 0u}; if (t >= 0 && t < SEQ) v = *(const u32x4*)(Z + ((size_t)b * SEQ + t) * ZP + g * 128 + 8 * ch);
        *(u32x4*)(UT + rr * 136 + 8 * ch) = v; }
    __syncthreads();
    { const int c = tid & 127, tq = tid >> 7, w = 2 << g, half = w >> 1;
#define U(rr) __uint_as_float(((unsigned)UT[(rr) * 136 + c]) << 16)
      int t = t0 + 16 * tq; float s = 0.f;
      for (int j = 0; j < w; ++j) s += U(t - half + j - t0 + 8);
      for (int j = 0; j < 16; ++j, ++t) {
          const int lo = max(t - half, 0), hi = min(t - half + w - 1, SEQ - 1);
          const float pooled = s / (float)(hi - lo + 1) - U(t - t0 + 8);
          PL[(16 * tq + j) * 136 + c] = f2bf(pooled);
          s += U(t + 1 - half + w - 1 - t0 + 8) - U(t - half - t0 + 8);
      }
#undef U
    }
    __syncthreads();
    { const int ib = wave >> 2, nb = wave & 3, r32 = lane & 31, hi = lane >> 5;
      const bf16* wp = WPT + ((size_t)(l * 4 + g) * 128 + 32 * nb + r32) * 128 + 8 * hi;
      f32x16 acc = {};
#pragma unroll
      for (int s = 0; s < 8; ++s) { const bf16x8 a = *(const bf16x8*)(PL + (32 * ib + r32) * 136 + 16 * s + 8 * hi); const bf16x8 bb = *(const bf16x8*)(wp + 16 * s);
          acc = __builtin_amdgcn_mfma_f32_32x32x16_bf16(a, bb, acc, 0, 0, 0); }
      const float sc = p->pool_scale[l * 512 + g * 128 + 32 * nb + r32];
      float* OL = LDSF(GL_OL);
#pragma unroll
      for (int r = 0; r < 16; ++r) OL[(32 * ib + (r & 3) + 8 * (r >> 2) + 4 * hi) * 132 + 32 * nb + r32] = acc[r] * sc; }
    __syncthreads();
    mixer_store(lds, AB + ((size_t)b * SEQ + t0) * 1024 + g * 128, false, nullptr, nullptr, tid);
    __syncthreads();
}

__device__ __forceinline__ void gla_scan(CP p, int gtid, int gthreads) {
    bf16* ST = (bf16*)(p->ws + WS_ST); const float* DEC = (const float*)(p->ws + WS_DEC);
    for (int ch = gtid; ch < 2 * 128 * 1024; ch += gthreads) {
        const int eg = ch & 1023, dbh = ch >> 10, dir = dbh >> 7;
        bf16* base = ST + (size_t)dbh * 32 * 8192 + 8 * eg; const float* dbase = DEC + (size_t)dbh * 32 * 64 + ((8 * eg) & 63);
        float s[8];
#pragma unroll
        for (int j = 0; j < 8; ++j) s[j] = 0.f;
#pragma unroll 4
        for (int it = 0; it < 32; ++it) {
            const int n = dir == 0 ? it : 31 - it;
            const u32x4 u = *(const u32x4*)(base + (size_t)n * 8192);
            const f32x4 d0 = *(const f32x4*)(dbase + n * 64), d1 = *(const f32x4*)(dbase + n * 64 + 4);
            u32x4 o; o.x = cvtpk(s[0], s[1]); o.y = cvtpk(s[2], s[3]); o.z = cvtpk(s[4], s[5]); o.w = cvtpk(s[6], s[7]);
            *(u32x4*)(base + (size_t)n * 8192) = o;
            s[0] = d0[0] * s[0] + bflo(u.x); s[1] = d0[1] * s[1] + bfhi(u.x); s[2] = d0[2] * s[2] + bflo(u.y); s[3] = d0[3] * s[3] + bfhi(u.y);
            s[4] = d1[0] * s[4] + bflo(u.z); s[5] = d1[1] * s[5] + bfhi(u.z); s[6] = d1[2] * s[6] + bflo(u.w); s[7] = d1[3] * s[7] + bfhi(u.w);
        }
    }
}

constexpr int RT_XS = 0;
constexpr int RT_H = 69632;
__device__ __forceinline__ void router_tile(unsigned char* lds, CP p, int l, int tile, int tid, int lane, int wave) {
    const float* X1 = p->out; const float* ROWSQ = (const float*)(p->ws + WS_ROWSQ); bf16* AB = (bf16*)(p->ws + WS_ABUF);
    int* CNT = (int*)(p->ws + WS_CTL) + 64 + l * 64; int* TOK = (int*)(p->ws + WS_TOK); float* GWL = (float*)(p->ws + WS_GWL);
    float* XS = LDSF(RT_XS + wave * 8704); int* H = (int*)(lds + RT_H); int* HB = H + 32;
    if (tid < 32) H[tid] = 0;
    const int tb = tile * 256 + wave * 32, b = tb >> 11;
    const float* sc2 = (const float*)(p->ws + WS_MOD) + ((size_t)(l * 32 + b) * 6144) + 4 * 1024; const float* sh2 = sc2 - 1024;
    const int rsub = lane >> 4, c4 = lane & 15, r32 = lane & 31, hi = lane >> 5;
    float rs[8];
#pragma unroll
    for (int it = 0; it < 8; ++it) { const f32x4* q = (const f32x4*)(ROWSQ + (size_t)(tb + 4 * it + rsub) * 16); const f32x4 a = q[0], bq = q[1], c = q[2], d = q[3];
        const float s = ((a[0] + a[1]) + (a[2] + a[3])) + ((bq[0] + bq[1]) + (bq[2] + bq[3])) + ((c[0] + c[1]) + (c[2] + c[3])) + ((d[0] + d[1]) + (d[2] + d[3]));
        rs[it] = 1.0f / sqrtf(s * (1.f / 1024.f) + EPS); }
    f32x16 acc = {};
    for (int k0 = 0; k0 < 1024; k0 += 64) {
        const f32x4 scv = *(const f32x4*)(sc2 + k0 + 4 * c4) + 1.0f, shv = *(const f32x4*)(sh2 + k0 + 4 * c4);
#pragma unroll
        for (int it = 0; it < 8; ++it) { const int row = 4 * it + rsub; const f32x4 xv = *(const f32x4*)(X1 + (size_t)(tb + row) * 1024 + k0 + 4 * c4);
            const f32x4 hv = xv * rs[it] * scv + shv; *(f32x4*)(XS + row * 68 + 4 * c4) = hv;
            u32x2 w; w.x = cvtpk(hv[0], hv[1]); w.y = cvtpk(hv[2], hv[3]); *(u32x2*)(AB + (size_t)(tb + row) * 1024 + k0 + 4 * c4) = w; }
        asm volatile("s_waitcnt lgkmcnt(0)" ::: "memory");
#pragma unroll
        for (int q = 0; q < 8; ++q) { const f32x4 av = *(const f32x4*)(XS + r32 * 68 + 8 * q + 4 * hi);
#pragma unroll
            for (int j = 0; j < 4; ++j) { const float bw = p->w_router[(size_t)(k0 + 8 * q + 4 * hi + j) * 32 + r32]; acc = __builtin_amdgcn_mfma_f32_32x32x2f32(av[j], bw, acc, 0, 0, 0); } }
        asm volatile("s_waitcnt lgkmcnt(0)" ::: "memory");
    }
#pragma unroll
    for (int r = 0; r < 16; ++r) XS[((r & 3) + 8 * (r >> 2) + 4 * hi) * 33 + r32] = acc[r];
    asm volatile("s_waitcnt lgkmcnt(0)" ::: "memory");
    int e1 = 0, e2 = 0, rk1 = 0, rk2 = 0; float gw1 = 0.f, gw2 = 0.f;
    if (lane < 32) {
        float s[32], sel[32];
#pragma unroll
        for (int e = 0; e < 32; ++e) { const float lg = XS[lane * 33 + e]; s[e] = 1.0f / (1.0f + __expf(-lg)); sel[e] = s[e] + p->b_router[e]; }
        float best = 0.f; int gi = 0;
#pragma unroll
        for (int g = 0; g < 4; ++g) { float m1 = -INFINITY, m2 = -INFINITY;
#pragma unroll
            for (int j = 0; j < 8; ++j) { const float v = sel[8 * g + j]; if (v > m1) { m2 = m1; m1 = v; } else if (v > m2) m2 = v; }
            const float gs = m1 + m2; if (g == 0 || gs > best) { best = gs; gi = g; } }
        float ig[8], sg[8];
#pragma unroll
        for (int j = 0; j < 8; ++j) { ig[j] = gi == 0 ? sel[j] : gi == 1 ? sel[8 + j] : gi == 2 ? sel[16 + j] : sel[24 + j]; sg[j] = gi == 0 ? s[j] : gi == 1 ? s[8 + j] : gi == 2 ? s[16 + j] : s[24 + j]; }
        int l1 = 0; float v1 = ig[0], w1 = sg[0];
#pragma unroll
        for (int j = 1; j < 8; ++j) if (ig[j] > v1) { v1 = ig[j]; l1 = j; w1 = sg[j]; }
        int l2 = l1 ^ 1; float v2 = -INFINITY, w2 = 0.f;
#pragma unroll
        for (int j = 0; j < 8; ++j) if (j != l1 && (ig[j] > v2 || (j == (l1 ^ 1) && v2 == -INFINITY))) { v2 = ig[j]; l2 = j; w2 = sg[j]; }
        e1 = 8 * gi + l1; e2 = 8 * gi + l2; const float inv = 1.0f / (w1 + w2); gw1 = w1 * inv; gw2 = w2 * inv;
    }
    __syncthreads();
    if (lane < 32) { rk1 = atomicAdd(&H[e1], 1); rk2 = atomicAdd(&H[e2], 1); }
    __syncthreads();
    if (tid < 32) HB[tid] = atomicAdd(&CNT[tid], H[tid]);
    __syncthreads();
    if (lane < 32) { const int t = tb + lane; const int p1 = HB[e1] + rk1, p2 = HB[e2] + rk2;
        TOK[e1 * 65536 + p1] = 2 * t; GWL[e1 * 65536 + p1] = gw1; TOK[e2 * 65536 + p2] = 2 * t + 1; GWL[e2 * 65536 + p2] = gw2; }
    __syncthreads();
}
__device__ __forceinline__ void moe_tables(unsigned char* lds, CP p, int l, int tid) {
    int* tab = (int*)(lds + LDS_SPARE); const int* CNT = (const int*)(p->ws + WS_CTL) + 64 + l * 64;
    __syncthreads();
    if (tid == 0) { int acc = 0;
#pragma unroll 1
        for (int e = 0; e < 32; ++e) { const int c = CNT[e]; tab[2 + e] = acc; tab[34 + e] = c; acc += (c + 255) >> 8; } tab[0] = acc; tab[1] = (acc + 7) & ~7; }
    __syncthreads();
    const int Rt = tab[0];
    for (int rt = tid; rt < Rt; rt += 512) { int e = 0;
#pragma unroll 1
        for (int q = 1; q < 32; ++q) if (tab[2 + q] <= rt) e = q;
        tab[128 + rt] = e; }
    __syncthreads();
}
__device__ __forceinline__ void moe_permute(unsigned char* lds, CP p, int gw, int NGW, int lane) {
    const int* tab = (const int*)(lds + LDS_SPARE); const int* TOK = (const int*)(p->ws + WS_TOK);
    const bf16* AB = (const bf16*)(p->ws + WS_ABUF); bf16* HS = (bf16*)(p->ws + WS_HS);
    const int nslots = tab[0] * 256;
    for (int s = gw; s < nslots; s += NGW) {
        const int rt = s >> 8, e = tab[128 + rt], pos = s - tab[2 + e] * 256;
        if (pos < tab[34 + e]) { const int t = TOK[e * 65536 + pos] >> 1;
            const u32x4* src = (const u32x4*)(AB + (size_t)t * 1024) + lane; u32x4* dst = (u32x4*)(HS + (size_t)s * 1024) + lane;
            const u32x4 a = src[0], bq = src[64]; dst[0] = a; dst[64] = bq; }
    }
}
__device__ __forceinline__ void combine_row(CP p, int l, int t, int lane) {
    const float* mod = (const float*)(p->ws + WS_MOD) + (size_t)(l * 32 + (t >> 11)) * 6144;
    const bf16* Y2 = (const bf16*)(p->ws + WS_Y2) + (size_t)t * 2048;
    f32x4* xr = (f32x4*)(p->out + (size_t)t * 1024) + lane; const f32x4* g2 = (const f32x4*)(mod + 5 * 1024) + lane;
    f32x4 v[4]; float s = 0.f;
#pragma unroll
    for (int j = 0; j < 4; ++j) { const u32x2 y0 = ((const u32x2*)Y2)[lane + 64 * j], y1 = ((const u32x2*)(Y2 + 1024))[lane + 64 * j];
        f32x4 ys = {bflo(y0.x) + bflo(y1.x), bfhi(y0.x) + bfhi(y1.x), bflo(y0.y) + bflo(y1.y), bfhi(y0.y) + bfhi(y1.y)};
        if (!((MK_MASK >> 10) & 1)) ys = (f32x4){0.f, 0.f, 0.f, 0.f};
        v[j] = xr[64 * j] + g2[64 * j] * ys; s += (v[j][0] * v[j][0] + v[j][1] * v[j][1]) + (v[j][2] * v[j][2] + v[j][3] * v[j][3]); }
    s = wave_sum(s);
    const float rstd = 1.0f / sqrtf(s * (1.f / 1024.f) + EPS);
    if (l + 1 < DEPTH) {
        const f32x4* sc = (const f32x4*)((const float*)(p->ws + WS_MOD) + (size_t)((l + 1) * 32 + (t >> 11)) * 6144 + 1024) + lane;
        u32x2* o = (u32x2*)((bf16*)(p->ws + WS_ABUF) + (size_t)t * 1024) + lane;
#pragma unroll
        for (int j = 0; j < 4; ++j) { xr[64 * j] = v[j]; const f32x4 w = v[j] * (sc[64 * j] + 1.0f); u32x2 q; q.x = cvtpk(w[0], w[1]); q.y = cvtpk(w[2], w[3]); o[64 * j] = q; }
        if (lane == 0) ((float*)(p->ws + WS_RSTD))[t] = rstd;
    } else {
        const f32x4* fg = (const f32x4*)p->final_g + lane;
#pragma unroll
        for (int j = 0; j < 4; ++j) xr[64 * j] = v[j] * rstd * fg[64 * j];
    }
}

#define PHASE_ENTER \
        CP p = (CP)__builtin_amdgcn_kernarg_segment_ptr(); asm volatile("" : "+s"(p)); \
        int tid = threadIdx.x; asm volatile("" : "+v"(tid)); \
        const int lane = tid & 63, wave = __builtin_amdgcn_readfirstlane(tid >> 6); \
        int G = gridDim.x, bx = blockIdx.x; asm volatile("" : "+s"(G), "+s"(bx)); \
        const int vcu = (G % 8 == 0) ? (bx % 8) * (G / 8) + bx / 8 : bx; \
        const int gw = vcu * 8 + wave, NGW = G * 8; \
        unsigned char* ws = p->ws; float* MOD = (float*)(ws + WS_MOD); \
        (void)lane; (void)wave; (void)gw; (void)NGW; (void)MOD; (void)vcu;

constexpr int NPHASE = 2 + 10 * DEPTH;
__global__ void __launch_bounds__(512, 2) fwd_kernel(Params p0) {
    extern __shared__ __attribute__((aligned(16))) unsigned char lds[];
    cg::grid_group grid = cg::this_grid();
    if (threadIdx.x < 2) ((LAS unsigned*)(lds + LDS_BYTES - 64))[threadIdx.x] = 0u;
    __syncthreads();
    const XcdBarrier bar = xcd_barrier_post((unsigned*)(p0.ws + WS_CTL) + 4096, (volatile LAS unsigned*)(lds + LDS_BYTES - 64));
#pragma unroll 1
    for (int ph = p0.ph_lo; ph < p0.ph_hi; ++ph) {
        const int l = ph < 2 ? 0 : (ph - 2) / 10, cls = ph < 2 ? ph : 2 + (ph - 2) % 10;
        const int nrep = (((MK_REP >> cls) & 1) && !(cls == 6 && l == 1)) ? 2 : 1;
#pragma unroll 1
        for (int rep = 0; rep < nrep; ++rep)
        switch (cls) {
        case 0: if ((MK_MASK >> 0) & 1) { PHASE_ENTER
            if (vcu < 192) { const int l2 = vcu / 96, n0 = (vcu % 96) * 64;
                gemv32_item(lds, p->c, 1024, true, p->w_mod + (size_t)l2 * 1024 * 6144, 6144, 6144, 6144, n0, p->b_mod + l2 * 6144, MOD + (size_t)l2 * 32 * 6144, 6144, tid, lane, wave); }
            { u32x4* z = (u32x4*)(ws + WS_WIN); const u32x4 zero = {0u, 0u, 0u, 0u};
              for (int i = bx * 512 + tid; i < 2 * 224 * 128; i += G * 512) { const int l2 = i / (224 * 128), r = i % (224 * 128); z[(size_t)l2 * 2304 * 128 + 2080 * 128 + r] = zero; } }
            float* scr = (float*)(lds + wave * 16384);
            constexpr int I_IN = 16 * 65, I_OUT = 16 * 32, I_PL = 8, I_W1 = 16 * 16, I_W2 = 8 * 32;
            constexpr int N_IN = 2 * I_IN, N_OUT = 2 * I_OUT, N_PL = 8 * I_PL, N_W1 = 64 * I_W1, N_W2 = 64 * I_W2;
            for (int it = gw; it < N_IN + N_OUT + N_PL + 2 * N_W1 + N_W2; it += NGW) {
                int r = it;
                if (r < N_IN) { const int l2 = r / I_IN; p0_transpose_item(p->w_in + (size_t)l2 * 1024 * DIN, 1024, DIN, (bf16*)(ws + WS_WIN) + (size_t)l2 * ZP * 1024, 0, scr, r % I_IN, lane); continue; } r -= N_IN;
                if (r < N_OUT) { const int l2 = r / I_OUT; p0_transpose_item(p->w_out + (size_t)l2 * 1024 * 1024, 1024, 1024, (bf16*)(ws + WS_WOUT) + (size_t)l2 * 1024 * 1024, 0, scr, r % I_OUT, lane); continue; } r -= N_OUT;
                if (r < N_PL) { const int lg = r / I_PL; p0_transpose_item(p->w_pool + (size_t)lg * 128 * 128, 128, 128, (bf16*)(ws + WS_WPT) + (size_t)lg * 128 * 128, 0, scr, r % I_PL, lane); continue; } r -= N_PL;
                if (r < N_W1) { const int le = r / I_W1; p0_transpose_item(p->w1 + (size_t)le * 1024 * 512, 1024, 512, (bf16*)(ws + WS_W13) + (size_t)le * 1024 * 1024, 1, scr, r % I_W1, lane); continue; } r -= N_W1;
                if (r < N_W1) { const int le = r / I_W1; p0_transpose_item(p->w3 + (size_t)le * 1024 * 512, 1024, 512, (bf16*)(ws + WS_W13) + (size_t)le * 1024 * 1024, 2, scr, r % I_W1, lane); continue; } r -= N_W1;
                { const int le = r / I_W2; p0_transpose_item(p->w2 + (size_t)le * 512 * 1024, 512, 1024, (bf16*)(ws + WS_W2) + (size_t)le * 1024 * 512, 0, scr, r % I_W2, lane); }
            }
        } break;
        case 1: if ((MK_MASK >> 1) & 1) { PHASE_ENTER
            if (vcu < 72) { const int l2 = vcu / 36, n0 = (vcu % 36) * 64;
                gemv32_item(lds, MOD + (size_t)l2 * 32 * 6144, 6144, false, p->w_in + (size_t)l2 * 1024 * DIN, DIN, DIN, ZP, n0, nullptr, (float*)(ws + WS_BIASIN) + (size_t)l2 * 32 * ZP, ZP, tid, lane, wave); }
            for (int t = gw; t < T; t += NGW) row_prep(p->x + (size_t)t * 1024, MOD + (size_t)(t >> 11) * 6144 + 1024, (bf16*)(ws + WS_ABUF) + (size_t)t * 1024, (float*)(ws + WS_RSTD) + t, lane);
        } break;
        case 2: if ((MK_MASK >> 2) & 1) { PHASE_ENTER
            pg8::Gemm g{(const bf16*)(ws + WS_ABUF), (const bf16*)(ws + WS_WIN) + (size_t)l * ZP * 1024, T, ZP, 1024}; pg8::StaticOrder S; S.init(T, ZP, G, bx);
            pg8::EpiZ E{(bf16*)(ws + WS_Z), (const float*)(ws + WS_RSTD), (const float*)(ws + WS_BIASIN) + (size_t)l * 32 * ZP, ZP};
            pg8::gemm_phase<pg8::EpiZ, pg8::StaticOrder, true, true>((PG8_LAS unsigned char*)lds, g, S, E);
        } break;
        case 3: if ((MK_MASK >> 3) & 1) { PHASE_ENTER
            for (int u = vcu; u < 8192; u += G) { if (u < 4096) gla_stepA_unit(lds, p, l, u, tid, lane, wave); else pool_unit(lds, p, l, u - 4096, tid, lane, wave); }
        } break;
        case 4: if ((MK_MASK >> 4) & 1) { PHASE_ENTER gla_scan(p, vcu * 512 + tid, G * 512); } break;
        case 5: if ((MK_MASK >> 5) & 1) { PHASE_ENTER for (int u = vcu; u < 4096; u += G) gla_stepC_unit(lds, p, l, u, tid, lane, wave); } break;
        case 6: if ((MK_MASK >> 6) & 1) { PHASE_ENTER
            pg8::Gemm g{(const bf16*)(ws + WS_ABUF), (const bf16*)(ws + WS_WOUT) + (size_t)l * 1024 * 1024, T, 1024, 1024}; pg8::StaticOrder S; S.init(T, 1024, G, bx);
            pg8::EpiRes E{l == 0 ? p->x : p->out, p->out, MOD + (size_t)l * 32 * 6144 + 2 * 1024, (float*)(ws + WS_ROWSQ)};
            pg8::gemm_phase<pg8::EpiRes, pg8::StaticOrder, true, true>((PG8_LAS unsigned char*)lds, g, S, E);
        } break;
        case 7: if ((MK_MASK >> 7) & 1) { PHASE_ENTER for (int tile = vcu; tile < T / 256; tile += G) router_tile(lds, p, l, tile, tid, lane, wave); } break;
        case 8: if ((MK_MASK >> 8) & 1) { PHASE_ENTER moe_tables(lds, p, l, tid); moe_permute(lds, p, gw, NGW, lane); } break;
        case 9: if ((MK_MASK >> 9) & 1) { PHASE_ENTER
            moe_tables(lds, p, l, tid);
            pg8::Gemm g{(const bf16*)(ws + WS_HS), (const bf16*)(ws + WS_W13) + (size_t)l * 32 * 1024 * 1024, HS_ROWS, 32 * 1024, 1024};
            pg8::MoeOrder S{(const PG8_LAS int*)(lds + LDS_SPARE), G, bx}; pg8::EpiAct E{(bf16*)(ws + WS_ACT)};
            pg8::gemm_phase<pg8::EpiAct, pg8::MoeOrder, true, true>((PG8_LAS unsigned char*)lds, g, S, E);
        } break;
        case 10: if ((MK_MASK >> 10) & 1) { PHASE_ENTER
            moe_tables(lds, p, l, tid);
            pg8::Gemm g{(const bf16*)(ws + WS_ACT), (const bf16*)(ws + WS_W2) + (size_t)l * 32 * 1024 * 512, HS_ROWS, 32 * 1024, 512};
            pg8::MoeOrder S{(const PG8_LAS int*)(lds + LDS_SPARE), G, bx};
            pg8::EpiY E{(bf16*)(ws + WS_Y2), (const int*)(ws + WS_TOK), (const float*)(ws + WS_GWL), (const int*)(ws + WS_CTL) + 64 + l * 64};
            pg8::gemm_phase<pg8::EpiY, pg8::MoeOrder, true, true>((PG8_LAS unsigned char*)lds, g, S, E);
        } break;
        default: if ((MK_MASK >> 11) & 1) { PHASE_ENTER for (int t = gw; t < T; t += NGW) combine_row(p, l, t, lane); } break;
        }
        if (ph + 1 < p0.ph_hi) { if (ph == 0) grid.sync(); else xcd_barrier(bar); }
    }
}

extern "C" void kernel_launch(void* const* d_in, const int* in_sizes, int n_in, void* d_out, int out_size, void* d_ws, size_t ws_size, hipStream_t stream) {
    static int grid = 0;
    if (grid == 0) {
        if (n_in != 17 || out_size != T * DM || ws_size < WS_END) { fprintf(stderr, "kernel_launch: unexpected shapes: n_in %d out %d ws %zu (need %zu)\n", n_in, out_size, ws_size, (size_t)WS_END); grid = -1; return; }
        int dev = 0, cus = 0, per_cu = 0;
        (void)hipGetDevice(&dev); (void)hipDeviceGetAttribute(&cus, hipDeviceAttributeMultiprocessorCount, dev);
        (void)hipFuncSetAttribute((const void*)fwd_kernel, hipFuncAttributeMaxDynamicSharedMemorySize, LDS_BYTES);
        (void)hipOccupancyMaxActiveBlocksPerMultiprocessor(&per_cu, (const void*)fwd_kernel, 512, LDS_BYTES);
        if (per_cu < 1) { fprintf(stderr, "kernel_launch: occupancy query says %d blocks per CU\n", per_cu); grid = -1; return; }
        grid = cus;
    }
    if (grid < 0) return;
    (void)hipMemsetAsync((char*)d_ws + WS_CTL, 0, 1 * MiB, stream);
    Params p{};
    const float** pp = (const float**)&p;
    for (int i = 0; i < 17; ++i) pp[i] = (const float*)d_in[i];
    p.out = (float*)d_out; p.ws = (unsigned char*)d_ws;
#if MK_MULTI
    for (int k = 0; k < NPHASE; ++k) { p.ph_lo = k; p.ph_hi = k + 1; void* args[] = {&p};
        hipError_t e = hipLaunchCooperativeKernel((const void*)fwd_kernel, dim3(grid), dim3(512), args, LDS_BYTES, stream);
        if (e != hipSuccess) { fprintf(stderr, "launch of phase %d failed: %s\n", k, hipGetErrorString(e)); break; } }
#else
    p.ph_lo = 0; p.ph_hi = NPHASE; void* args[] = {&p};
    hipError_t e = hipLaunchCooperativeKernel((const void*)fwd_kernel, dim3(grid), dim3(512), args, LDS_BYTES, stream);
    if (e != hipSuccess) fprintf(stderr, "cooperative launch failed: %s (grid %d)\n", hipGetErrorString(e), grid);
#endif
}
```

```cpp
#include <hip/hip_runtime.h>
#include <hip/hip_cooperative_groups.h>
#include <cstdio>
#include <cstdint>
namespace cg = cooperative_groups;

#ifndef MK_MASK
#define MK_MASK 0xFFF
#endif
#ifndef MK_REP
#define MK_REP 0
#endif
#ifndef MK_DIL
#define MK_DIL 0
#endif
#ifndef MK_POOL2
#define MK_POOL2 0
#endif
#ifndef MK_MULTI
#define MK_MULTI 0
#endif

constexpr int DM = 1024, NB = 32, SEQ = 2048, T = NB * SEQ, DEPTH = 2;
constexpr int DIN = 2080, ZP = 2304;
constexpr int C_Q = 512, C_K = 768, C_V = 1024, C_G = 1536, C_RF = 2048;
constexpr int NE = 32, DFF = 512;
constexpr int HS_ROWS = 139264;
constexpr float EPS = 1e-6f;

constexpr size_t MiB = 1u << 20;
constexpr size_t WS_CTL = 0;
constexpr size_t WS_MOD = 1 * MiB;
constexpr size_t WS_BIASIN = 3 * MiB;
constexpr size_t WS_RSTD = 4 * MiB;
constexpr size_t WS_ROWSQ = 5 * MiB;
constexpr size_t WS_DEC = 9 * MiB;
constexpr size_t WS_TOK = 11 * MiB;
constexpr size_t WS_GWL = 19 * MiB;
constexpr size_t WS_WPT = 28 * MiB;
constexpr size_t WS_WOUT = 29 * MiB;
constexpr size_t WS_WIN = 33 * MiB;
constexpr size_t WS_W2 = 42 * MiB;
constexpr size_t WS_W13 = 106 * MiB;
constexpr size_t WS_ABUF = 234 * MiB;
constexpr size_t WS_R = 362 * MiB;
constexpr size_t WS_Z = WS_R;
constexpr size_t WS_ST = WS_R + 288 * MiB;
constexpr size_t WS_HS = WS_R;
constexpr size_t WS_Y2 = WS_R;
constexpr size_t WS_ACT = WS_R + 272 * MiB;
constexpr size_t WS_BCG = WS_R + 416 * MiB;
constexpr size_t WS_XB = WS_R + 480 * MiB;
constexpr size_t WS_END = WS_R + 608 * MiB;
constexpr int LDS_BYTES = 147456;
constexpr int LDS_SPARE = 131072;

typedef unsigned short bf16;
typedef float f32x4 __attribute__((ext_vector_type(4)));
typedef float f32x16 __attribute__((ext_vector_type(16)));
typedef short bf16x8 __attribute__((ext_vector_type(8)));
typedef unsigned u32x4 __attribute__((ext_vector_type(4)));
typedef unsigned u32x2 __attribute__((ext_vector_type(2)));
typedef float f32x2_t __attribute__((ext_vector_type(2)));
typedef __bf16 bf16x2_t __attribute__((ext_vector_type(2)));

__device__ __forceinline__ unsigned cvtpk(float lo, float hi) { f32x2_t v = {lo, hi}; bf16x2_t b = __builtin_convertvector(v, bf16x2_t); return __builtin_bit_cast(unsigned, b); }
__device__ __forceinline__ unsigned short f2bf(float f) { return (unsigned short)(cvtpk(f, 0.f) & 0xffffu); }
__device__ __forceinline__ float bflo(unsigned u) { return __uint_as_float(u << 16); }
__device__ __forceinline__ float bfhi(unsigned u) { return __uint_as_float(u & 0xffff0000u); }
__device__ __forceinline__ float siluf(float x) { return x * __builtin_amdgcn_rcpf(1.0f + __expf(-x)); }
__device__ __forceinline__ float wave_sum(float v) {
#pragma unroll
    for (int o = 1; o < 64; o <<= 1) v += __shfl_xor(v, o);
    return v;
}

namespace pg8 {
#define PG8_LAS __attribute__((address_space(3)))
typedef unsigned short bf16_t;
typedef short bf16x8 __attribute__((ext_vector_type(8)));
typedef float f32x4 __attribute__((ext_vector_type(4)));
typedef unsigned u32x4 __attribute__((ext_vector_type(4)));
typedef int v8i_t __attribute__((ext_vector_type(8)));
typedef int v4i_t __attribute__((ext_vector_type(4)));
__device__ __forceinline__ v8i_t cat8(bf16x8 a, bf16x8 b) { return __builtin_shufflevector(__builtin_bit_cast(v4i_t, a), __builtin_bit_cast(v4i_t, b), 0, 1, 2, 3, 4, 5, 6, 7); }
constexpr int BM = 256, BK = 64, HALF = 128, HTB = HALF * BK * 2  , STAGE_BYTES = 8 * HTB, NXCD = 8, WGM = 8;

__host__ __device__ __forceinline__ int lds_byte(int r, int c) { const int st = (r >> 4) * 2 + (c >> 5), rr = r & 15, cc = c & 31, ob = rr * 64 + cc * 2; return st * 1024 + (ob ^ (((ob >> 9) & 1) << 5)); }
__host__ __device__ __forceinline__ void stage_rc(int b, int& R, int& C) { const int st = b / 1024, sb = b % 1024, swz = sb ^ (((sb >> 9) & 1) << 5); R = (st >> 1) * 16 + swz / 64; C = (st & 1) * 32 + (swz % 64) / 2; }
__host__ __device__ __forceinline__ int perm32(int rho) { const int n = rho >> 4, i = rho & 15; return 8 * (i >> 2) + 4 * n + (i & 3); }

struct Unit { int pm, pn, x0, x1; };
struct Gemm { const bf16_t* A; const bf16_t* Bt; int M, N, K; };

struct StaticOrder {
    int nM, nN, nwg, G, c;
    __host__ __device__ void init(int M, int N, int G_, int c_) { nM = M / BM; nN = N / BM; nwg = nM * nN; G = G_; c = c_; }
    __host__ __device__ bool next(int i, Unit& u) const {
        const long L = (long)i * G + c; if (L >= nwg) return false;
        int wgid = (int)L; { const int q = nwg / NXCD, r = nwg % NXCD, xcd = wgid % NXCD, off = wgid / NXCD; wgid = (xcd < r ? xcd * (q + 1) : r * (q + 1) + (xcd - r) * q) + off; }
        const int nig = WGM * nN, gid = wgid / nig, fm = gid * WGM, gsz = (nM - fm) < WGM ? (nM - fm) : WGM;
        u.pm = fm + ((wgid % nig) % gsz); u.pn = (wgid % nig) / gsz; return true;
    }
    __device__ __forceinline__ void a_ready(const Unit&) const {}
    __device__ __forceinline__ void done(const Unit&) const {}
};


__device__ __forceinline__ unsigned pk2(float lo, float hi) { typedef float v2f __attribute__((ext_vector_type(2))); typedef __bf16 v2b __attribute__((ext_vector_type(2))); v2f v = {lo, hi}; v2b b = __builtin_convertvector(v, v2b); return __builtin_bit_cast(unsigned, b); }
struct EpiZ {
    static constexpr bool PERM = true, AFTER_DRAIN = false;
    bf16_t* Z; const float* rstd; const float* bias; int zp, ncols;
    __device__ __forceinline__ void operator()(const f32x4 (&acc)[2][2][4][2], const Unit& u, int wr, int wc, int fr, int fq) const {
        const int row0 = u.pm * BM + wr * 64 + fr, col0 = u.pn * BM + wc * 64 + 8 * fq;
        const float* bp = bias + (size_t)((u.pm * BM) >> 11) * zp + col0;
        f32x4 bv[2][2];
#pragma unroll
        for (int bj = 0; bj < 2; ++bj)
#pragma unroll
            for (int n = 0; n < 2; ++n) bv[bj][n] = *(const f32x4*)(bp + bj * 32 + 4 * n);
        float rsv[2][4];
#pragma unroll
        for (int ai = 0; ai < 2; ++ai)
#pragma unroll
            for (int m = 0; m < 4; ++m) rsv[ai][m] = rstd[row0 + ai * HALF + m * 16];
#pragma unroll
        for (int ai = 0; ai < 2; ++ai)
#pragma unroll
            for (int m = 0; m < 4; ++m) { const int row = row0 + ai * HALF + m * 16; const float rs = rsv[ai][m]; bf16_t* rowp = Z + (size_t)row * zp + col0;
#pragma unroll
                for (int bj = 0; bj < 2; ++bj) { if (col0 + bj * 32 >= ncols) continue; const f32x4 v0 = acc[ai][bj][m][0] * rs + bv[bj][0], v1 = acc[ai][bj][m][1] * rs + bv[bj][1];
                    u32x4 w; w.x = pk2(v0[0], v0[1]); w.y = pk2(v0[2], v0[3]); w.z = pk2(v1[0], v1[1]); w.w = pk2(v1[2], v1[3]);
                    *(u32x4*)(rowp + bj * 32) = w; } }
    }
};
struct EpiRes {
    static constexpr bool PERM = true, AFTER_DRAIN = false;
    const float* xf; const bf16_t* xb; bf16_t* out; const float* g1; float* rowsq;
    __device__ __forceinline__ void operator()(const f32x4 (&acc)[2][2][4][2], const Unit& u, int wr, int wc, int fr, int fq) const {
        const int row0 = u.pm * BM + wr * 64 + fr, col0 = u.pn * BM + wc * 64 + 8 * fq;
        const float* gp = g1 + (size_t)((u.pm * BM) >> 11) * 6144 + col0;
        f32x4 gv[2][2];
#pragma unroll
        for (int bj = 0; bj < 2; ++bj)
#pragma unroll
            for (int n = 0; n < 2; ++n) gv[bj][n] = *(const f32x4*)(gp + bj * 32 + 4 * n);
        if (!xf) {
            u32x4 xw[2][2], xn[2][2];
#define ER_LOAD(DST, AM) do { _Pragma("unroll") for (int mm = 0; mm < 2; ++mm) _Pragma("unroll") for (int bj = 0; bj < 2; ++bj) \
                DST[mm][bj] = *(const u32x4*)(xb + (size_t)(row0 + ((AM) >> 1) * HALF + (((AM) & 1) * 2 + mm) * 16) * 1024 + col0 + bj * 32); } while (0)
            ER_LOAD(xw, 0);
#pragma unroll
            for (int am = 0; am < 4; ++am) { const int ai = am >> 1, m0 = (am & 1) * 2;
                if (am < 3) ER_LOAD(xn, am + 1);
#pragma unroll
                for (int mm = 0; mm < 2; ++mm) { const int m = m0 + mm, row = row0 + ai * HALF + m * 16; const size_t off = (size_t)row * 1024 + col0; float s = 0.f;
#pragma unroll
                    for (int bj = 0; bj < 2; ++bj) { const u32x4 w = xw[mm][bj];
                        const f32x4 x0 = {__uint_as_float(w.x << 16), __uint_as_float(w.x & 0xffff0000u), __uint_as_float(w.y << 16), __uint_as_float(w.y & 0xffff0000u)};
                        const f32x4 x1 = {__uint_as_float(w.z << 16), __uint_as_float(w.z & 0xffff0000u), __uint_as_float(w.w << 16), __uint_as_float(w.w & 0xffff0000u)};
                        const f32x4 o0 = x0 + gv[bj][0] * acc[ai][bj][m][0], o1 = x1 + gv[bj][1] * acc[ai][bj][m][1];
                        s += ((o0[0] * o0[0] + o0[1] * o0[1]) + (o0[2] * o0[2] + o0[3] * o0[3])) + ((o1[0] * o1[0] + o1[1] * o1[1]) + (o1[2] * o1[2] + o1[3] * o1[3]));
                        u32x4 q; q.x = pk2(o0[0], o0[1]); q.y = pk2(o0[2], o0[3]); q.z = pk2(o1[0], o1[1]); q.w = pk2(o1[2], o1[3]);
                        *(u32x4*)(out + off + bj * 32) = q; }
                    s += __shfl_xor(s, 16); s += __shfl_xor(s, 32);
                    if (fq == 0) rowsq[(size_t)row * 16 + u.pn * 4 + wc] = s; }
#pragma unroll
                for (int mm = 0; mm < 2; ++mm)
#pragma unroll
                    for (int bj = 0; bj < 2; ++bj) xw[mm][bj] = xn[mm][bj];
            }
#undef ER_LOAD
            return;
        }
#pragma unroll
        for (int am = 0; am < 4; ++am) { const int ai = am >> 1, m0 = (am & 1) * 2;
            f32x4 xp[2][2][2];
            if (xf) {
#pragma unroll
                for (int mm = 0; mm < 2; ++mm)
#pragma unroll
                    for (int bj = 0; bj < 2; ++bj)
#pragma unroll
                        for (int n = 0; n < 2; ++n) xp[mm][bj][n] = *(const f32x4*)(xf + (size_t)(row0 + ai * HALF + (m0 + mm) * 16) * 1024 + col0 + bj * 32 + 4 * n);
            } else {
                u32x4 xw[2][2];
#pragma unroll
                for (int mm = 0; mm < 2; ++mm)
#pragma unroll
                    for (int bj = 0; bj < 2; ++bj) xw[mm][bj] = *(const u32x4*)(xb + (size_t)(row0 + ai * HALF + (m0 + mm) * 16) * 1024 + col0 + bj * 32);
#pragma unroll
                for (int mm = 0; mm < 2; ++mm)
#pragma unroll
                    for (int bj = 0; bj < 2; ++bj) { const u32x4 w = xw[mm][bj];
                        xp[mm][bj][0] = (f32x4){__uint_as_float(w.x << 16), __uint_as_float(w.x & 0xffff0000u), __uint_as_float(w.y << 16), __uint_as_float(w.y & 0xffff0000u)};
                        xp[mm][bj][1] = (f32x4){__uint_as_float(w.z << 16), __uint_as_float(w.z & 0xffff0000u), __uint_as_float(w.w << 16), __uint_as_float(w.w & 0xffff0000u)}; }
            }
            asm volatile("" ::: "memory");
#pragma unroll
            for (int mm = 0; mm < 2; ++mm) { const int m = m0 + mm, row = row0 + ai * HALF + m * 16; const size_t off = (size_t)row * 1024 + col0; float s = 0.f;
#pragma unroll
                for (int bj = 0; bj < 2; ++bj) { const f32x4 o0 = xp[mm][bj][0] + gv[bj][0] * acc[ai][bj][m][0], o1 = xp[mm][bj][1] + gv[bj][1] * acc[ai][bj][m][1];
                    s += ((o0[0] * o0[0] + o0[1] * o0[1]) + (o0[2] * o0[2] + o0[3] * o0[3])) + ((o1[0] * o1[0] + o1[1] * o1[1]) + (o1[2] * o1[2] + o1[3] * o1[3]));
                    u32x4 w; w.x = pk2(o0[0], o0[1]); w.y = pk2(o0[2], o0[3]); w.z = pk2(o1[0], o1[1]); w.w = pk2(o1[2], o1[3]);
                    *(u32x4*)(out + off + bj * 32) = w; }
                s += __shfl_xor(s, 16); s += __shfl_xor(s, 32);
                if (fq == 0) rowsq[(size_t)row * 16 + u.pn * 4 + wc] = s; }
            asm volatile("" ::: "memory"); }
    }
};
__device__ __forceinline__ unsigned pk4_fp8(float a, float b, float c, float d) { int w = __builtin_amdgcn_cvt_pk_fp8_f32(a, b, 0, false); w = __builtin_amdgcn_cvt_pk_fp8_f32(c, d, w, true); return (unsigned)w; }
struct EpiAct {
    static constexpr bool PERM = true, AFTER_DRAIN = false;
    unsigned char* ACT;
    __device__ __forceinline__ void operator()(const f32x4 (&acc)[2][2][4][2], const Unit& u, int wr, int wc, int fr, int fq) const {
        if (!(u.x0 >> 8)) return;
        const int ct = u.pn & 3, row0 = u.pm * BM + wr * 64 + fr, col0 = ct * 128 + wc * 32 + 8 * fq;
#pragma unroll
        for (int ai = 0; ai < 2; ++ai)
#pragma unroll
            for (int m = 0; m < 4; ++m) { unsigned char* rowp = ACT + (size_t)(row0 + ai * HALF + m * 16) * 512 + col0;
                float v[8];
#pragma unroll
                for (int n = 0; n < 2; ++n)
#pragma unroll
                    for (int i = 0; i < 4; ++i) { const float a = acc[ai][0][m][n][i], b = acc[ai][1][m][n][i]; v[n * 4 + i] = a * __builtin_amdgcn_rcpf(1.0f + __expf(-a)) * b; }
                typedef unsigned u32x2_ __attribute__((ext_vector_type(2)));
                u32x2_ w; w.x = pk4_fp8(v[0], v[1], v[2], v[3]); w.y = pk4_fp8(v[4], v[5], v[6], v[7]);
                *(u32x2_*)rowp = w; }
    }
};
struct EpiY {
    static constexpr bool PERM = true, AFTER_DRAIN = false;
    unsigned char* Y;
    __device__ __forceinline__ void operator()(const f32x4 (&acc)[2][2][4][2], const Unit& u, int wr, int wc, int fr, int fq) const {
        if (!(u.x0 >> 8)) return;
        const int ct = u.pn & 3, row0 = u.pm * BM + wr * 64 + fr, col0 = ct * 256 + wc * 64 + 16 * fq;
#pragma unroll
        for (int ai = 0; ai < 2; ++ai)
#pragma unroll
            for (int m = 0; m < 4; ++m) { unsigned char* dst = Y + (size_t)(row0 + ai * HALF + m * 16) * 1024 + col0;
                u32x4 w;
                w.x = pk4_fp8(acc[ai][0][m][0][0], acc[ai][0][m][0][1], acc[ai][0][m][0][2], acc[ai][0][m][0][3]); w.y = pk4_fp8(acc[ai][0][m][1][0], acc[ai][0][m][1][1], acc[ai][0][m][1][2], acc[ai][0][m][1][3]);
                w.z = pk4_fp8(acc[ai][1][m][0][0], acc[ai][1][m][0][1], acc[ai][1][m][0][2], acc[ai][1][m][0][3]); w.w = pk4_fp8(acc[ai][1][m][1][0], acc[ai][1][m][1][1], acc[ai][1][m][1][2], acc[ai][1][m][1][3]);
                *(u32x4*)dst = w; }
    }
};
struct MoeOrder {
    const PG8_LAS int* tab; int G, c;
    __device__ __forceinline__ bool next(int i, Unit& u) const {
        const int RTP = __builtin_amdgcn_readfirstlane(tab[1]), Rt = __builtin_amdgcn_readfirstlane(tab[0]), nwg = RTP * 4;
        const long L = (long)i * G + c; if (L >= nwg) return false;
        int wgid = (int)L; { const int q = nwg / NXCD, r = nwg % NXCD, xcd = wgid % NXCD, off = wgid / NXCD; wgid = (xcd < r ? xcd * (q + 1) : r * (q + 1) + (xcd - r) * q) + off; }
        const int gid = wgid / 32, w = wgid % 32, rt = 8 * gid + (w & 7), ct = w >> 3, valid = rt < Rt ? 1 : 0, rtc = valid ? rt : 0;
        const int e = __builtin_amdgcn_readfirstlane(tab[128 + rtc]), sb = __builtin_amdgcn_readfirstlane(tab[2 + e]);
        u.pm = rtc; u.pn = e * 4 + ct; u.x0 = e | (valid << 8); u.x1 = (rtc - sb) * 256; return true;
    }
    __device__ __forceinline__ void a_ready(const Unit&) const {}
    __device__ __forceinline__ void done(const Unit&) const {}
};

struct MoeOrderG : MoeOrder { const PG8_LAS int* rowtab; };

template <class Epi, class Sched, bool ALIGN_EPI = false, bool SP2 = false, bool FP8 = false>
__device__ __forceinline__ void gemm_phase(PG8_LAS unsigned char* lds, const Gemm g, const Sched& S, const Epi& E) {
    int tid = threadIdx.x; asm volatile("" : "+v"(tid)); const int wid = __builtin_amdgcn_readfirstlane(tid >> 6), lane = tid & 63, wr = wid >> 2, wc = wid & 3, fr = lane & 15, fq = lane >> 4;
    const int K = g.K, nt = K / BK;
    unsigned voffA[2], voffB[2];
#pragma unroll
    for (int i = 0; i < 2; ++i) { int R, C; stage_rc(tid * 16 + i * 8192, R, C); const int Rb = Epi::PERM ? ((R & ~31) + perm32(R & 31)) : R;
        voffA[i] = (unsigned)(R * K + C) * 2u; voffB[i] = (unsigned)(Rb * K + C) * 2u; }
    const size_t kstep = (size_t)(BK * 2);
    const size_t hstep = (size_t)HALF * K * 2;
    const size_t tstep = 2 * hstep;
    const unsigned ldsw = (unsigned)wid * 1024u;
    const int aoff = FP8 ? lds_byte(wr * 64 + fr, (fq >> 1) * 32 + (fq & 1) * 16) : lds_byte(wr * 64 + fr, fq * 8), boff = FP8 ? lds_byte(wc * 32 + fr, (fq >> 1) * 32 + (fq & 1) * 16) : lds_byte(wc * 32 + fr, fq * 8);
#define PG8_SA(b, h) (((b) * 2 + (h)) * HTB)
#define PG8_SB(b, h) ((4 + (b) * 2 + (h)) * HTB)
#define PG8_STAGE(bufoff, gbase, voff) do { _Pragma("unroll") for (int _i = 0; _i < 2; ++_i) \
        __builtin_amdgcn_global_load_lds((const unsigned*)((const char*)(gbase) + (voff)[_i]), (PG8_LAS unsigned*)(lds + (bufoff) + ldsw + _i * 8192), 16, 0, 0); } while (0)
#define PG8_LDA(dst, b, h) do { if constexpr (FP8) { _Pragma("unroll") for (int m = 0; m < 4; ++m) dst##8[m] = *(const PG8_LAS v8i_t*)(lds + PG8_SA(b, h) + aoff + m * 2048); } \
        else { _Pragma("unroll") for (int m = 0; m < 4; ++m) _Pragma("unroll") for (int k = 0; k < 2; ++k) dst[m][k] = *(const PG8_LAS bf16x8*)(lds + PG8_SA(b, h) + aoff + m * 2048 + k * 1024); } } while (0)
#define PG8_LDB(dst, b, h) do { if constexpr (FP8) { _Pragma("unroll") for (int n = 0; n < 2; ++n) dst##8[n] = *(const PG8_LAS v8i_t*)(lds + PG8_SB(b, h) + boff + n * 2048); } \
        else { _Pragma("unroll") for (int n = 0; n < 2; ++n) _Pragma("unroll") for (int k = 0; k < 2; ++k) dst[n][k] = *(const PG8_LAS bf16x8*)(lds + PG8_SB(b, h) + boff + n * 2048 + k * 1024); } } while (0)
#define PG8_MMA(ai, bj, At, Bt) do { __builtin_amdgcn_s_setprio(1); \
        if constexpr (FP8) {     \
            _Pragma("unroll") for (int m = 0; m < 4; ++m) _Pragma("unroll") for (int n = 0; n < 2; ++n) \
                asm volatile("v_mfma_scale_f32_16x16x128_f8f6f4 %0, %1, %2, %0, %3, %4 op_sel_hi:[0,0,0]" : "+v"(acc[ai][bj][m][n]) : "v"(Bt##8[n]), "v"(At##8[m]), "v"(sc_w8), "v"(sc_a8));     \
        } else { \
            _Pragma("unroll") for (int m = 0; m < 4; ++m) _Pragma("unroll") for (int n = 0; n < 2; ++n) _Pragma("unroll") for (int k = 0; k < 2; ++k) \
                acc[ai][bj][m][n] = __builtin_amdgcn_mfma_f32_16x16x32_bf16(Bt[n][k], At[m][k], acc[ai][bj][m][n], 0, 0, 0); } \
        __builtin_amdgcn_s_setprio(0); } while (0)
#define PG8_WAIT_V(n) asm volatile("s_waitcnt vmcnt(" #n ")" ::: "memory")
#define PG8_WAIT_L(n) asm volatile("s_waitcnt lgkmcnt(" #n ")" ::: "memory")
#define PG8_BAR __builtin_amdgcn_s_barrier()
#define PG8_SCHED __builtin_amdgcn_sched_barrier(0)
    Unit cur, nxt; int ui = 0;
    if (!S.next(0, cur)) return;
    f32x4 acc[2][2][4][2];
#pragma unroll
    for (int a = 0; a < 2; ++a)
#pragma unroll
        for (int b = 0; b < 2; ++b)
#pragma unroll
            for (int m = 0; m < 4; ++m)
#pragma unroll
                for (int n = 0; n < 2; ++n) acc[a][b][m][n] = (f32x4){0.f, 0.f, 0.f, 0.f};
    const int sc_w8 = 0x79797979, sc_a8 = 0x7F7F7F7F;
    bf16x8 At[4][2], B0[2][2], B1[2][2]; v8i_t At8[4], B08[2], B18[2];
    const char* cA = (const char*)g.A + (size_t)cur.pm * tstep; const char* cB = (const char*)g.Bt + (size_t)cur.pn * tstep;
    S.a_ready(cur);
    if constexpr (SP2) {
        PG8_STAGE(PG8_SB(0, 0), cB, voffB); PG8_STAGE(PG8_SB(0, 1), cB + hstep, voffB); PG8_STAGE(PG8_SA(0, 0), cA, voffA); PG8_STAGE(PG8_SA(0, 1), cA + hstep, voffA);
        if (wr == 1) PG8_BAR;
        PG8_WAIT_V(2); PG8_BAR;
        PG8_STAGE(PG8_SB(1, 0), cB + kstep, voffB); PG8_STAGE(PG8_SA(1, 0), cA + kstep, voffA); PG8_STAGE(PG8_SB(1, 1), cB + hstep + kstep, voffB);
        PG8_WAIT_V(6); PG8_BAR;
    } else {
        PG8_STAGE(PG8_SB(0, 0), cB, voffB); PG8_STAGE(PG8_SA(0, 0), cA, voffA); PG8_STAGE(PG8_SB(0, 1), cB + hstep, voffB); PG8_STAGE(PG8_SA(0, 1), cA + hstep, voffA);
        if (wr == 1) PG8_BAR;
        PG8_WAIT_V(4); PG8_BAR;
        PG8_STAGE(PG8_SB(1, 0), cB + kstep, voffB); PG8_STAGE(PG8_SA(1, 0), cA + kstep, voffA); PG8_STAGE(PG8_SB(1, 1), cB + hstep + kstep, voffB);
        PG8_WAIT_V(6); PG8_BAR;
    }
    for (;;) {
        const bool has_next = S.next(ui + 1, nxt);
        const char* nA = has_next ? (const char*)g.A + (size_t)nxt.pm * tstep : cA; const char* nB = has_next ? (const char*)g.Bt + (size_t)nxt.pn * tstep : cB;
#pragma unroll 1
        for (int t = 0; t < nt; t += 2) {
            const bool last = (t == nt - 2);
            const char* a1 = cA + (size_t)(t + 1) * kstep;
            const char* a2 = last ? nA : cA + (size_t)(t + 2) * kstep; const char* b2 = last ? nB : cB + (size_t)(t + 2) * kstep;
            const char* a3 = a2 + kstep; const char* b3 = b2 + kstep;
            if (last && has_next) S.a_ready(nxt);
            if constexpr (SP2) {
            PG8_LDB(B0, 0, 0); PG8_LDB(B1, 0, 1); PG8_SCHED; PG8_LDA(At, 0, 0); PG8_STAGE(PG8_SA(1, 1), a1 + hstep, voffA);
            PG8_WAIT_V(8); PG8_WAIT_L(0); PG8_BAR; PG8_MMA(0, 0, At, B0); PG8_MMA(0, 1, At, B1); PG8_BAR; PG8_SCHED;
            PG8_LDA(At, 0, 1); PG8_STAGE(PG8_SB(0, 0), b2, voffB); PG8_STAGE(PG8_SB(0, 1), b2 + hstep, voffB); PG8_STAGE(PG8_SA(0, 0), a2, voffA);
            PG8_WAIT_V(8); PG8_WAIT_L(0); PG8_BAR; PG8_MMA(1, 0, At, B0); PG8_MMA(1, 1, At, B1); PG8_BAR; PG8_SCHED;
            PG8_LDB(B0, 1, 0); PG8_LDB(B1, 1, 1); PG8_SCHED; PG8_LDA(At, 1, 0); PG8_STAGE(PG8_SA(0, 1), a2 + hstep, voffA);
            PG8_WAIT_V(8); PG8_WAIT_L(0); PG8_BAR; PG8_MMA(0, 0, At, B0); PG8_MMA(0, 1, At, B1); PG8_BAR; PG8_SCHED;
            PG8_LDA(At, 1, 1); PG8_STAGE(PG8_SB(1, 0), b3, voffB); PG8_STAGE(PG8_SB(1, 1), b3 + hstep, voffB); PG8_STAGE(PG8_SA(1, 0), a3, voffA);
            PG8_WAIT_V(8); PG8_WAIT_L(0); PG8_BAR; PG8_MMA(1, 0, At, B0); PG8_MMA(1, 1, At, B1); PG8_BAR; PG8_SCHED;
            } else {
            PG8_LDB(B0, 0, 0); PG8_SCHED; PG8_LDA(At, 0, 0); PG8_STAGE(PG8_SA(1, 1), a1 + hstep, voffA);
            PG8_WAIT_L(8); PG8_BAR; PG8_WAIT_L(0); PG8_MMA(0, 0, At, B0); PG8_BAR; PG8_SCHED;
            PG8_LDB(B1, 0, 1); PG8_STAGE(PG8_SB(0, 0), b2, voffB);
            PG8_BAR; PG8_WAIT_L(0); PG8_MMA(0, 1, At, B1); PG8_BAR;
            PG8_LDA(At, 0, 1); PG8_STAGE(PG8_SA(0, 0), a2, voffA);
            PG8_BAR; PG8_WAIT_L(0); PG8_MMA(1, 0, At, B0); PG8_BAR; PG8_SCHED;
            PG8_STAGE(PG8_SB(0, 1), b2 + hstep, voffB);
            PG8_WAIT_V(6); PG8_BAR; PG8_MMA(1, 1, At, B1); PG8_BAR;
            PG8_LDB(B0, 1, 0); PG8_SCHED; PG8_LDA(At, 1, 0); PG8_STAGE(PG8_SA(0, 1), a2 + hstep, voffA);
            PG8_WAIT_L(8); PG8_BAR; PG8_WAIT_L(0); PG8_MMA(0, 0, At, B0); PG8_BAR; PG8_SCHED;
            PG8_LDB(B1, 1, 1); PG8_STAGE(PG8_SB(1, 0), b3, voffB);
            PG8_BAR; PG8_WAIT_L(0); PG8_MMA(0, 1, At, B1); PG8_BAR;
            PG8_LDA(At, 1, 1); PG8_STAGE(PG8_SA(1, 0), a3, voffA);
            PG8_BAR; PG8_WAIT_L(0); PG8_MMA(1, 0, At, B0); PG8_BAR; PG8_SCHED;
            PG8_STAGE(PG8_SB(1, 1), b3 + hstep, voffB);
            PG8_WAIT_V(6); PG8_BAR; PG8_MMA(1, 1, At, B1); PG8_BAR;
            }
        }
        if constexpr (ALIGN_EPI) { if (wr == 0) PG8_BAR; }
        if constexpr (FP8) asm volatile("s_nop 15\n\ts_nop 15\n\ts_nop 7" ::: "memory");
        if constexpr (!Epi::AFTER_DRAIN) { int tid_e = threadIdx.x; asm volatile("" : "+v"(tid_e));
            E(acc, cur, wr, wc, tid_e & 15, (tid_e & 63) >> 4); S.done(cur); }
        if (!has_next) break;
#pragma unroll
        for (int a = 0; a < 2; ++a)
#pragma unroll
            for (int b = 0; b < 2; ++b)
#pragma unroll
                for (int m = 0; m < 4; ++m)
#pragma unroll
                    for (int n = 0; n < 2; ++n) acc[a][b][m][n] = (f32x4){0.f, 0.f, 0.f, 0.f};
        cur = nxt; cA = nA; cB = nB; ++ui;
        if constexpr (ALIGN_EPI) { if (wr == 1) PG8_BAR; }
    }
    PG8_WAIT_V(0);
    if constexpr (!ALIGN_EPI) { if (wr == 0) PG8_BAR; }
    PG8_BAR;
    if constexpr (Epi::AFTER_DRAIN) { E.fused(acc, cur, wr, wc, fr, fq, lds, wid, lane); S.done(cur); }
#undef PG8_SA
#undef PG8_SB
#undef PG8_STAGE
#undef PG8_LDA
#undef PG8_LDB
#undef PG8_MMA
#undef PG8_WAIT_V
#undef PG8_WAIT_L
#undef PG8_BAR
#undef PG8_SCHED
}
template <class Epi, class Sched, bool ALIGN_EPI = false, bool SP2 = false, bool FP8 = false>
__device__ __forceinline__ void gemm_phase_gather(PG8_LAS unsigned char* lds, const Gemm g, const Sched& S, const Epi& E) {
    int tid = threadIdx.x; asm volatile("" : "+v"(tid)); const int wid = __builtin_amdgcn_readfirstlane(tid >> 6), lane = tid & 63, wr = wid >> 2, wc = wid & 3, fr = lane & 15, fq = lane >> 4;
    const int K = g.K, nt = K / BK;
    unsigned voffA[2], voffB[2]; int rA[2]; unsigned vA[2][2], vN[2][2];
#pragma unroll
    for (int i = 0; i < 2; ++i) { int R, C; stage_rc(tid * 16 + i * 8192, R, C); const int Rb = Epi::PERM ? ((R & ~31) + perm32(R & 31)) : R;
        voffA[i] = (unsigned)C * 2u; rA[i] = R; voffB[i] = (unsigned)(Rb * K + C) * 2u; }
    const size_t kstep = (size_t)(BK * 2);
    const size_t hstep = (size_t)HALF * K * 2;
    const size_t tstep = 2 * hstep;
    const unsigned ldsw = (unsigned)wid * 1024u;
    const int aoff = FP8 ? lds_byte(wr * 64 + fr, (fq >> 1) * 32 + (fq & 1) * 16) : lds_byte(wr * 64 + fr, fq * 8), boff = FP8 ? lds_byte(wc * 32 + fr, (fq >> 1) * 32 + (fq & 1) * 16) : lds_byte(wc * 32 + fr, fq * 8);
#define PG8_SA(b, h) (((b) * 2 + (h)) * HTB)
#define PG8_SB(b, h) ((4 + (b) * 2 + (h)) * HTB)
#define PG8_STAGE(bufoff, gbase, voff) do { _Pragma("unroll") for (int _i = 0; _i < 2; ++_i) \
        __builtin_amdgcn_global_load_lds((const unsigned*)((const char*)(gbase) + (voff)[_i]), (PG8_LAS unsigned*)(lds + (bufoff) + ldsw + _i * 8192), 16, 0, 0); } while (0)
#define PG8_LDA(dst, b, h) do { if constexpr (FP8) { _Pragma("unroll") for (int m = 0; m < 4; ++m) dst##8[m] = *(const PG8_LAS v8i_t*)(lds + PG8_SA(b, h) + aoff + m * 2048); } \
        else { _Pragma("unroll") for (int m = 0; m < 4; ++m) _Pragma("unroll") for (int k = 0; k < 2; ++k) dst[m][k] = *(const PG8_LAS bf16x8*)(lds + PG8_SA(b, h) + aoff + m * 2048 + k * 1024); } } while (0)
#define PG8_LDB(dst, b, h) do { if constexpr (FP8) { _Pragma("unroll") for (int n = 0; n < 2; ++n) dst##8[n] = *(const PG8_LAS v8i_t*)(lds + PG8_SB(b, h) + boff + n * 2048); } \
        else { _Pragma("unroll") for (int n = 0; n < 2; ++n) _Pragma("unroll") for (int k = 0; k < 2; ++k) dst[n][k] = *(const PG8_LAS bf16x8*)(lds + PG8_SB(b, h) + boff + n * 2048 + k * 1024); } } while (0)
#define PG8_MMA(ai, bj, At, Bt) do { __builtin_amdgcn_s_setprio(1); \
        if constexpr (FP8) {     \
            _Pragma("unroll") for (int m = 0; m < 4; ++m) _Pragma("unroll") for (int n = 0; n < 2; ++n) \
                asm volatile("v_mfma_scale_f32_16x16x128_f8f6f4 %0, %1, %2, %0, %3, %4 op_sel_hi:[0,0,0]" : "+v"(acc[ai][bj][m][n]) : "v"(Bt##8[n]), "v"(At##8[m]), "v"(sc_w8), "v"(sc_a8));     \
        } else { \
            _Pragma("unroll") for (int m = 0; m < 4; ++m) _Pragma("unroll") for (int n = 0; n < 2; ++n) _Pragma("unroll") for (int k = 0; k < 2; ++k) \
                acc[ai][bj][m][n] = __builtin_amdgcn_mfma_f32_16x16x32_bf16(Bt[n][k], At[m][k], acc[ai][bj][m][n], 0, 0, 0); } \
        __builtin_amdgcn_s_setprio(0); } while (0)
#define PG8_WAIT_V(n) asm volatile("s_waitcnt vmcnt(" #n ")" ::: "memory")
#define PG8_WAIT_L(n) asm volatile("s_waitcnt lgkmcnt(" #n ")" ::: "memory")
#define PG8_BAR __builtin_amdgcn_s_barrier()
#define PG8_SCHED __builtin_amdgcn_sched_barrier(0)
    Unit cur, nxt; int ui = 0;
    if (!S.next(0, cur)) return;
#define PG8_ROWS(dst, uidx) do { _Pragma("unroll") for (int h_ = 0; h_ < 2; ++h_) _Pragma("unroll") for (int i_ = 0; i_ < 2; ++i_) dst[h_][i_] = (unsigned)S.rowtab[(uidx) * 256 + h_ * HALF + rA[i_]] * (unsigned)(K * 2) + voffA[i_]; } while (0)
    PG8_ROWS(vA, 0);
    f32x4 acc[2][2][4][2];
#pragma unroll
    for (int a = 0; a < 2; ++a)
#pragma unroll
        for (int b = 0; b < 2; ++b)
#pragma unroll
            for (int m = 0; m < 4; ++m)
#pragma unroll
                for (int n = 0; n < 2; ++n) acc[a][b][m][n] = (f32x4){0.f, 0.f, 0.f, 0.f};
    const int sc_w8 = 0x79797979, sc_a8 = 0x7F7F7F7F;
    bf16x8 At[4][2], B0[2][2], B1[2][2]; v8i_t At8[4], B08[2], B18[2];
    const char* cA = (const char*)g.A; const char* cB = (const char*)g.Bt + (size_t)cur.pn * tstep;
    S.a_ready(cur);
    if constexpr (SP2) {
        PG8_STAGE(PG8_SB(0, 0), cB, voffB); PG8_STAGE(PG8_SB(0, 1), cB + hstep, voffB); PG8_STAGE(PG8_SA(0, 0), cA, vA[0]); PG8_STAGE(PG8_SA(0, 1), cA, vA[1]);
        if (wr == 1) PG8_BAR;
        PG8_WAIT_V(2); PG8_BAR;
        PG8_STAGE(PG8_SB(1, 0), cB + kstep, voffB); PG8_STAGE(PG8_SA(1, 0), cA + kstep, vA[0]); PG8_STAGE(PG8_SB(1, 1), cB + hstep + kstep, voffB);
        PG8_WAIT_V(6); PG8_BAR;
    } else {
        PG8_STAGE(PG8_SB(0, 0), cB, voffB); PG8_STAGE(PG8_SA(0, 0), cA, vA[0]); PG8_STAGE(PG8_SB(0, 1), cB + hstep, voffB); PG8_STAGE(PG8_SA(0, 1), cA, vA[1]);
        if (wr == 1) PG8_BAR;
        PG8_WAIT_V(4); PG8_BAR;
        PG8_STAGE(PG8_SB(1, 0), cB + kstep, voffB); PG8_STAGE(PG8_SA(1, 0), cA + kstep, vA[0]); PG8_STAGE(PG8_SB(1, 1), cB + hstep + kstep, voffB);
        PG8_WAIT_V(6); PG8_BAR;
    }
    for (;;) {
        const bool has_next = S.next(ui + 1, nxt);
        if (has_next) PG8_ROWS(vN, ui + 1);
        const char* nA = cA; const char* nB = has_next ? (const char*)g.Bt + (size_t)nxt.pn * tstep : cB;
#pragma unroll 1
        for (int t = 0; t < nt; t += 2) {
            const bool last = (t == nt - 2);
            unsigned vX[2][2];
#pragma unroll
            for (int h_ = 0; h_ < 2; ++h_)
#pragma unroll
                for (int i_ = 0; i_ < 2; ++i_) vX[h_][i_] = (last && has_next) ? vN[h_][i_] : vA[h_][i_];
            const char* a1 = cA + (size_t)(t + 1) * kstep;
            const char* a2 = last ? nA : cA + (size_t)(t + 2) * kstep; const char* b2 = last ? nB : cB + (size_t)(t + 2) * kstep;
            const char* a3 = a2 + kstep; const char* b3 = b2 + kstep;
            if (last && has_next) S.a_ready(nxt);
            if constexpr (SP2) {
            PG8_LDB(B0, 0, 0); PG8_LDB(B1, 0, 1); PG8_SCHED; PG8_LDA(At, 0, 0); PG8_STAGE(PG8_SA(1, 1), a1, vA[1]);
            PG8_WAIT_V(8); PG8_WAIT_L(0); PG8_BAR; PG8_MMA(0, 0, At, B0); PG8_MMA(0, 1, At, B1); PG8_BAR; PG8_SCHED;
            PG8_LDA(At, 0, 1); PG8_STAGE(PG8_SB(0, 0), b2, voffB); PG8_STAGE(PG8_SB(0, 1), b2 + hstep, voffB); PG8_STAGE(PG8_SA(0, 0), a2, vX[0]);
            PG8_WAIT_V(8); PG8_WAIT_L(0); PG8_BAR; PG8_MMA(1, 0, At, B0); PG8_MMA(1, 1, At, B1); PG8_BAR; PG8_SCHED;
            PG8_LDB(B0, 1, 0); PG8_LDB(B1, 1, 1); PG8_SCHED; PG8_LDA(At, 1, 0); PG8_STAGE(PG8_SA(0, 1), a2, vX[1]);
            PG8_WAIT_V(8); PG8_WAIT_L(0); PG8_BAR; PG8_MMA(0, 0, At, B0); PG8_MMA(0, 1, At, B1); PG8_BAR; PG8_SCHED;
            PG8_LDA(At, 1, 1); PG8_STAGE(PG8_SB(1, 0), b3, voffB); PG8_STAGE(PG8_SB(1, 1), b3 + hstep, voffB); PG8_STAGE(PG8_SA(1, 0), a3, vX[0]);
            PG8_WAIT_V(8); PG8_WAIT_L(0); PG8_BAR; PG8_MMA(1, 0, At, B0); PG8_MMA(1, 1, At, B1); PG8_BAR; PG8_SCHED;
            } else {
            PG8_LDB(B0, 0, 0); PG8_SCHED; PG8_LDA(At, 0, 0); PG8_STAGE(PG8_SA(1, 1), a1, vA[1]);
            PG8_WAIT_L(8); PG8_BAR; PG8_WAIT_L(0); PG8_MMA(0, 0, At, B0); PG8_BAR; PG8_SCHED;
            PG8_LDB(B1, 0, 1); PG8_STAGE(PG8_SB(0, 0), b2, voffB);
            PG8_BAR; PG8_WAIT_L(0); PG8_MMA(0, 1, At, B1); PG8_BAR;
            PG8_LDA(At, 0, 1); PG8_STAGE(PG8_SA(0, 0), a2, vX[0]);
            PG8_BAR; PG8_WAIT_L(0); PG8_MMA(1, 0, At, B0); PG8_BAR; PG8_SCHED;
            PG8_STAGE(PG8_SB(0, 1), b2 + hstep, voffB);
            PG8_WAIT_V(6); PG8_BAR; PG8_MMA(1, 1, At, B1); PG8_BAR;
            PG8_LDB(B0, 1, 0); PG8_SCHED; PG8_LDA(At, 1, 0); PG8_STAGE(PG8_SA(0, 1), a2, vX[1]);
            PG8_WAIT_L(8); PG8_BAR; PG8_WAIT_L(0); PG8_MMA(0, 0, At, B0); PG8_BAR; PG8_SCHED;
            PG8_LDB(B1, 1, 1); PG8_STAGE(PG8_SB(1, 0), b3, voffB);
            PG8_BAR; PG8_WAIT_L(0); PG8_MMA(0, 1, At, B1); PG8_BAR;
            PG8_LDA(At, 1, 1); PG8_STAGE(PG8_SA(1, 0), a3, vX[0]);
            PG8_BAR; PG8_WAIT_L(0); PG8_MMA(1, 0, At, B0); PG8_BAR; PG8_SCHED;
            PG8_STAGE(PG8_SB(1, 1), b3 + hstep, voffB);
            PG8_WAIT_V(6); PG8_BAR; PG8_MMA(1, 1, At, B1); PG8_BAR;
            }
        }
        if constexpr (ALIGN_EPI) { if (wr == 0) PG8_BAR; }
        if constexpr (FP8) asm volatile("s_nop 15\n\ts_nop 15\n\ts_nop 7" ::: "memory");
        if constexpr (!Epi::AFTER_DRAIN) { int tid_e = threadIdx.x; asm volatile("" : "+v"(tid_e));
            E(acc, cur, wr, wc, tid_e & 15, (tid_e & 63) >> 4); S.done(cur); }
        if (!has_next) break;
#pragma unroll
        for (int a = 0; a < 2; ++a)
#pragma unroll
            for (int b = 0; b < 2; ++b)
#pragma unroll
                for (int m = 0; m < 4; ++m)
#pragma unroll
                    for (int n = 0; n < 2; ++n) acc[a][b][m][n] = (f32x4){0.f, 0.f, 0.f, 0.f};
        cur = nxt; cA = nA; cB = nB; ++ui;
#pragma unroll
        for (int h_ = 0; h_ < 2; ++h_)
#pragma unroll
            for (int i_ = 0; i_ < 2; ++i_) vA[h_][i_] = vN[h_][i_];
        if constexpr (ALIGN_EPI) { if (wr == 1) PG8_BAR; }
    }
    PG8_WAIT_V(0);
    if constexpr (!ALIGN_EPI) { if (wr == 0) PG8_BAR; }
    PG8_BAR;
    if constexpr (Epi::AFTER_DRAIN) { E.fused(acc, cur, wr, wc, fr, fq, lds, wid, lane); S.done(cur); }
#undef PG8_ROWS
#undef PG8_SA
#undef PG8_SB
#undef PG8_STAGE
#undef PG8_LDA
#undef PG8_LDB
#undef PG8_MMA
#undef PG8_WAIT_V
#undef PG8_WAIT_L
#undef PG8_BAR
#undef PG8_SCHED
}
}

struct Params {
    const float *x, *c, *w_mod, *b_mod, *w_in, *w_pool, *pool_scale, *w_gk_up, *b_gk, *gla_norm_g, *w_out, *w_router, *b_router, *w1, *w3, *w2, *final_g;
    float* out; unsigned char* ws; int ph_lo, ph_hi;
};
typedef const __attribute__((address_space(4))) Params* CP;
#define LDSF(off) ((float*)(lds + (off)))

#define LAS __attribute__((address_space(3)))
#define XB_TMO      128
#define XB_XCNT(j)  (256  + 64 * (j))
#define XB_XSUB(j)  (1280 + 64 * (j))
#define XB_XGEN(j)  (2304 + 64 * (j))
#define XB_TOP      3328
#define XB_TOPGEN   3392
#define XCD_BAR_WORDS 3456
#define XB_SPIN_CAP (1u << 18)

__device__ __forceinline__ unsigned xb_ld(unsigned* p)              { return __hip_atomic_load(p, __ATOMIC_RELAXED, __HIP_MEMORY_SCOPE_AGENT); }
__device__ __forceinline__ unsigned xb_add(unsigned* p, unsigned v) { return __hip_atomic_fetch_add(p, v, __ATOMIC_RELAXED, __HIP_MEMORY_SCOPE_AGENT); }
__device__ __forceinline__ unsigned xb_xcc_id() { return (unsigned)__builtin_amdgcn_s_getreg((3 << 11) | 20) & 0xFu; }
#define XB_SPIN(cond, bar) do { unsigned _sp = 0; while (cond) { __builtin_amdgcn_s_sleep(1); \
    if ((++_sp & 255u) == 0u) { if (xb_ld(&(bar)[XB_TMO])) break; if (_sp > XB_SPIN_CAP) { atomicAdd(&(bar)[XB_TMO], 1u); break; } } } } while (0)

struct XcdBarrier {
    unsigned* bar; unsigned x;
    volatile LAS unsigned* st;
};

__device__ __forceinline__ XcdBarrier xcd_barrier_post(unsigned* bar, volatile LAS unsigned* st) {
    XcdBarrier b; b.bar = bar; b.x = xb_xcc_id(); b.st = st;
    if (threadIdx.x == 0) (void)xb_add(&bar[XB_XCNT(b.x)], 1u);
    return b;
}
__device__ __forceinline__ void xcd_barrier_complete(unsigned* bar, unsigned x, unsigned& nloc, unsigned& nx) {
    const unsigned G = gridDim.x * gridDim.y * gridDim.z;
    unsigned sum, cnt, mine, sp = 0u;
    for (;;) {
        sum = 0u; cnt = 0u; mine = 0u;
#pragma unroll
        for (unsigned j = 0; j < 16; ++j) { const unsigned c = xb_ld(&bar[XB_XCNT(j)]); sum += c; cnt += (c > 0u) ? 1u : 0u; mine = (j == x) ? c : mine; }
        if (sum == G) break;
        __builtin_amdgcn_s_sleep(1);
        if ((++sp & 255u) == 0u) { if (xb_ld(&bar[XB_TMO])) break; if (sp > XB_SPIN_CAP) { atomicAdd(&bar[XB_TMO], 1u); break; } }
    }
    nloc = mine > 0u ? mine : 1u; nx = cnt > 0u ? cnt : 1u;
}

__device__ __forceinline__ void xcd_barrier(const XcdBarrier& b) {
    asm volatile("s_waitcnt vmcnt(0)" ::: "memory");
    __syncthreads();
    if (threadIdx.x == 0) {
        unsigned* bar = b.bar;
        __builtin_amdgcn_s_waitcnt(0);
        unsigned nloc = b.st[0], nx = b.st[1];
        if (nloc == 0u) { xcd_barrier_complete(bar, b.x, nloc, nx); b.st[0] = nloc; b.st[1] = nx; }
        const unsigned old = xb_add(&bar[XB_XSUB(b.x)], 1u);
        const unsigned gen = old / nloc;
        if (old + 1u == (gen + 1u) * nloc) {
            __builtin_amdgcn_fence(__ATOMIC_RELEASE, "agent");
            asm volatile("s_waitcnt vmcnt(0)" ::: "memory");
            const unsigned og = xb_add(&bar[XB_TOP], 1u);
            const unsigned tg = og / nx;
            if (og + 1u == (tg + 1u) * nx) xb_add(&bar[XB_TOPGEN], 1u);
            else XB_SPIN(xb_ld(&bar[XB_TOPGEN]) == tg, bar);
            __builtin_amdgcn_fence(__ATOMIC_ACQUIRE, "agent");
            xb_add(&bar[XB_XGEN(b.x)], 1u);
            asm volatile("s_waitcnt vmcnt(0)" ::: "memory");
        } else {
            XB_SPIN(xb_ld(&bar[XB_XGEN(b.x)]) == gen, bar);
            __builtin_amdgcn_fence(__ATOMIC_ACQUIRE, "agent");
            asm volatile("s_waitcnt vmcnt(0)" ::: "memory");
        }
    }
    __syncthreads();
}

__device__ __forceinline__ void p0_transpose_item(const float* W, int K, int N, bf16* WT, int imode, float* scr, int item, int lane) {
    const int nblk = N / 32, kb = item / nblk, nb = item % nblk, k0 = 64 * kb, n0 = 32 * nb;
    const int rbase = imode == 0 ? n0 : (256 * (n0 >> 7) + (n0 & 127) + (imode == 2 ? 128 : 0));
#pragma unroll 32
    for (int i = 0; i < 32; ++i) { const int kk = 2 * i + (lane >> 5); scr[kk * 33 + (lane & 31)] = W[(size_t)(k0 + kk) * N + n0 + (lane & 31)]; }
    asm volatile("s_waitcnt lgkmcnt(0)" ::: "memory");
    const int c = lane & 7;
#pragma unroll
    for (int j = 0; j < 4; ++j) { const int n = (lane >> 3) + 8 * j; const float* s = scr + (8 * c) * 33 + n;
        u32x4 o; o.x = cvtpk(s[0 * 33], s[1 * 33]); o.y = cvtpk(s[2 * 33], s[3 * 33]); o.z = cvtpk(s[4 * 33], s[5 * 33]); o.w = cvtpk(s[6 * 33], s[7 * 33]);
        *(u32x4*)(WT + (size_t)(rbase + n) * K + k0 + 8 * c) = o; }
    asm volatile("s_waitcnt lgkmcnt(0)" ::: "memory");
}
__device__ __forceinline__ void p0_tile_load(f32x4 (&regs)[8], const float* W, int N, int k0, int n0, int tid) {
    const float* src = W + (size_t)(k0 + (tid >> 5)) * N + n0 + 4 * (tid & 31);
#pragma unroll
    for (int i = 0; i < 8; ++i) regs[i] = *(const f32x4*)(src + (size_t)(16 * i) * N);
}
__device__ __forceinline__ void p0_tile_to_lds(float* TL, const f32x4 (&regs)[8], int tid) {
#pragma unroll
    for (int i = 0; i < 8; ++i) { const int k = (tid >> 5) + 16 * i; *(f32x4*)(TL + k * 132 + ((4 * (tid & 31) + 8 * (k >> 5)) & 127)) = regs[i]; }
}
__device__ __forceinline__ int p0_row(int c, int perm) { return perm == 1 ? (c & ~255) + 128 * ((c >> 5) & 1) + 32 * ((c >> 6) & 3) + (c & 31) : perm == 2 ? (c & ~255) + 128 * ((c >> 3) & 1) + 32 * ((c >> 6) & 3) + 8 * ((c >> 4) & 3) + (c & 7) : c; }
__device__ __forceinline__ void p0_tile_store(const float* TL, bf16* WT, int K, int k0, int rbase, int perm, int tid) {
    const int n = tid >> 2, kq = tid & 3; const float* s = TL + (32 * kq) * 132 + ((n + 8 * kq) & 127);
    bf16* dst = WT + (size_t)p0_row(rbase + n, perm) * K + k0 + 32 * kq;
#pragma unroll
    for (int j = 0; j < 4; ++j) { u32x4 o; o.x = cvtpk(s[(8 * j) * 132], s[(8 * j + 1) * 132]); o.y = cvtpk(s[(8 * j + 2) * 132], s[(8 * j + 3) * 132]);
        o.z = cvtpk(s[(8 * j + 4) * 132], s[(8 * j + 5) * 132]); o.w = cvtpk(s[(8 * j + 6) * 132], s[(8 * j + 7) * 132]); *(u32x4*)(dst + 8 * j) = o; }
}
__device__ __forceinline__ unsigned pk4f8(float a, float b, float c, float d) { int w = __builtin_amdgcn_cvt_pk_fp8_f32(a * 64.f, b * 64.f, 0, false); w = __builtin_amdgcn_cvt_pk_fp8_f32(c * 64.f, d * 64.f, w, true); return (unsigned)w; }
__device__ __forceinline__ void p0_tile_store8(const float* TL, unsigned char* WT, int K, int k0, int rbase, int perm, int tid) {
    const int n = tid >> 2, kq = tid & 3; const float* s = TL + (32 * kq) * 132 + ((n + 8 * kq) & 127);
    unsigned char* dst = WT + (size_t)p0_row(rbase + n, perm) * K + k0 + 32 * kq;
#pragma unroll
    for (int j = 0; j < 2; ++j) { u32x4 o; o.x = pk4f8(s[(16 * j) * 132], s[(16 * j + 1) * 132], s[(16 * j + 2) * 132], s[(16 * j + 3) * 132]); o.y = pk4f8(s[(16 * j + 4) * 132], s[(16 * j + 5) * 132], s[(16 * j + 6) * 132], s[(16 * j + 7) * 132]);
        o.z = pk4f8(s[(16 * j + 8) * 132], s[(16 * j + 9) * 132], s[(16 * j + 10) * 132], s[(16 * j + 11) * 132]); o.w = pk4f8(s[(16 * j + 12) * 132], s[(16 * j + 13) * 132], s[(16 * j + 14) * 132], s[(16 * j + 15) * 132]); *(u32x4*)(dst + 16 * j) = o; }
}
struct P0Tile { const float* W; bf16* WT; int K, N, k0, n0, rbase, f8, perm; };
__device__ __forceinline__ P0Tile p0_tile(CP p, unsigned char* ws, int t) {
    P0Tile o;
    constexpr int T_IN = 2 * 8 * 16, T_OUT = 2 * 8 * 8, T_PL = 8, T_W1 = 64 * 8 * 4, T_W2 = 64 * 4 * 8;
    if (t < T_IN) { const int l = t / 128, r = t % 128; o.W = p->w_in + (size_t)l * 1024 * DIN; o.WT = (bf16*)(ws + WS_WIN) + (size_t)l * ZP * 1024; o.K = 1024; o.N = DIN; o.k0 = 128 * (r / 16); o.n0 = 128 * (r % 16); o.rbase = o.n0; o.f8 = 0; o.perm = 1; return o; } t -= T_IN;
    if (t < T_OUT) { const int l = t / 64, r = t % 64; o.W = p->w_out + (size_t)l * 1024 * 1024; o.WT = (bf16*)(ws + WS_WOUT + (size_t)l * 1024 * 1024); o.K = 1024; o.N = 1024; o.k0 = 128 * (r / 8); o.n0 = 128 * (r % 8); o.rbase = o.n0; o.f8 = 1; o.perm = 1; return o; } t -= T_OUT;
    if (t < T_PL) { o.W = p->w_pool + (size_t)t * 128 * 128; o.WT = (bf16*)(ws + WS_WPT) + (size_t)t * 128 * 128; o.K = 128; o.N = 128; o.k0 = 0; o.n0 = 0; o.rbase = 0; o.f8 = 0; o.perm = 0; return o; } t -= T_PL;
    if (t < 2 * T_W1) { const int w3 = t >= T_W1 ? 1 : 0; if (w3) t -= T_W1; const int le = t / 32, r = t % 32; o.W = (w3 ? p->w3 : p->w1) + (size_t)le * 1024 * 512; o.WT = (bf16*)(ws + WS_W13 + (size_t)le * 1024 * 1024);
        o.K = 1024; o.N = 512; o.k0 = 128 * (r / 4); o.n0 = 128 * (r % 4); o.rbase = 256 * (r % 4) + 128 * w3; o.f8 = 1; o.perm = 0; return o; } t -= 2 * T_W1;
    { const int le = t / 32, r = t % 32; o.W = p->w2 + (size_t)le * 512 * 1024; o.WT = (bf16*)(ws + WS_W2 + (size_t)le * 1024 * 512); o.K = 512; o.N = 1024; o.k0 = 128 * (r / 8); o.n0 = 128 * (r % 8); o.rbase = o.n0; o.f8 = 1; o.perm = 2; return o; }
}
constexpr int P0_NTILES = 2 * 8 * 16 + 2 * 8 * 8 + 8 + 2 * 64 * 8 * 4 + 64 * 4 * 8;
__device__ __forceinline__ void gemv32_item(unsigned char* lds, const float* in, int ld_in, bool act, const float* W, int ldw, int N, int NP, int n0, const float* bias, float* out, int ldo, int tid, int lane, int wave) {
    float* INT = (float*)lds + wave * 4096;
    __syncthreads();
#pragma unroll 1
    for (int i0 = 0; i0 < 64; i0 += 16) { float tv[16];
#pragma unroll
        for (int i = 0; i < 16; ++i) { const int idx = (i0 + i) * 64 + lane; tv[i] = in[(size_t)(idx >> 7) * ld_in + 128 * wave + (idx & 127)]; }
#pragma unroll
        for (int i = 0; i < 16; ++i) { const int idx = (i0 + i) * 64 + lane; float v = tv[i]; if (act) v = siluf(v); INT[(idx & 127) * 32 + (idx >> 7)] = v; } }
    asm volatile("s_waitcnt lgkmcnt(0)" ::: "memory");
    const int n = n0 + lane;
    float accs[2][16];
#pragma unroll
    for (int bh = 0; bh < 2; ++bh)
#pragma unroll
        for (int b = 0; b < 16; ++b) accs[bh][b] = 0.f;
    if (n < N) {
        const float* wp = W + (size_t)(128 * wave) * ldw + n;
#pragma unroll 1
        for (int k0 = 0; k0 < 128; k0 += 32) { float wr[32];
#pragma unroll
            for (int j = 0; j < 32; ++j) wr[j] = wp[(size_t)(k0 + j) * ldw];
#pragma unroll
            for (int j = 0; j < 32; ++j) { const float w = wr[j];
#pragma unroll
                for (int bh = 0; bh < 2; ++bh) { const f32x4* iv = (const f32x4*)(INT + (k0 + j) * 32 + 16 * bh);
#pragma unroll
                    for (int q = 0; q < 4; ++q) { const f32x4 v = iv[q]; accs[bh][4 * q + 0] += v[0] * w; accs[bh][4 * q + 1] += v[1] * w; accs[bh][4 * q + 2] += v[2] * w; accs[bh][4 * q + 3] += v[3] * w; }
                    asm volatile("" : "+v"(accs[bh][0]), "+v"(accs[bh][4]), "+v"(accs[bh][8]), "+v"(accs[bh][12]) :: "memory"); } } }
    }
    __syncthreads();
    float* RED = (float*)lds;
#pragma unroll
    for (int bh = 0; bh < 2; ++bh)
#pragma unroll
        for (int b = 0; b < 16; ++b) RED[(wave * 32 + 16 * bh + b) * 64 + lane] = accs[bh][b];
    __syncthreads();
#pragma unroll
    for (int q = 0; q < 4; ++q) { const int b = (tid >> 6) + 8 * q, col = tid & 63, nn = n0 + col; float sum = 0.f;
#pragma unroll
        for (int w = 0; w < 8; ++w) sum += RED[(w * 32 + b) * 64 + col];
        if (nn < N) out[(size_t)b * ldo + nn] = sum + (bias ? bias[nn] : 0.f); else if (nn < NP) out[(size_t)b * ldo + nn] = 0.f; }
    __syncthreads();
}
template <bool B_> struct BoolK { static constexpr bool value = B_; };
template <int NR>
__device__ __forceinline__ void rows_prep_loop(const float* x, const float* mod0, bf16* xsb, float* rstd_out, int gw, int ngw, int lane) {
    const int rpw = (((T + ngw - 1) / ngw) + NR - 1) / NR * NR, tfirst = gw * rpw, tlast = (tfirst + rpw) < T ? (tfirst + rpw) : T;
    struct Set { f32x4 v[NR][4]; };
    Set A, B; f32x4 scv[4];
#define RP_LOAD(S_, TB) do { _Pragma("unroll") for (int r = 0; r < NR; ++r) { const f32x4* xr_ = (const f32x4*)(x + (size_t)((TB) + r) * 1024) + lane; \
        _Pragma("unroll") for (int j = 0; j < 4; ++j) S_.v[r][j] = xr_[64 * j]; } } while (0)
#pragma unroll 1
    for (int t0 = tfirst; t0 < tlast; ) {
        const int tend = (((t0 >> 11) + 1) << 11) < tlast ? (((t0 >> 11) + 1) << 11) : tlast;
        { const f32x4* sr = (const f32x4*)(mod0 + (size_t)(t0 >> 11) * 6144 + 1024) + lane;
#pragma unroll
          for (int j = 0; j < 4; ++j) scv[j] = sr[64 * j] + 1.0f; }
        RP_LOAD(A, t0);
        auto step = [&](auto allc, Set& cur, Set& nxt, const int tb) __attribute__((always_inline)) { constexpr bool ALL = decltype(allc)::value;
            if (ALL || tb + NR < tend) RP_LOAD(nxt, tb + NR);
            asm volatile("" ::: "memory");
            float s[NR];
#pragma unroll
            for (int r = 0; r < NR; ++r) { s[r] = 0.f;
#pragma unroll
                for (int j = 0; j < 4; ++j) s[r] += (cur.v[r][j][0] * cur.v[r][j][0] + cur.v[r][j][1] * cur.v[r][j][1]) + (cur.v[r][j][2] * cur.v[r][j][2] + cur.v[r][j][3] * cur.v[r][j][3]); }
#pragma unroll
            for (int o = 1; o < 64; o <<= 1) {
#pragma unroll
                for (int r = 0; r < NR; ++r) s[r] += __shfl_xor(s[r], o); }
#pragma unroll
            for (int r = 0; r < NR; ++r) { const int t = tb + r;
                if (lane == 0) rstd_out[t] = __builtin_amdgcn_rsqf(s[r] * (1.f / 1024.f) + EPS);
                u32x2* o = (u32x2*)(xsb + (size_t)t * 1024) + lane;
#pragma unroll
                for (int j = 0; j < 4; ++j) { const f32x4 w = cur.v[r][j] * scv[j]; u32x2 q; q.x = cvtpk(w[0], w[1]); q.y = cvtpk(w[2], w[3]); o[64 * j] = q; } }
            asm volatile("" ::: "memory");
        };
        int tb = t0;
#pragma unroll 1
        for (; tb + 2 * NR < tend; tb += 2 * NR) { step(BoolK<true>{}, A, B, tb); step(BoolK<true>{}, B, A, tb + NR); }
#pragma unroll 1
        for (; tb < tend; tb += 2 * NR) { step(BoolK<false>{}, A, B, tb); if (tb + NR < tend) step(BoolK<false>{}, B, A, tb + NR); }
        t0 = tend; }
#undef RP_LOAD
}

constexpr int CH_R = 0;
constexpr int CH_QT = 4096;
constexpr int CH_BL = 6144;
constexpr int CH_DEC = 6400;
constexpr int CH_BC = 8192;
constexpr int CH_VT = 25600;
constexpr int CH_KDT = 44032;
constexpr int CH_STL = 53248;
constexpr int GL_R = 0;
constexpr int GL_QT = 8192;
constexpr int GL_BL = 10240;
constexpr int GL_BC = 10752;
constexpr int GL_VT = 43520;
constexpr int GL_QE = 61952;
constexpr int GL_KE = 80384;
constexpr int GL_OL = 98816;
constexpr int GL_NG = 132608;
constexpr int PL_UT = 0;
constexpr int PL_PL = 21760;
static_assert(GL_NG + 512 <= LDS_BYTES - 64, "mixer LDS map");

#define LBAR() do { asm volatile("s_waitcnt lgkmcnt(0)" ::: "memory"); __builtin_amdgcn_s_barrier(); asm volatile("" ::: "memory"); } while (0)
__device__ __forceinline__ float logsig16(float x) {
    const float t = __builtin_amdgcn_exp2f(fabsf(x) * -1.4426950408889634f), lg = __builtin_amdgcn_logf(1.0f + t);
    const float mn = __builtin_amdgcn_fmed3f(x, 0.f, -__builtin_inff());
    return fmaf(lg, -0.0625f, mn * (0.0625f * 1.4426950408889634f)); }

__device__ __forceinline__ void stage_vt(bf16* VT, const u32x4& v0, const u32x4& v1, int tok, int vg) {
    const unsigned w[8] = {v0.x, v0.y, v0.z, v0.w, v1.x, v1.y, v1.z, v1.w};
#pragma unroll
    for (int j = 0; j < 8; ++j) { VT[(16 * vg + 2 * j) * 72 + tok] = (bf16)(w[j] & 0xffffu); VT[(16 * vg + 2 * j + 1) * 72 + tok] = (bf16)(w[j] >> 16); }
}

constexpr int CP_R = 0, CP_QT = 8192, CP_BLD = 12288, CP_BC = 13312, CP_KDT = 48128, CP_VT = 66560, CP_STL = 103424;
static_assert(CP_STL + 2 * 18432 <= LDS_BYTES - 64, "chain LDS map");
template <bool B_> struct BoolC { static constexpr bool value = B_; };
__device__ __forceinline__ void gla_chain(unsigned char* lds, CP p, int l, int item, int tid, int lane, int wave) {
    const bf16* Z = (const bf16*)(p->ws + WS_Z); bf16* ST = (bf16*)(p->ws + WS_ST);
    const int dir = item >> 7, bh = item & 127, h = bh & 3, b = bh >> 2;
    const int l15 = lane & 15, kq4 = lane >> 4;
    const int d = 16 * (wave & 3) + l15, tg = 4 * (wave >> 2) + kq4;
    const int tk2 = tid & 63, gr2 = tid >> 6;
    const int vb = wave & 3, db = wave >> 2, r32 = lane & 31, hi = lane >> 5;
    typedef short bf16x4_t __attribute__((ext_vector_type(4)));
    bf16x4_t wHi, wLo;
    { const float* wup = p->w_gk_up + ((size_t)(l * 2 + dir) * 16 + 4 * kq4) * 256 + h * 64 + d;
#pragma unroll
      for (int kk = 0; kk < 4; ++kk) { const float w = wup[kk * 256]; const unsigned short hb = f2bf(w); wHi[kk] = (short)hb; wLo[kk] = (short)f2bf(w - bflo((unsigned)hb)); } }
    const float bias = p->b_gk[(l * 2 + dir) * 256 + h * 64 + d];
    f32x16 S = {};
    const bf16* zrow = Z + ((size_t)b * SEQ + 32 * (wave >> 2) + 8 * (l15 >> 2) + (l15 & 3)) * ZP + C_RF + dir * 16 + 4 * kq4;
    const bf16* zrow2 = Z + ((size_t)b * SEQ + tk2) * ZP;
    _Float16* bcg = (_Float16*)(p->ws + WS_BCG) + ((size_t)((dir * 128 + bh) * 32)) * 4096 + (size_t)(8 * tg) * 64 + d;
    unsigned char* stb = (unsigned char*)ST + ((size_t)((dir * 128 + bh) * 32)) * 8192 + (size_t)(tid >> 2) * 64 + 16 * (tid & 3);
#define CH_N(j) (dir ? 31 - (j) : (j))
#define CH_LOAD_R(j, blk) (*(const u32x2*)(zrow + ((size_t)CH_N(j) * 64 + 4 * (blk)) * ZP))
    u32x2 rA0 = {0u, 0u}, rA1 = rA0, rB0 = CH_LOAD_R(0, 0), rB1 = CH_LOAD_R(0, 1);
    u32x4 kA = {0u, 0u, 0u, 0u}, v0A = kA, v1A = kA, kB = kA, v0B = kA, v1B = kA;
    float gprev[8]; f32x4 dcv[4];
#pragma unroll
    for (int j = 0; j < 8; ++j) gprev[j] = 0.f;
#pragma unroll
    for (int rq = 0; rq < 4; ++rq) dcv[rq] = (f32x4){0.f, 0.f, 0.f, 0.f};
    LBAR();
    const unsigned incmask = dir == 0 ? ((1u << tg) - 1u) : (0xffu & ~((2u << tg) - 1u));
    auto interval = [&](auto allc, const int i, u32x2& r0, u32x2& r1, u32x4& kk, u32x4& vv0, u32x4& vv1) __attribute__((always_inline)) { constexpr bool ALL = decltype(allc)::value;
        if (ALL || (i >= 5 && i < 37)) { const int j = i - 5; const unsigned char* sr = lds + CP_STL + (j & 1) * 18432 + (tid >> 2) * 80 + 16 * (tid & 3);
            *(u32x4*)(stb + (size_t)CH_N(j) * 8192) = *(const u32x4*)sr; }
        if (ALL || (i >= 4 && i < 36)) { const int pq = (i - 4) & 1;
            const bf16* KDT = (const bf16*)(lds + CP_KDT + pq * 9216); const bf16* VT = (const bf16*)(lds + CP_VT + pq * 18432);
            unsigned char* stl_w = lds + CP_STL + pq * 18432 + (32 * vb + r32) * 80 + 32 * db + 4 * hi;
            f32x16 u = {};
#pragma unroll
            for (int s = 0; s < 4; ++s) {
                const bf16x8 a = *(const bf16x8*)(KDT + (32 * db + r32) * 72 + 16 * s + 8 * hi);
                const bf16x8 bb = *(const bf16x8*)(VT + (32 * vb + r32) * 72 + 16 * s + 8 * hi);
                u = __builtin_amdgcn_mfma_f32_32x32x16_bf16(a, bb, u, 0, 0, 0);
            }
#pragma unroll
            for (int rq = 0; rq < 4; ++rq) {
                *(unsigned*)(stl_w + 8 * rq) = pg8::pk4_fp8(S[4 * rq], S[4 * rq + 1], S[4 * rq + 2], S[4 * rq + 3]);
                const f32x4 dc = dcv[rq];
                S[4 * rq] = dc[0] * S[4 * rq] + u[4 * rq]; S[4 * rq + 1] = dc[1] * S[4 * rq + 1] + u[4 * rq + 1];
                S[4 * rq + 2] = dc[2] * S[4 * rq + 2] + u[4 * rq + 2]; S[4 * rq + 3] = dc[3] * S[4 * rq + 3] + u[4 * rq + 3];
            } }
        if (ALL || (i >= 3 && i < 35)) { const int pq = (i - 3) & 1;
            const float* BLD = (const float*)(lds + CP_BLD + pq * 512); const float* BC = (const float*)(lds + CP_BC + pq * 17408);
            bf16* KDT = (bf16*)(lds + CP_KDT + pq * 9216); bf16* VT = (bf16*)(lds + CP_VT + pq * 18432);
#pragma unroll
            for (int rq = 0; rq < 4; ++rq) dcv[rq] = *(const f32x4*)(BLD + 64 + 32 * db + 8 * rq + 4 * hi);
            const f32x4 c0 = *(const f32x4*)(BC + tk2 * 68 + 8 * gr2), c1 = *(const f32x4*)(BC + tk2 * 68 + 8 * gr2 + 4);
            const f32x4 l0 = *(const f32x4*)(BLD + 8 * gr2), l1 = *(const f32x4*)(BLD + 8 * gr2 + 4);
            const float kf[8] = {bflo(kk.x), bfhi(kk.x), bflo(kk.y), bfhi(kk.y), bflo(kk.z), bfhi(kk.z), bflo(kk.w), bfhi(kk.w)};
#pragma unroll
            for (int j = 0; j < 8; ++j) { const float bc = j < 4 ? c0[j & 3] : c1[j & 3], bl = j < 4 ? l0[j & 3] : l1[j & 3];
                KDT[(8 * gr2 + j) * 72 + tk2] = f2bf(kf[j] * __builtin_amdgcn_exp2f(bl - bc)); }
            stage_vt(VT, vv0, vv1, tk2, gr2); }
        if (ALL || (i >= 2 && i < 34)) { const int j2 = i - 2, pq = j2 & 1;
            const float* QT = (const float*)(lds + CP_QT + pq * 2048); float* BLD = (float*)(lds + CP_BLD + pq * 512); float* BC = (float*)(lds + CP_BC + pq * 17408);
            float off = 0.f, tot = 0.f;
#pragma unroll
            for (int q = 0; q < 8; ++q) { const float t = QT[q * 64 + d]; tot += t; off += ((incmask >> q) & 1u) ? t : 0.f; }
            _Float16* bo = bcg + (size_t)CH_N(j2) * 4096;
#pragma unroll
            for (int j = 0; j < 8; ++j) { const float bcv = gprev[j] + off; BC[(8 * tg + j) * 68 + d] = bcv; bo[j * 64] = (_Float16)bcv; }
            if (tg == 0) { BLD[d] = tot; BLD[64 + d] = __builtin_amdgcn_exp2f(tot); } }
        if (ALL || (i >= 1 && i < 33)) { const int pq = (i - 1) & 1;
            float* QT = (float*)(lds + CP_QT + pq * 2048);
            f32x4 x0 = {bias, bias, bias, bias}, x1 = x0;
            x0 = __builtin_amdgcn_mfma_f32_16x16x16bf16_1k(__builtin_bit_cast(bf16x4_t, r0), wHi, x0, 0, 0, 0); x0 = __builtin_amdgcn_mfma_f32_16x16x16bf16_1k(__builtin_bit_cast(bf16x4_t, r0), wLo, x0, 0, 0, 0);
            x1 = __builtin_amdgcn_mfma_f32_16x16x16bf16_1k(__builtin_bit_cast(bf16x4_t, r1), wHi, x1, 0, 0, 0); x1 = __builtin_amdgcn_mfma_f32_16x16x16bf16_1k(__builtin_bit_cast(bf16x4_t, r1), wLo, x1, 0, 0, 0);
#pragma unroll
            for (int j = 0; j < 4; ++j) { gprev[j] = logsig16(x0[j]); gprev[4 + j] = logsig16(x1[j]); }
            float run = 0.f;
            if (dir == 0) {
#pragma unroll
                for (int j = 0; j < 8; ++j) { run += gprev[j]; gprev[j] = run; }
            } else {
#pragma unroll
                for (int j = 7; j >= 0; --j) { run += gprev[j]; gprev[j] = run; }
            }
            QT[tg * 64 + d] = run; }
        if (ALL || i + 1 < 32) { r0 = CH_LOAD_R(i + 1, 0); r1 = CH_LOAD_R(i + 1, 1); }
        if (ALL || (i >= 1 && i - 1 < 32)) { const bf16* zr = zrow2 + (size_t)CH_N(i - 1) * 64 * ZP;
            kk = *(const u32x4*)(zr + C_K + h * 64 + 8 * gr2); vv0 = *(const u32x4*)(zr + C_V + h * 128 + 16 * gr2); vv1 = *(const u32x4*)(zr + C_V + h * 128 + 16 * gr2 + 8); }
        LBAR();
    };
    int i = 0;
#pragma unroll 1
    for (; i < 6; i += 2) { interval(BoolC<false>{}, i, rA0, rA1, kA, v0A, v1A); interval(BoolC<false>{}, i + 1, rB0, rB1, kB, v0B, v1B); }
#pragma unroll 1
    for (; i < 30; i += 2) { interval(BoolC<true>{}, i, rA0, rA1, kA, v0A, v1A); interval(BoolC<true>{}, i + 1, rB0, rB1, kB, v0B, v1B); }
#pragma unroll 1
    for (; i < 38; i += 2) { interval(BoolC<false>{}, i, rA0, rA1, kA, v0A, v1A); interval(BoolC<false>{}, i + 1, rB0, rB1, kB, v0B, v1B); }
#undef CH_N
#undef CH_LOAD_R
}

__device__ __forceinline__ void mixer_store(unsigned char* lds, unsigned char* dstbase, bool gla, const u32x4& g0, const u32x4& g1, int tid) {
    const float* OL = LDSF(GL_OL); const int tok = tid >> 3, vg = tid & 7;
    float o[16];
#pragma unroll
    for (int q = 0; q < 4; ++q) { const f32x4 t = *(const f32x4*)(OL + tok * 132 + 16 * vg + 4 * q); o[4 * q] = t[0]; o[4 * q + 1] = t[1]; o[4 * q + 2] = t[2]; o[4 * q + 3] = t[3]; }
    if (gla) {
        float ss = 0.f;
#pragma unroll
        for (int j = 0; j < 16; ++j) ss += o[j] * o[j];
        ss += __shfl_xor(ss, 1); ss += __shfl_xor(ss, 2); ss += __shfl_xor(ss, 4);
        const float rstd = __builtin_amdgcn_rsqf(ss * (1.f / 128.f) + EPS);
        const unsigned gw[8] = {g0.x, g0.y, g0.z, g0.w, g1.x, g1.y, g1.z, g1.w};
        const float* NG = LDSF(GL_NG) + 16 * vg;
#pragma unroll
        for (int j = 0; j < 8; ++j) { const float ga = bflo(gw[j]), gb = bfhi(gw[j]);
            o[2 * j] = o[2 * j] * rstd * NG[2 * j] * siluf(ga); o[2 * j + 1] = o[2 * j + 1] * rstd * NG[2 * j + 1] * siluf(gb); }
    }
    u32x4 w0;
    w0.x = pg8::pk4_fp8(o[0], o[1], o[2], o[3]); w0.y = pg8::pk4_fp8(o[4], o[5], o[6], o[7]); w0.z = pg8::pk4_fp8(o[8], o[9], o[10], o[11]); w0.w = pg8::pk4_fp8(o[12], o[13], o[14], o[15]);
    *(u32x4*)(dstbase + (size_t)tok * 1024 + 16 * vg) = w0;
}

__device__ __forceinline__ void gla_stepC_phase(unsigned char* lds, CP p, int l, int vcu, int G, int tid, int lane, int wave) {
    const bf16* Z = (const bf16*)(p->ws + WS_Z); const bf16* ST = (const bf16*)(p->ws + WS_ST); unsigned char* AB = p->ws + WS_ABUF; const _Float16* BCG = (const _Float16*)(p->ws + WS_BCG);
    bf16* QE = (bf16*)(lds + GL_QE); bf16* KE = (bf16*)(lds + GL_KE); bf16* VT = (bf16*)(lds + GL_VT);
    const int tok = tid >> 3, dg = tid & 7, tk2 = tid & 63, gr2 = tid >> 6;
    const int ib = wave >> 2, vb = wave & 3, r32 = lane & 31, hi = lane >> 5;
    if (tid < 128) LDSF(GL_NG)[tid] = p->gla_norm_g[l * 128 + tid];
    int u = vcu; if (u >= 4096) return;
    int n = u & 31, h = (u >> 5) & 3, b = u >> 7;
    typedef _Float16 h8 __attribute__((ext_vector_type(8)));
    u32x4 q8, k8, va, vb2, ga, gb; h8 bc[2];
#define SC_LOAD() do { const bf16* zr = Z + ((size_t)b * SEQ + n * 64 + tok) * ZP; const bf16* zr2 = Z + ((size_t)b * SEQ + n * 64 + tk2) * ZP; \
        q8 = *(const u32x4*)(zr + C_Q + h * 64 + 8 * dg); k8 = *(const u32x4*)(zr + C_K + h * 64 + 8 * dg); \
        va = *(const u32x4*)(zr2 + C_V + h * 128 + 16 * gr2); vb2 = *(const u32x4*)(zr2 + C_V + h * 128 + 16 * gr2 + 8); \
        ga = *(const u32x4*)(zr + C_G + h * 128 + 16 * dg); gb = *(const u32x4*)(zr + C_G + h * 128 + 16 * dg + 8); \
        _Pragma("unroll") for (int dd = 0; dd < 2; ++dd) { bc[dd] = *(const h8*)(BCG + ((size_t)((dd * 128 + b * 4 + h) * 32 + n)) * 4096 + tok * 64 + 8 * dg); } } while (0)
    SC_LOAD();
#pragma unroll 1
    for (;;) {
        const int bh = b * 4 + h, hc = h; const size_t row0 = (size_t)b * SEQ + n * 64;
        u32x2 sraw[2][4];
#pragma unroll
        for (int dd = 0; dd < 2; ++dd) { const unsigned char* Sg = (const unsigned char*)ST + ((size_t)((dd * 128 + bh) * 32 + n)) * 8192 + (size_t)(32 * vb + r32) * 64 + 8 * hi;
#pragma unroll
            for (int s = 0; s < 4; ++s) sraw[dd][s] = *(const u32x2*)(Sg + 16 * s); }
        { const float qf[8] = {bflo(q8.x), bfhi(q8.x), bflo(q8.y), bfhi(q8.y), bflo(q8.z), bfhi(q8.z), bflo(q8.w), bfhi(q8.w)};
          const float kf[8] = {bflo(k8.x), bfhi(k8.x), bflo(k8.y), bfhi(k8.y), bflo(k8.z), bfhi(k8.z), bflo(k8.w), bfhi(k8.w)};
#pragma unroll
          for (int dd = 0; dd < 2; ++dd) {
              float qe[8], ke[8];
#pragma unroll
              for (int j = 0; j < 8; ++j) { const float bcv = (float)bc[dd][j]; const float e = __builtin_amdgcn_exp2f(bcv); qe[j] = qf[j] * e * 0.125f; ke[j] = kf[j] * __builtin_amdgcn_exp2f(-bcv);     }
              u32x4 wq, wk;
              wq.x = cvtpk(qe[0], qe[1]); wq.y = cvtpk(qe[2], qe[3]); wq.z = cvtpk(qe[4], qe[5]); wq.w = cvtpk(qe[6], qe[7]);
              wk.x = cvtpk(ke[0], ke[1]); wk.y = cvtpk(ke[2], ke[3]); wk.z = cvtpk(ke[4], ke[5]); wk.w = cvtpk(ke[6], ke[7]);
              *(u32x4*)(QE + (dd * 64 + tok) * 72 + 8 * dg) = wq; *(u32x4*)(KE + (dd * 64 + tok) * 72 + 8 * dg) = wk;
          }
          stage_vt(VT, va, vb2, tk2, gr2); }
        const u32x4 gc0 = ga, gc1 = gb;
        const int un = u + G; const bool more = un < 4096;
        if (more) { n = un & 31; h = (un >> 5) & 3; b = un >> 7; SC_LOAD(); }
        LBAR();
        {
            f32x16 o = {};
#pragma unroll
            for (int dd = 0; dd < 2; ++dd) {
                bf16x8 qfr[4];
#pragma unroll
                for (int s = 0; s < 4; ++s) qfr[s] = *(const bf16x8*)(QE + (dd * 64 + 32 * ib + r32) * 72 + 16 * s + 8 * hi);
#pragma unroll
                for (int s = 0; s < 4; ++s) { typedef float f2_ __attribute__((ext_vector_type(2)));
                const f2_ c0 = __builtin_amdgcn_cvt_pk_f32_fp8((int)sraw[dd][s].x, false), c1 = __builtin_amdgcn_cvt_pk_f32_fp8((int)sraw[dd][s].x, true), c2 = __builtin_amdgcn_cvt_pk_f32_fp8((int)sraw[dd][s].y, false), c3 = __builtin_amdgcn_cvt_pk_f32_fp8((int)sraw[dd][s].y, true);
                u32x4 sw; sw.x = cvtpk(c0[0], c0[1]); sw.y = cvtpk(c1[0], c1[1]); sw.z = cvtpk(c2[0], c2[1]); sw.w = cvtpk(c3[0], c3[1]);
                o = __builtin_amdgcn_mfma_f32_32x32x16_bf16(qfr[s], __builtin_bit_cast(bf16x8, sw), o, 0, 0, 0); }
#pragma unroll
                for (int jb = 0; jb < 2; ++jb) {
                    if (dd == 0 ? (jb > ib) : (jb < ib)) continue;
                    f32x16 x = {};
#pragma unroll
                    for (int s = 0; s < 4; ++s) { const bf16x8 a = *(const bf16x8*)(KE + (dd * 64 + 32 * jb + r32) * 72 + 16 * s + 8 * hi); x = __builtin_amdgcn_mfma_f32_32x32x16_bf16(a, qfr[s], x, 0, 0, 0); }
                    if (jb == ib) {
#pragma unroll
                        for (int r = 0; r < 16; ++r) { const int j = (r & 3) + 8 * (r >> 2) + 4 * hi; const bool keep = dd == 0 ? (j <= r32) : (j > r32); if (!keep) x[r] = 0.f; } }
#pragma unroll
                    for (int s2 = 0; s2 < 2; ++s2) {
                        u32x4 pa; pa.x = cvtpk(x[8 * s2], x[8 * s2 + 1]); pa.y = cvtpk(x[8 * s2 + 2], x[8 * s2 + 3]); pa.z = cvtpk(x[8 * s2 + 4], x[8 * s2 + 5]); pa.w = cvtpk(x[8 * s2 + 6], x[8 * s2 + 7]);
                        const bf16* vp = VT + (32 * vb + r32) * 72 + 32 * jb + 16 * s2 + 4 * hi;
                        const u32x2 b0 = *(const u32x2*)vp, b1 = *(const u32x2*)(vp + 8);
                        u32x4 pb; pb.x = b0.x; pb.y = b0.y; pb.z = b1.x; pb.w = b1.y;
                        o = __builtin_amdgcn_mfma_f32_32x32x16_bf16(__builtin_bit_cast(bf16x8, pa), __builtin_bit_cast(bf16x8, pb), o, 0, 0, 0);
                    }
                }
            }
            float* OL = LDSF(GL_OL);
#pragma unroll
            for (int r = 0; r < 16; ++r) OL[(32 * ib + (r & 3) + 8 * (r >> 2) + 4 * hi) * 132 + 32 * vb + r32] = o[r];
        }
        LBAR();
        mixer_store(lds, AB + row0 * 1024 + 512 + hc * 128, true, gc0, gc1, tid);
        if (!more) break;
        u = un;
    }
#undef SC_LOAD
    LBAR();
}
__device__ __forceinline__ void pool_phase(unsigned char* lds, CP p, int l, int vcu, int G, int tid, int lane, int wave) {
    const bf16* Z = (const bf16*)(p->ws + WS_Z); unsigned char* AB = p->ws + WS_ABUF; const bf16* WPT = (const bf16*)(p->ws + WS_WPT);
    bf16* UT = (bf16*)(lds + PL_UT); bf16* PL = (bf16*)(lds + PL_PL);
    const int ib = wave >> 2, nb = wave & 3, r32 = lane & 31, hi = lane >> 5;
    int u = vcu; if (u >= 4096) return;
    int g = u & 3, tt = (u >> 2) & 31, b = u >> 7, gw_ = -1;
    bf16x8 wfr[8]; float sc = 0.f;
    u32x4 pre[3];
#define POOL_LOAD(bq, ttq, gq) do { _Pragma("unroll") for (int i_ = 0; i_ < 3; ++i_) { const int idx = tid + 512 * i_; const int rr = idx >> 4, chn = idx & 15, t = (ttq) * 64 - 8 + rr; \
        u32x4 v_ = {0u, 0u, 0u, 0u}; if (idx < 1280 && t >= 0 && t < SEQ) v_ = *(const u32x4*)(Z + ((size_t)(bq) * SEQ + t) * ZP + (gq) * 128 + 8 * chn); pre[i_] = v_; } } while (0)
    POOL_LOAD(b, tt, g);
#pragma unroll 1
    for (;;) {
        const int t0 = tt * 64, gc = g, bc = b;
        if (gc != gw_) { gw_ = gc; const bf16* wp = WPT + ((size_t)(l * 4 + gc) * 128 + 32 * nb + r32) * 128 + 8 * hi;
#pragma unroll
            for (int s = 0; s < 8; ++s) wfr[s] = *(const bf16x8*)(wp + 16 * s);
            sc = p->pool_scale[l * 512 + gc * 128 + 32 * nb + r32]; }
#pragma unroll
        for (int i_ = 0; i_ < 3; ++i_) { const int idx = tid + 512 * i_; if (idx < 1280) *(u32x4*)(UT + (idx >> 4) * 136 + 8 * (idx & 15)) = pre[i_]; }
        const int un = u + G; const bool more = un < 4096;
        if (more) { g = un & 3; tt = (un >> 2) & 31; b = un >> 7; POOL_LOAD(b, tt, g); }
        LBAR();
        { const int c = tid & 127, tq = tid >> 7, w = 2 << gc, half = w >> 1;
          const bf16* ut = UT + (16 * tq + 8) * 136 + c;
          const bf16* ulo = ut - half * 136;
          const bf16* uhi = ulo + w * 136;
#define UF(ptr, j) __uint_as_float(((unsigned)(ptr)[(j) * 136]) << 16)
          float s = 0.f;
          for (int j = 0; j < w; ++j) s += UF(ulo, j);
          const int tb = t0 + 16 * tq;
          bf16* pl = PL + (16 * tq) * 136 + c;
#pragma unroll
          for (int j = 0; j < 16; ++j) {
              const int t = tb + j, lo = max(t - half, 0), hi2 = min(t - half + w - 1, SEQ - 1);
              const float pooled = s * __builtin_amdgcn_rcpf((float)(hi2 - lo + 1)) - UF(ut, j);
              pl[j * 136] = f2bf(pooled);
              s += UF(uhi, j) - UF(ulo, j);
          }
#undef UF
        }
        LBAR();
        { f32x16 acc = {};
#pragma unroll
          for (int s = 0; s < 8; ++s) { const bf16x8 a = *(const bf16x8*)(PL + (32 * ib + r32) * 136 + 16 * s + 8 * hi); acc = __builtin_amdgcn_mfma_f32_32x32x16_bf16(a, wfr[s], acc, 0, 0, 0); }
          float* OL = LDSF(GL_OL);
#pragma unroll
          for (int r = 0; r < 16; ++r) OL[(32 * ib + (r & 3) + 8 * (r >> 2) + 4 * hi) * 132 + 32 * nb + r32] = acc[r] * sc; }
        LBAR();
        { const u32x4 zz = {0u, 0u, 0u, 0u}; mixer_store(lds, AB + ((size_t)bc * SEQ + t0) * 1024 + gc * 128, false, zz, zz, tid); }
        if (!more) break;
        u = un;
    }
#undef POOL_LOAD
    LBAR();
}

constexpr int RT_XS = 0;
constexpr int RT_H = 69632;
__device__ __forceinline__ void router_tile(unsigned char* lds, CP p, int l, int tile, int tid, int lane, int wave) {
    const bf16* X1 = (const bf16*)(p->ws + WS_XB); const float* ROWSQ = (const float*)(p->ws + WS_ROWSQ); unsigned char* H8 = p->ws + WS_ABUF;
    int* CNT = (int*)(p->ws + WS_CTL) + 64 + l * 64; int* TOK = (int*)(p->ws + WS_TOK); float* GWL = (float*)(p->ws + WS_GWL);
    float* XS = LDSF(RT_XS + wave * 8704); int* H = (int*)(lds + RT_H); int* HB = H + 32;
    if (tid < 32) H[tid] = 0;
    const int tb = tile * 256 + wave * 32, b = tb >> 11;
    const float* sc2 = (const float*)(p->ws + WS_MOD) + ((size_t)(l * 32 + b) * 6144) + 4 * 1024; const float* sh2 = sc2 - 1024;
    const int rsub = lane >> 4, c4 = lane & 15, r32 = lane & 31, hi = lane >> 5;
    float rs[8];
#pragma unroll
    for (int it = 0; it < 8; ++it) { const f32x4* q = (const f32x4*)(ROWSQ + (size_t)(tb + 4 * it + rsub) * 16); const f32x4 a = q[0], bq = q[1], c = q[2], d = q[3];
        const float s = ((a[0] + a[1]) + (a[2] + a[3])) + ((bq[0] + bq[1]) + (bq[2] + bq[3])) + ((c[0] + c[1]) + (c[2] + c[3])) + ((d[0] + d[1]) + (d[2] + d[3]));
        rs[it] = 1.0f / sqrtf(s * (1.f / 1024.f) + EPS); }
    f32x16 acc = {};
    u32x2 xn[8];
#pragma unroll
    for (int it = 0; it < 8; ++it) xn[it] = *(const u32x2*)(X1 + (size_t)(tb + 4 * it + rsub) * 1024 + 4 * c4);
#pragma unroll 1
    for (int k0 = 0; k0 < 1024; k0 += 64) {
        f32x4 xc[8];
#pragma unroll
        for (int it = 0; it < 8; ++it) xc[it] = (f32x4){bflo(xn[it].x), bfhi(xn[it].x), bflo(xn[it].y), bfhi(xn[it].y)};
        if (k0 + 64 < 1024) {
#pragma unroll
            for (int it = 0; it < 8; ++it) xn[it] = *(const u32x2*)(X1 + (size_t)(tb + 4 * it + rsub) * 1024 + k0 + 64 + 4 * c4); }
        float bw[32];
#pragma unroll
        for (int s = 0; s < 4; ++s)
#pragma unroll
            for (int j = 0; j < 8; ++j) bw[8 * s + j] = p->w_router[(size_t)(k0 + 16 * s + 8 * hi + j) * 32 + r32];
        const f32x4 scv = *(const f32x4*)(sc2 + k0 + 4 * c4) + 1.0f, shv = *(const f32x4*)(sh2 + k0 + 4 * c4);
#pragma unroll
        for (int it = 0; it < 8; ++it) { const int row = 4 * it + rsub;
            const f32x4 hv = xc[it] * rs[it] * scv + shv; *(f32x4*)(XS + row * 68 + 4 * c4) = hv;
            *(unsigned*)(H8 + (size_t)(tb + row) * 1024 + k0 + 4 * c4) = pg8::pk4_fp8(hv[0], hv[1], hv[2], hv[3]); }
        asm volatile("s_waitcnt lgkmcnt(0)" ::: "memory");
#pragma unroll
        for (int s = 0; s < 4; ++s) { const f32x4 a0 = *(const f32x4*)(XS + r32 * 68 + 16 * s + 8 * hi), a1 = *(const f32x4*)(XS + r32 * 68 + 16 * s + 8 * hi + 4);
            const float av[8] = {a0[0], a0[1], a0[2], a0[3], a1[0], a1[1], a1[2], a1[3]};
            u32x4 ah, al, bh, bl; unsigned* ahp = (unsigned*)&ah; unsigned* alp = (unsigned*)&al; unsigned* bhp = (unsigned*)&bh; unsigned* blp = (unsigned*)&bl;
#pragma unroll
            for (int q = 0; q < 4; ++q) { const unsigned h = cvtpk(av[2 * q], av[2 * q + 1]); ahp[q] = h; alp[q] = cvtpk(av[2 * q] - bflo(h), av[2 * q + 1] - bfhi(h));
                const float b0 = bw[8 * s + 2 * q], b1 = bw[8 * s + 2 * q + 1]; const unsigned g = cvtpk(b0, b1); bhp[q] = g; blp[q] = cvtpk(b0 - bflo(g), b1 - bfhi(g)); }
            acc = __builtin_amdgcn_mfma_f32_32x32x16_bf16(__builtin_bit_cast(bf16x8, ah), __builtin_bit_cast(bf16x8, bh), acc, 0, 0, 0);
            acc = __builtin_amdgcn_mfma_f32_32x32x16_bf16(__builtin_bit_cast(bf16x8, ah), __builtin_bit_cast(bf16x8, bl), acc, 0, 0, 0);
            acc = __builtin_amdgcn_mfma_f32_32x32x16_bf16(__builtin_bit_cast(bf16x8, al), __builtin_bit_cast(bf16x8, bh), acc, 0, 0, 0); }
        asm volatile("s_waitcnt lgkmcnt(0)" ::: "memory");
    }
#pragma unroll
    for (int r = 0; r < 16; ++r) XS[((r & 3) + 8 * (r >> 2) + 4 * hi) * 33 + r32] = acc[r];
    asm volatile("s_waitcnt lgkmcnt(0)" ::: "memory");
    int e1 = 0, e2 = 0, rk1 = 0, rk2 = 0; float gw1 = 0.f, gw2 = 0.f;
    if (lane < 32) {
        float s[32], sel[32];
#pragma unroll
        for (int e = 0; e < 32; ++e) { const float lg = XS[lane * 33 + e]; s[e] = __builtin_amdgcn_rcpf(1.0f + __expf(-lg)); sel[e] = s[e] + p->b_router[e]; }
        float best = 0.f; int gi = 0;
#pragma unroll
        for (int g = 0; g < 4; ++g) { float m1 = -INFINITY, m2 = -INFINITY;
#pragma unroll
            for (int j = 0; j < 8; ++j) { const float v = sel[8 * g + j]; if (v > m1) { m2 = m1; m1 = v; } else if (v > m2) m2 = v; }
            const float gs = m1 + m2; if (g == 0 || gs > best) { best = gs; gi = g; } }
        float ig[8], sg[8];
#pragma unroll
        for (int j = 0; j < 8; ++j) { ig[j] = gi == 0 ? sel[j] : gi == 1 ? sel[8 + j] : gi == 2 ? sel[16 + j] : sel[24 + j]; sg[j] = gi == 0 ? s[j] : gi == 1 ? s[8 + j] : gi == 2 ? s[16 + j] : s[24 + j]; }
        int l1 = 0; float v1 = ig[0], w1 = sg[0];
#pragma unroll
        for (int j = 1; j < 8; ++j) if (ig[j] > v1) { v1 = ig[j]; l1 = j; w1 = sg[j]; }
        int l2 = l1 ^ 1; float v2 = -INFINITY, w2 = 0.f;
#pragma unroll
        for (int j = 0; j < 8; ++j) if (j != l1 && (ig[j] > v2 || (j == (l1 ^ 1) && v2 == -INFINITY))) { v2 = ig[j]; l2 = j; w2 = sg[j]; }
        e1 = 8 * gi + l1; e2 = 8 * gi + l2; const float inv = 1.0f / (w1 + w2); gw1 = w1 * inv; gw2 = w2 * inv;
    }
    __syncthreads();
    if (lane < 32) { rk1 = atomicAdd(&H[e1], 1); rk2 = atomicAdd(&H[e2], 1); }
    __syncthreads();
    if (tid < 32) HB[tid] = atomicAdd(&CNT[tid], H[tid]);
    __syncthreads();
    if (lane < 32) { const int t = tb + lane; const int p1 = HB[e1] + rk1, p2 = HB[e2] + rk2;
        TOK[e1 * 65536 + p1] = 2 * t; TOK[e2 * 65536 + p2] = 2 * t + 1;
        GWL[2 * t] = gw1; GWL[2 * t + 1] = gw2; ((int*)(GWL + 2 * T))[2 * t] = (e1 << 16) | p1; ((int*)(GWL + 2 * T))[2 * t + 1] = (e2 << 16) | p2; }
    __syncthreads();
}
__device__ __forceinline__ void moe_tables(unsigned char* lds, CP p, int l, int tid) {
    int* tab = (int*)(lds + LDS_SPARE); const int* CNT = (const int*)(p->ws + WS_CTL) + 64 + l * 64;
    __syncthreads();
    if (tid < 64) {
        const int c = tid < 32 ? CNT[tid] : 0; int v = (c + 255) >> 8; const int own = v;
#pragma unroll
        for (int o = 1; o < 32; o <<= 1) { const int n = __shfl_up(v, o); if ((tid & 31) >= o) v += n; }
        if (tid < 32) { tab[2 + tid] = v - own; tab[34 + tid] = c; if (tid == 31) { tab[0] = v; tab[1] = (v + 7) & ~7; } }
    }
    __syncthreads();
    const int Rt = tab[0];
    for (int rt = tid; rt < Rt; rt += 512) { int e = 0;
#pragma unroll 1
        for (int q = 1; q < 32; ++q) if (tab[2 + q] <= rt) e = q;
        tab[128 + rt] = e; }
    __syncthreads();
}
constexpr int ROWTAB_OFF = LDS_SPARE + 4096, ROWTAB_UNITS = (LDS_BYTES - 64 - ROWTAB_OFF) / 1024;
__device__ __forceinline__ void moe_rowtab(unsigned char* lds, CP p, int G, int bx, int tid) {
    const int* tab = (const int*)(lds + LDS_SPARE); int* rowtab = (int*)(lds + ROWTAB_OFF); const int* TOK = (const int*)(p->ws + WS_TOK);
    pg8::MoeOrder S{(const PG8_LAS int*)(lds + LDS_SPARE), G, bx};
    int tv[ROWTAB_UNITS]; int nu = 0;
#pragma unroll
    for (int i = 0; i < ROWTAB_UNITS; ++i) { pg8::Unit u; tv[i] = 0;
        if (S.next(i, u)) { nu = i + 1; const int valid = u.x0 >> 8, e = u.x0 & 0xff, pos = u.x1 + tid;
            if (tid < 256 && valid && pos < tab[34 + e]) tv[i] = TOK[e * 65536 + pos] >> 1; } }
#pragma unroll
    for (int i = 0; i < ROWTAB_UNITS; ++i) if (i < nu && tid < 256) rowtab[i * 256 + tid] = tv[i];
    __syncthreads();
}
template <int NR>
__device__ __forceinline__ void combine_loop(CP p, int l, int gw, int ngw, int lane) {
    const bf16* XB = (const bf16*)(p->ws + WS_XB); const unsigned char* Yb = p->ws + WS_Y2;
    const float* GWT = (const float*)(p->ws + WS_GWL); const int* SLW = (const int*)(GWT + 2 * T);
    int sb; { const int* CNT = (const int*)(p->ws + WS_CTL) + 64 + l * 64; const int c = lane < 32 ? CNT[lane] : 0; int v = ((c + 255) >> 8) * 256; const int own = v;
#pragma unroll
        for (int o = 1; o < 32; o <<= 1) { const int n = __shfl_up(v, o); if ((lane & 31) >= o) v += n; }
        sb = v - own; }
    const int rpw = (((T + ngw - 1) / ngw) + NR - 1) / NR * NR, tfirst = gw * rpw, tlast = (tfirst + rpw) < T ? (tfirst + rpw) : T;
    struct Set { u32x2 xw[NR][4]; unsigned y0[NR][4], y1[NR][4]; float gA[NR], gB[NR]; int sA[NR], sB[NR]; };
    Set A, B;
    f32x4 g2v[4], scv[4];
#define CB_IDX(S_, TB) do { _Pragma("unroll") for (int r = 0; r < NR; ++r) { const int t_ = (TB) + r; S_.sA[r] = SLW[2 * t_]; S_.sB[r] = SLW[2 * t_ + 1]; } } while (0)
#define CB_LOAD(S_, TB) do { _Pragma("unroll") for (int r = 0; r < NR; ++r) { const int t_ = (TB) + r; \
        const int ra_ = __shfl(sb, S_.sA[r] >> 16) + (S_.sA[r] & 0xffff), rb_ = __shfl(sb, S_.sB[r] >> 16) + (S_.sB[r] & 0xffff); \
        const u32x2* xr_ = (const u32x2*)(XB + (size_t)t_ * 1024) + lane; const unsigned* ya_ = (const unsigned*)(Yb + (size_t)ra_ * 1024) + lane; const unsigned* yb_ = (const unsigned*)(Yb + (size_t)rb_ * 1024) + lane; \
        S_.gA[r] = GWT[2 * t_]; S_.gB[r] = GWT[2 * t_ + 1]; \
        _Pragma("unroll") for (int j = 0; j < 4; ++j) { S_.xw[r][j] = xr_[64 * j]; S_.y0[r][j] = ya_[64 * j]; S_.y1[r][j] = yb_[64 * j]; } } } while (0)
#pragma unroll 1
    for (int t0 = tfirst; t0 < tlast; ) {
    const int tend = (((t0 >> 11) + 1) << 11) < tlast ? (((t0 >> 11) + 1) << 11) : tlast;
    { const int bcur = t0 >> 11;
      const f32x4* g2 = (const f32x4*)((const float*)(p->ws + WS_MOD) + (size_t)(l * 32 + bcur) * 6144 + 5 * 1024) + lane;
      const f32x4* sc = (const f32x4*)((const float*)(p->ws + WS_MOD) + (size_t)((l + 1 < DEPTH ? l + 1 : l) * 32 + bcur) * 6144 + 1024) + lane;
#pragma unroll
      for (int j = 0; j < 4; ++j) { g2v[j] = g2[64 * j]; scv[j] = l + 1 < DEPTH ? sc[64 * j] + 1.0f : ((const f32x4*)p->final_g + lane)[64 * j]; } }
    CB_IDX(A, t0); if (t0 + NR < tend) CB_IDX(B, t0 + NR);
    CB_LOAD(A, t0);
    auto step = [&](auto allc, Set& cur, Set& nxt, const int tb) __attribute__((always_inline)) { constexpr bool ALL = decltype(allc)::value;
        if (ALL || tb + 2 * NR < tend) CB_IDX(cur, tb + 2 * NR);
        asm volatile("" ::: "memory");
        if (ALL || tb + NR < tend) CB_LOAD(nxt, tb + NR);
        asm volatile("" ::: "memory");
        f32x4 v[NR][4]; float s[NR];
#pragma unroll
        for (int r = 0; r < NR; ++r) { s[r] = 0.f;
#pragma unroll
            for (int j = 0; j < 4; ++j) { const unsigned a = cur.y0[r][j], bq = cur.y1[r][j]; const u32x2 xq = cur.xw[r][j];
                typedef float f2_ __attribute__((ext_vector_type(2)));
                const f2_ a01 = __builtin_amdgcn_cvt_pk_f32_fp8((int)a, false), a23 = __builtin_amdgcn_cvt_pk_f32_fp8((int)a, true), b01 = __builtin_amdgcn_cvt_pk_f32_fp8((int)bq, false), b23 = __builtin_amdgcn_cvt_pk_f32_fp8((int)bq, true);
                f32x4 ys = {cur.gA[r] * a01[0] + cur.gB[r] * b01[0], cur.gA[r] * a01[1] + cur.gB[r] * b01[1], cur.gA[r] * a23[0] + cur.gB[r] * b23[0], cur.gA[r] * a23[1] + cur.gB[r] * b23[1]};
                if (!((MK_MASK >> 10) & 1)) ys = (f32x4){0.f, 0.f, 0.f, 0.f};
                const f32x4 xv = {bflo(xq.x), bfhi(xq.x), bflo(xq.y), bfhi(xq.y)};
                v[r][j] = xv + g2v[j] * ys; s[r] += (v[r][j][0] * v[r][j][0] + v[r][j][1] * v[r][j][1]) + (v[r][j][2] * v[r][j][2] + v[r][j][3] * v[r][j][3]); } }
#pragma unroll
        for (int o = 1; o < 64; o <<= 1) {
#pragma unroll
            for (int r = 0; r < NR; ++r) s[r] += __shfl_xor(s[r], o); }
#pragma unroll
        for (int r = 0; r < NR; ++r) { const int t = tb + r;
            if (t < tend) {
            const float rstd = __builtin_amdgcn_rsqf(s[r] * (1.f / 1024.f) + EPS);
            if (l + 1 < DEPTH) {
                u32x2* xo = (u32x2*)((bf16*)(p->ws + WS_XB) + (size_t)t * 1024) + lane;
                u32x2* o = (u32x2*)((bf16*)(p->ws + WS_ABUF) + (size_t)t * 1024) + lane;
#pragma unroll
                for (int j = 0; j < 4; ++j) { u32x2 xq; xq.x = cvtpk(v[r][j][0], v[r][j][1]); xq.y = cvtpk(v[r][j][2], v[r][j][3]); xo[64 * j] = xq; const f32x4 w = v[r][j] * scv[j]; u32x2 q; q.x = cvtpk(w[0], w[1]); q.y = cvtpk(w[2], w[3]); o[64 * j] = q; }
                if (lane == 0) ((float*)(p->ws + WS_RSTD))[t] = rstd;
            } else {
                f32x4* xr = (f32x4*)(p->out + (size_t)t * 1024) + lane;
#pragma unroll
                for (int j = 0; j < 4; ++j) xr[64 * j] = v[r][j] * rstd * scv[j];
            } } }
        asm volatile("" ::: "memory");
    };
    int tb = t0;
#pragma unroll 1
    for (; tb + 3 * NR < tend; tb += 2 * NR) { step(BoolC<true>{}, A, B, tb); step(BoolC<true>{}, B, A, tb + NR); }
#pragma unroll 1
    for (; tb < tend; tb += 2 * NR) { step(BoolC<false>{}, A, B, tb); if (tb + NR < tend) step(BoolC<false>{}, B, A, tb + NR); }
    t0 = tend; }
#undef CB_LOAD
#undef CB_IDX
}

#define PHASE_ENTER \
        CP p = (CP)__builtin_amdgcn_kernarg_segment_ptr(); asm volatile("" : "+s"(p)); \
        int tid = threadIdx.x; asm volatile("" : "+v"(tid)); \
        const int lane = tid & 63, wave = __builtin_amdgcn_readfirstlane(tid >> 6); \
        int G = gridDim.x, bx = blockIdx.x; asm volatile("" : "+s"(G), "+s"(bx)); \
        const int vcu = (G % 8 == 0) ? (bx % 8) * (G / 8) + bx / 8 : bx; \
        const int gw = vcu * 8 + wave, NGW = G * 8; \
        unsigned char* ws = p->ws; float* MOD = (float*)(ws + WS_MOD); \
        (void)lane; (void)wave; (void)gw; (void)NGW; (void)MOD; (void)vcu;
#define RUN_PHASE(k, c, LL, ...) \
    if (p0.ph_lo <= (k) && (k) < p0.ph_hi) { \
        const unsigned long long tph0 = MK_DIL ? __builtin_amdgcn_s_memrealtime() : 0ull; \
        if ((MK_MASK >> (c)) & 1) { \
            _Pragma("unroll 1") for (int rep = 0; rep < ((((MK_REP >> (c)) & 1) && !((c) == 6 && (LL) == 1)) ? 2 : 1); ++rep) { PHASE_ENTER __VA_ARGS__ } } \
        if ((k) + 1 < p0.ph_hi) { if (p0.ph_lo < 0) grid.sync(); else xcd_barrier(bar); }     \
        if (MK_DIL && ((MK_DIL >> (c)) & 1)) { const unsigned long long t1 = __builtin_amdgcn_s_memrealtime(), dt = t1 - tph0; while (__builtin_amdgcn_s_memrealtime() - t1 < dt) __builtin_amdgcn_s_sleep(8); } \
    }
#define LAYER_PHASES(l) \
    RUN_PHASE(2 + 8 * (l), 2, l, {     \
        pg8::Gemm g{(const bf16*)(ws + WS_ABUF), (const bf16*)(ws + WS_WIN) + (size_t)(l) * ZP * 1024, T, ZP, 1024}; pg8::StaticOrder S; S.init(T, ZP, G, bx); \
        pg8::EpiZ E{(bf16*)(ws + WS_Z), (const float*)(ws + WS_RSTD), (const float*)(ws + WS_BIASIN) + (size_t)(l) * 32 * ZP, ZP, DIN}; \
        pg8::gemm_phase<pg8::EpiZ, pg8::StaticOrder, true, true>((PG8_LAS unsigned char*)lds, g, S, E); }) \
    RUN_PHASE(3 + 8 * (l), 3, l, {     \
        for (int item = vcu; item < 256; item += G) gla_chain(lds, p, l, item, tid, lane, wave); \
        pool_phase(lds, p, l, vcu, G, tid, lane, wave); if (MK_POOL2) pool_phase(lds, p, l, vcu, G, tid, lane, wave); }) \
    RUN_PHASE(4 + 8 * (l), 5, l, { gla_stepC_phase(lds, p, l, vcu, G, tid, lane, wave); }) \
    RUN_PHASE(5 + 8 * (l), 6, l, {     \
        pg8::Gemm g{(const bf16*)(ws + WS_ABUF), (const bf16*)(ws + WS_WOUT + (size_t)(l) * 1024 * 1024), T, 1024, 512}; pg8::StaticOrder S; S.init(T, 1024, G, bx);     \
        pg8::EpiRes E{(l) == 0 ? p->x : nullptr, (const bf16*)(ws + WS_XB), (bf16*)(ws + WS_XB), MOD + (size_t)(l) * 32 * 6144 + 2 * 1024, (float*)(ws + WS_ROWSQ)}; \
        pg8::gemm_phase<pg8::EpiRes, pg8::StaticOrder, true, true, true>((PG8_LAS unsigned char*)lds, g, S, E); }) \
    RUN_PHASE(6 + 8 * (l), 7, l, { for (int tile = vcu; tile < T / 256; tile += G) router_tile(lds, p, l, tile, tid, lane, wave); }) \
    RUN_PHASE(7 + 8 * (l), 9, l, {     \
        moe_tables(lds, p, l, tid); moe_rowtab(lds, p, G, bx, tid); \
        pg8::Gemm g{(const bf16*)(ws + WS_ABUF), (const bf16*)(ws + WS_W13 + (size_t)(l) * 32 * 1024 * 1024), T, 32 * 1024, 512};     \
        pg8::MoeOrderG S; S.tab = (const PG8_LAS int*)(lds + LDS_SPARE); S.G = G; S.c = bx; S.rowtab = (const PG8_LAS int*)(lds + ROWTAB_OFF); pg8::EpiAct E{ws + WS_ACT}; \
        pg8::gemm_phase_gather<pg8::EpiAct, pg8::MoeOrderG, true, true, true>((PG8_LAS unsigned char*)lds, g, S, E); }) \
    RUN_PHASE(8 + 8 * (l), 10, l, { \
        moe_tables(lds, p, l, tid); \
        pg8::Gemm g{(const bf16*)(ws + WS_ACT), (const bf16*)(ws + WS_W2 + (size_t)(l) * 32 * 1024 * 512), HS_ROWS, 32 * 1024, 256};     \
        pg8::MoeOrder S{(const PG8_LAS int*)(lds + LDS_SPARE), G, bx}; \
        pg8::EpiY E{ws + WS_Y2}; \
        pg8::gemm_phase<pg8::EpiY, pg8::MoeOrder, true, true, true>((PG8_LAS unsigned char*)lds, g, S, E); }) \
    RUN_PHASE(9 + 8 * (l), 11, l, { combine_loop<2>(p, l, gw, NGW, lane); })

constexpr int NPHASE = 2 + 8 * DEPTH;
__global__ void __launch_bounds__(512, 2) fwd_kernel(Params p0) {
    extern __shared__ __attribute__((aligned(16))) unsigned char lds[];
    cg::grid_group grid = cg::this_grid();
    if (threadIdx.x < 2) ((LAS unsigned*)(lds + LDS_BYTES - 64))[threadIdx.x] = 0u;
    __syncthreads();
    const XcdBarrier bar = xcd_barrier_post((unsigned*)(p0.ws + WS_CTL) + 4096, (volatile LAS unsigned*)(lds + LDS_BYTES - 64));
    RUN_PHASE(0, 0, 0, {
        if (vcu < 192) { const int l2 = vcu / 96, n0 = (vcu % 96) * 64;
            gemv32_item(lds, p->c, 1024, true, p->w_mod + (size_t)l2 * 1024 * 6144, 6144, 6144, 6144, n0, p->b_mod + l2 * 6144, MOD + (size_t)l2 * 32 * 6144, 6144, tid, lane, wave); }
        asm volatile("" : "+v"(tid));
        { u32x4* z = (u32x4*)(ws + WS_WIN); const u32x4 zero = {0u, 0u, 0u, 0u};
          for (int i = bx * 512 + tid; i < 2 * 224 * 128; i += G * 512) { const int l2 = i / (224 * 128), r = i % (224 * 128); z[(size_t)l2 * 2304 * 128 + 2080 * 128 + r] = zero; } }
        {
            float* scr = (float*)(lds + wave * 16384);
            for (int it = gw; it < 32; it += NGW) { const int l2 = it / 16; p0_transpose_item(p->w_in + (size_t)l2 * 1024 * DIN, 1024, DIN, (bf16*)(ws + WS_WIN) + (size_t)l2 * ZP * 1024, 0, scr, (it % 16) * 65 + 64, tid & 63); }
        }
        __syncthreads();
        {
            float* TL = (float*)lds; f32x4 regs[8];
            int t = vcu; P0Tile cur = p0_tile(p, ws, t < P0_NTILES ? t : 0);
            if (t < P0_NTILES) p0_tile_load(regs, cur.W, cur.N, cur.k0, cur.n0, tid);
            _Pragma("unroll 1")
            for (; t < P0_NTILES; t += G) {
                p0_tile_to_lds(TL, regs, tid);
                const int tn = t + G; P0Tile nxt = p0_tile(p, ws, tn < P0_NTILES ? tn : 0);
                if (tn < P0_NTILES) p0_tile_load(regs, nxt.W, nxt.N, nxt.k0, nxt.n0, tid);
                LBAR();
                if (cur.f8) p0_tile_store8(TL, (unsigned char*)cur.WT, cur.K, cur.k0, cur.rbase, cur.perm, tid); else p0_tile_store(TL, cur.WT, cur.K, cur.k0, cur.rbase, cur.perm, tid);
                LBAR();
                cur = nxt;
            }
        }
    })
    RUN_PHASE(1, 1, 0, {
        if (vcu < 72) { const int l2 = vcu / 36, n0 = (vcu % 36) * 64;
            gemv32_item(lds, MOD + (size_t)l2 * 32 * 6144, 6144, false, p->w_in + (size_t)l2 * 1024 * DIN, DIN, DIN, ZP, n0, nullptr, (float*)(ws + WS_BIASIN) + (size_t)l2 * 32 * ZP, ZP, tid, lane, wave); }
        int lane2 = lane; asm volatile("" : "+v"(lane2));
        rows_prep_loop<2>(p->x, MOD, (bf16*)(ws + WS_ABUF), (float*)(ws + WS_RSTD), gw, NGW, lane2);
    })
    LAYER_PHASES(0)
    LAYER_PHASES(1)
}

extern "C" void kernel_launch(void* const* d_in, const int* in_sizes, int n_in, void* d_out, int out_size, void* d_ws, size_t ws_size, hipStream_t stream) {
    static int grid = 0;
    if (grid == 0) {
        if (n_in != 17 || out_size != T * DM || ws_size < WS_END) { fprintf(stderr, "kernel_launch: unexpected shapes: n_in %d out %d ws %zu (need %zu)\n", n_in, out_size, ws_size, (size_t)WS_END); grid = -1; return; }
        int dev = 0, cus = 0, per_cu = 0;
        (void)hipGetDevice(&dev); (void)hipDeviceGetAttribute(&cus, hipDeviceAttributeMultiprocessorCount, dev);
        (void)hipFuncSetAttribute((const void*)fwd_kernel, hipFuncAttributeMaxDynamicSharedMemorySize, LDS_BYTES);
        (void)hipOccupancyMaxActiveBlocksPerMultiprocessor(&per_cu, (const void*)fwd_kernel, 512, LDS_BYTES);
        if (per_cu < 1) { fprintf(stderr, "kernel_launch: occupancy query says %d blocks per CU\n", per_cu); grid = -1; return; }
        grid = cus;
    }
    if (grid < 0) return;
    (void)hipMemsetAsync((char*)d_ws + WS_CTL, 0, 65536, stream);
    Params p{};
    const float** pp = (const float**)&p;
    for (int i = 0; i < 17; ++i) pp[i] = (const float*)d_in[i];
    p.out = (float*)d_out; p.ws = (unsigned char*)d_ws;
#if MK_MULTI
    for (int k = 0; k < NPHASE; ++k) { p.ph_lo = k; p.ph_hi = k + 1; void* args[] = {&p};
        hipError_t e = hipLaunchCooperativeKernel((const void*)fwd_kernel, dim3(grid), dim3(512), args, LDS_BYTES, stream);
        if (e != hipSuccess) { fprintf(stderr, "launch of phase %d failed: %s\n", k, hipGetErrorString(e)); break; } }
#else
    p.ph_lo = 0; p.ph_hi = NPHASE; void* args[] = {&p};
    hipError_t e = hipLaunchCooperativeKernel((const void*)fwd_kernel, dim3(grid), dim3(512), args, LDS_BYTES, stream);
    if (e != hipSuccess) fprintf(stderr, "cooperative launch failed: %s (grid %d)\n", hipGetErrorString(e), grid);
#endif
}
```

```cpp
#include <hip/hip_runtime.h>
#include <hip/hip_cooperative_groups.h>
#include <cstdio>
#include <cstdint>
namespace cg = cooperative_groups;

#ifndef MK_MASK
#define MK_MASK 0xFFF
#endif
#ifndef MK_REP
#define MK_REP 0
#endif
#ifndef MK_DIL
#define MK_DIL 0
#endif
#ifndef MK_POOL2
#define MK_POOL2 0
#endif
#ifndef MK_MULTI
#define MK_MULTI 0
#endif

constexpr int DM = 1024, NB = 32, SEQ = 2048, T = NB * SEQ, DEPTH = 2;
constexpr int DIN = 2080, ZP = 2304;
constexpr int C_Q = 512, C_K = 768, C_V = 1024, C_G = 1536, C_RF = 2048;
constexpr int NE = 32, DFF = 512;
constexpr int HS_ROWS = 139264;
constexpr float EPS = 1e-6f;

constexpr size_t MiB = 1u << 20;
constexpr size_t WS_CTL = 0;
constexpr size_t WS_MOD = 1 * MiB;
constexpr size_t WS_BIASIN = 3 * MiB;
constexpr size_t WS_RSTD = 4 * MiB;
constexpr size_t WS_ROWSQ = 5 * MiB;
constexpr size_t WS_DEC = 9 * MiB;
constexpr size_t WS_TOK = 11 * MiB;
constexpr size_t WS_GWL = 19 * MiB;
constexpr size_t WS_WPT = 28 * MiB;
constexpr size_t WS_WOUT = 29 * MiB;
constexpr size_t WS_WIN = 33 * MiB;
constexpr size_t WS_W2 = 42 * MiB;
constexpr size_t WS_W13 = 106 * MiB;
constexpr size_t WS_ABUF = 234 * MiB;
constexpr size_t WS_R = 362 * MiB;
constexpr size_t WS_Z = WS_R;
constexpr size_t WS_ST = WS_R + 288 * MiB;
constexpr size_t WS_HS = WS_R;
constexpr size_t WS_Y2 = WS_R;
constexpr size_t WS_ACT = WS_R + 272 * MiB;
constexpr size_t WS_BCG = WS_R + 416 * MiB;
constexpr size_t WS_XB = WS_R + 480 * MiB;
constexpr size_t WS_END = WS_R + 608 * MiB;
constexpr int LDS_BYTES = 147456;
constexpr int LDS_SPARE = 131072;

typedef unsigned short bf16;
typedef float f32x4 __attribute__((ext_vector_type(4)));
typedef float f32x16 __attribute__((ext_vector_type(16)));
typedef short bf16x8 __attribute__((ext_vector_type(8)));
typedef unsigned u32x4 __attribute__((ext_vector_type(4)));
typedef unsigned u32x2 __attribute__((ext_vector_type(2)));
typedef float f32x2_t __attribute__((ext_vector_type(2)));
typedef __bf16 bf16x2_t __attribute__((ext_vector_type(2)));

__device__ __forceinline__ unsigned cvtpk(float lo, float hi) { f32x2_t v = {lo, hi}; bf16x2_t b = __builtin_convertvector(v, bf16x2_t); return __builtin_bit_cast(unsigned, b); }
__device__ __forceinline__ unsigned short f2bf(float f) { return (unsigned short)(cvtpk(f, 0.f) & 0xffffu); }
__device__ __forceinline__ float bflo(unsigned u) { return __uint_as_float(u << 16); }
__device__ __forceinline__ float bfhi(unsigned u) { return __uint_as_float(u & 0xffff0000u); }
__device__ __forceinline__ float siluf(float x) { return x * __builtin_amdgcn_rcpf(1.0f + __expf(-x)); }
__device__ __forceinline__ float wave_sum(float v) {
#pragma unroll
    for (int o = 1; o < 64; o <<= 1) v += __shfl_xor(v, o);
    return v;
}

namespace pg8 {
#define PG8_LAS __attribute__((address_space(3)))
typedef unsigned short bf16_t;
typedef short bf16x8 __attribute__((ext_vector_type(8)));
typedef float f32x4 __attribute__((ext_vector_type(4)));
typedef unsigned u32x4 __attribute__((ext_vector_type(4)));
typedef int v8i_t __attribute__((ext_vector_type(8)));
typedef int v4i_t __attribute__((ext_vector_type(4)));
__device__ __forceinline__ v8i_t cat8(bf16x8 a, bf16x8 b) { return __builtin_shufflevector(__builtin_bit_cast(v4i_t, a), __builtin_bit_cast(v4i_t, b), 0, 1, 2, 3, 4, 5, 6, 7); }
constexpr int BM = 256, BK = 64, HALF = 128, HTB = HALF * BK * 2  , STAGE_BYTES = 8 * HTB, NXCD = 8, WGM = 8;

__host__ __device__ __forceinline__ int lds_byte(int r, int c) { const int st = (r >> 4) * 2 + (c >> 5), rr = r & 15, cc = c & 31, ob = rr * 64 + cc * 2; return st * 1024 + (ob ^ (((ob >> 9) & 1) << 5)); }
__host__ __device__ __forceinline__ void stage_rc(int b, int& R, int& C) { const int st = b / 1024, sb = b % 1024, swz = sb ^ (((sb >> 9) & 1) << 5); R = (st >> 1) * 16 + swz / 64; C = (st & 1) * 32 + (swz % 64) / 2; }
__host__ __device__ __forceinline__ int perm32(int rho) { const int n = rho >> 4, i = rho & 15; return 8 * (i >> 2) + 4 * n + (i & 3); }

struct Unit { int pm, pn, x0, x1; };
struct Gemm { const bf16_t* A; const bf16_t* Bt; int M, N, K; };

struct StaticOrder {
    int nM, nN, nwg, G, c;
    __host__ __device__ void init(int M, int N, int G_, int c_) { nM = M / BM; nN = N / BM; nwg = nM * nN; G = G_; c = c_; }
    __host__ __device__ bool next(int i, Unit& u) const {
        const long L = (long)i * G + c; if (L >= nwg) return false;
        int wgid = (int)L; { const int q = nwg / NXCD, r = nwg % NXCD, xcd = wgid % NXCD, off = wgid / NXCD; wgid = (xcd < r ? xcd * (q + 1) : r * (q + 1) + (xcd - r) * q) + off; }
        const int nig = WGM * nN, gid = wgid / nig, fm = gid * WGM, gsz = (nM - fm) < WGM ? (nM - fm) : WGM;
        u.pm = fm + ((wgid % nig) % gsz); u.pn = (wgid % nig) / gsz; return true;
    }
    __device__ __forceinline__ void a_ready(const Unit&) const {}
    __device__ __forceinline__ void done(const Unit&) const {}
};


__device__ __forceinline__ unsigned pk2(float lo, float hi) { typedef float v2f __attribute__((ext_vector_type(2))); typedef __bf16 v2b __attribute__((ext_vector_type(2))); v2f v = {lo, hi}; v2b b = __builtin_convertvector(v, v2b); return __builtin_bit_cast(unsigned, b); }
struct EpiZ {
    static constexpr bool PERM = true, AFTER_DRAIN = false;
    bf16_t* Z; const float* rstd; const float* bias; int zp, ncols;
    __device__ __forceinline__ void operator()(const f32x4 (&acc)[2][2][4][2], const Unit& u, int wr, int wc, int fr, int fq) const {
        const int row0 = u.pm * BM + wr * 64 + fr, col0 = u.pn * BM + wc * 64 + 8 * fq;
        const float* bp = bias + (size_t)((u.pm * BM) >> 11) * zp + col0;
        f32x4 bv[2][2];
#pragma unroll
        for (int bj = 0; bj < 2; ++bj)
#pragma unroll
            for (int n = 0; n < 2; ++n) bv[bj][n] = *(const f32x4*)(bp + bj * 32 + 4 * n);
        float rsv[2][4];
#pragma unroll
        for (int ai = 0; ai < 2; ++ai)
#pragma unroll
            for (int m = 0; m < 4; ++m) rsv[ai][m] = rstd[row0 + ai * HALF + m * 16];
#pragma unroll
        for (int ai = 0; ai < 2; ++ai)
#pragma unroll
            for (int m = 0; m < 4; ++m) { const int row = row0 + ai * HALF + m * 16; const float rs = rsv[ai][m]; bf16_t* rowp = Z + (size_t)row * zp + col0;
#pragma unroll
                for (int bj = 0; bj < 2; ++bj) { if (col0 + bj * 32 >= ncols) continue; const f32x4 v0 = acc[ai][bj][m][0] * rs + bv[bj][0], v1 = acc[ai][bj][m][1] * rs + bv[bj][1];
                    u32x4 w; w.x = pk2(v0[0], v0[1]); w.y = pk2(v0[2], v0[3]); w.z = pk2(v1[0], v1[1]); w.w = pk2(v1[2], v1[3]);
                    *(u32x4*)(rowp + bj * 32) = w; } }
    }
};
struct EpiRes {
    static constexpr bool PERM = true, AFTER_DRAIN = false;
    const float* xf; const bf16_t* xb; bf16_t* out; const float* g1; float* rowsq;
    __device__ __forceinline__ void operator()(const f32x4 (&acc)[2][2][4][2], const Unit& u, int wr, int wc, int fr, int fq) const {
        const int row0 = u.pm * BM + wr * 64 + fr, col0 = u.pn * BM + wc * 64 + 8 * fq;
        const float* gp = g1 + (size_t)((u.pm * BM) >> 11) * 6144 + col0;
        f32x4 gv[2][2];
#pragma unroll
        for (int bj = 0; bj < 2; ++bj)
#pragma unroll
            for (int n = 0; n < 2; ++n) gv[bj][n] = *(const f32x4*)(gp + bj * 32 + 4 * n);
        if (!xf) {
            u32x4 xw[2][2], xn[2][2];
#define ER_LOAD(DST, AM) do { _Pragma("unroll") for (int mm = 0; mm < 2; ++mm) _Pragma("unroll") for (int bj = 0; bj < 2; ++bj) \
                DST[mm][bj] = *(const u32x4*)(xb + (size_t)(row0 + ((AM) >> 1) * HALF + (((AM) & 1) * 2 + mm) * 16) * 1024 + col0 + bj * 32); } while (0)
            ER_LOAD(xw, 0);
#pragma unroll
            for (int am = 0; am < 4; ++am) { const int ai = am >> 1, m0 = (am & 1) * 2;
                if (am < 3) ER_LOAD(xn, am + 1);
#pragma unroll
                for (int mm = 0; mm < 2; ++mm) { const int m = m0 + mm, row = row0 + ai * HALF + m * 16; const size_t off = (size_t)row * 1024 + col0; float s = 0.f;
#pragma unroll
                    for (int bj = 0; bj < 2; ++bj) { const u32x4 w = xw[mm][bj];
                        const f32x4 x0 = {__uint_as_float(w.x << 16), __uint_as_float(w.x & 0xffff0000u), __uint_as_float(w.y << 16), __uint_as_float(w.y & 0xffff0000u)};
                        const f32x4 x1 = {__uint_as_float(w.z << 16), __uint_as_float(w.z & 0xffff0000u), __uint_as_float(w.w << 16), __uint_as_float(w.w & 0xffff0000u)};
                        const f32x4 o0 = x0 + gv[bj][0] * acc[ai][bj][m][0], o1 = x1 + gv[bj][1] * acc[ai][bj][m][1];
                        s += ((o0[0] * o0[0] + o0[1] * o0[1]) + (o0[2] * o0[2] + o0[3] * o0[3])) + ((o1[0] * o1[0] + o1[1] * o1[1]) + (o1[2] * o1[2] + o1[3] * o1[3]));
                        u32x4 q; q.x = pk2(o0[0], o0[1]); q.y = pk2(o0[2], o0[3]); q.z = pk2(o1[0], o1[1]); q.w = pk2(o1[2], o1[3]);
                        *(u32x4*)(out + off + bj * 32) = q; }
                    s += __shfl_xor(s, 16); s += __shfl_xor(s, 32);
                    if (fq == 0) rowsq[(size_t)row * 16 + u.pn * 4 + wc] = s; }
#pragma unroll
                for (int mm = 0; mm < 2; ++mm)
#pragma unroll
                    for (int bj = 0; bj < 2; ++bj) xw[mm][bj] = xn[mm][bj];
            }
#undef ER_LOAD
            return;
        }
#pragma unroll
        for (int am = 0; am < 4; ++am) { const int ai = am >> 1, m0 = (am & 1) * 2;
            f32x4 xp[2][2][2];
            if (xf) {
#pragma unroll
                for (int mm = 0; mm < 2; ++mm)
#pragma unroll
                    for (int bj = 0; bj < 2; ++bj)
#pragma unroll
                        for (int n = 0; n < 2; ++n) xp[mm][bj][n] = *(const f32x4*)(xf + (size_t)(row0 + ai * HALF + (m0 + mm) * 16) * 1024 + col0 + bj * 32 + 4 * n);
            } else {
                u32x4 xw[2][2];
#pragma unroll
                for (int mm = 0; mm < 2; ++mm)
#pragma unroll
                    for (int bj = 0; bj < 2; ++bj) xw[mm][bj] = *(const u32x4*)(xb + (size_t)(row0 + ai * HALF + (m0 + mm) * 16) * 1024 + col0 + bj * 32);
#pragma unroll
                for (int mm = 0; mm < 2; ++mm)
#pragma unroll
                    for (int bj = 0; bj < 2; ++bj) { const u32x4 w = xw[mm][bj];
                        xp[mm][bj][0] = (f32x4){__uint_as_float(w.x << 16), __uint_as_float(w.x & 0xffff0000u), __uint_as_float(w.y << 16), __uint_as_float(w.y & 0xffff0000u)};
                        xp[mm][bj][1] = (f32x4){__uint_as_float(w.z << 16), __uint_as_float(w.z & 0xffff0000u), __uint_as_float(w.w << 16), __uint_as_float(w.w & 0xffff0000u)}; }
            }
            asm volatile("" ::: "memory");
#pragma unroll
            for (int mm = 0; mm < 2; ++mm) { const int m = m0 + mm, row = row0 + ai * HALF + m * 16; const size_t off = (size_t)row * 1024 + col0; float s = 0.f;
#pragma unroll
                for (int bj = 0; bj < 2; ++bj) { const f32x4 o0 = xp[mm][bj][0] + gv[bj][0] * acc[ai][bj][m][0], o1 = xp[mm][bj][1] + gv[bj][1] * acc[ai][bj][m][1];
                    s += ((o0[0] * o0[0] + o0[1] * o0[1]) + (o0[2] * o0[2] + o0[3] * o0[3])) + ((o1[0] * o1[0] + o1[1] * o1[1]) + (o1[2] * o1[2] + o1[3] * o1[3]));
                    u32x4 w; w.x = pk2(o0[0], o0[1]); w.y = pk2(o0[2], o0[3]); w.z = pk2(o1[0], o1[1]); w.w = pk2(o1[2], o1[3]);
                    *(u32x4*)(out + off + bj * 32) = w; }
                s += __shfl_xor(s, 16); s += __shfl_xor(s, 32);
                if (fq == 0) rowsq[(size_t)row * 16 + u.pn * 4 + wc] = s; }
            asm volatile("" ::: "memory"); }
    }
};
__device__ __forceinline__ unsigned pk4_fp8(float a, float b, float c, float d) { int w = __builtin_amdgcn_cvt_pk_fp8_f32(a, b, 0, false); w = __builtin_amdgcn_cvt_pk_fp8_f32(c, d, w, true); return (unsigned)w; }
struct EpiAct {
    static constexpr bool PERM = true, AFTER_DRAIN = false;
    unsigned char* ACT;
    __device__ __forceinline__ void operator()(const f32x4 (&acc)[2][2][4][2], const Unit& u, int wr, int wc, int fr, int fq) const {
        if (!(u.x0 >> 8)) return;
        const int ct = u.pn & 3, row0 = u.pm * BM + wr * 64 + fr, col0 = ct * 128 + wc * 32 + 8 * fq;
#pragma unroll
        for (int ai = 0; ai < 2; ++ai)
#pragma unroll
            for (int m = 0; m < 4; ++m) { unsigned char* rowp = ACT + (size_t)(row0 + ai * HALF + m * 16) * 512 + col0;
                float v[8];
#pragma unroll
                for (int n = 0; n < 2; ++n)
#pragma unroll
                    for (int i = 0; i < 4; ++i) { const float a = acc[ai][0][m][n][i], b = acc[ai][1][m][n][i]; v[n * 4 + i] = a * __builtin_amdgcn_rcpf(1.0f + __expf(-a)) * b; }
                typedef unsigned u32x2_ __attribute__((ext_vector_type(2)));
                u32x2_ w; w.x = pk4_fp8(v[0], v[1], v[2], v[3]); w.y = pk4_fp8(v[4], v[5], v[6], v[7]);
                *(u32x2_*)rowp = w; }
    }
};
struct EpiY {
    static constexpr bool PERM = true, AFTER_DRAIN = false;
    unsigned char* Y;
    __device__ __forceinline__ void operator()(const f32x4 (&acc)[2][2][4][2], const Unit& u, int wr, int wc, int fr, int fq) const {
        if (!(u.x0 >> 8)) return;
        const int ct = u.pn & 3, row0 = u.pm * BM + wr * 64 + fr, col0 = ct * 256 + wc * 64 + 16 * fq;
#pragma unroll
        for (int ai = 0; ai < 2; ++ai)
#pragma unroll
            for (int m = 0; m < 4; ++m) { unsigned char* dst = Y + (size_t)(row0 + ai * HALF + m * 16) * 1024 + col0;
                u32x4 w;
                w.x = pk4_fp8(acc[ai][0][m][0][0], acc[ai][0][m][0][1], acc[ai][0][m][0][2], acc[ai][0][m][0][3]); w.y = pk4_fp8(acc[ai][0][m][1][0], acc[ai][0][m][1][1], acc[ai][0][m][1][2], acc[ai][0][m][1][3]);
                w.z = pk4_fp8(acc[ai][1][m][0][0], acc[ai][1][m][0][1], acc[ai][1][m][0][2], acc[ai][1][m][0][3]); w.w = pk4_fp8(acc[ai][1][m][1][0], acc[ai][1][m][1][1], acc[ai][1][m][1][2], acc[ai][1][m][1][3]);
                *(u32x4*)dst = w; }
    }
};
struct MoeOrder {
    const PG8_LAS int* tab; int G, c;
    __device__ __forceinline__ bool next(int i, Unit& u) const {
        const int RTP = __builtin_amdgcn_readfirstlane(tab[1]), Rt = __builtin_amdgcn_readfirstlane(tab[0]), nwg = RTP * 4;
        const long L = (long)i * G + c; if (L >= nwg) return false;
        int wgid = (int)L; { const int q = nwg / NXCD, r = nwg % NXCD, xcd = wgid % NXCD, off = wgid / NXCD; wgid = (xcd < r ? xcd * (q + 1) : r * (q + 1) + (xcd - r) * q) + off; }
        const int gid = wgid / 32, w = wgid % 32, rt = 8 * gid + (w & 7), ct = w >> 3, valid = rt < Rt ? 1 : 0, rtc = valid ? rt : 0;
        const int e = __builtin_amdgcn_readfirstlane(tab[128 + rtc]), sb = __builtin_amdgcn_readfirstlane(tab[2 + e]);
        u.pm = rtc; u.pn = e * 4 + ct; u.x0 = e | (valid << 8); u.x1 = (rtc - sb) * 256; return true;
    }
    __device__ __forceinline__ void a_ready(const Unit&) const {}
    __device__ __forceinline__ void done(const Unit&) const {}
};

struct MoeOrderG : MoeOrder { const PG8_LAS int* rowtab; };

template <class Epi, class Sched, bool ALIGN_EPI = false, bool SP2 = false, bool FP8 = false>
__device__ __forceinline__ void gemm_phase(PG8_LAS unsigned char* lds, const Gemm g, const Sched& S, const Epi& E) {
    int tid = threadIdx.x; asm volatile("" : "+v"(tid)); const int wid = __builtin_amdgcn_readfirstlane(tid >> 6), lane = tid & 63, wr = wid >> 2, wc = wid & 3, fr = lane & 15, fq = lane >> 4;
    const int K = g.K, nt = K / BK;
    unsigned voffA[2], voffB[2];
#pragma unroll
    for (int i = 0; i < 2; ++i) { int R, C; stage_rc(tid * 16 + i * 8192, R, C); const int Rb = Epi::PERM ? ((R & ~31) + perm32(R & 31)) : R;
        voffA[i] = (unsigned)(R * K + C) * 2u; voffB[i] = (unsigned)(Rb * K + C) * 2u; }
    const size_t kstep = (size_t)(BK * 2);
    const size_t hstep = (size_t)HALF * K * 2;
    const size_t tstep = 2 * hstep;
    const unsigned ldsw = (unsigned)wid * 1024u;
    const int aoff = lds_byte(wr * 64 + fr, fq * 8), boff = lds_byte(wc * 32 + fr, fq * 8);
#define PG8_SA(b, h) (((b) * 2 + (h)) * HTB)
#define PG8_SB(b, h) ((4 + (b) * 2 + (h)) * HTB)
#define PG8_STAGE(bufoff, gbase, voff) do { _Pragma("unroll") for (int _i = 0; _i < 2; ++_i) \
        __builtin_amdgcn_global_load_lds((const unsigned*)((const char*)(gbase) + (voff)[_i]), (PG8_LAS unsigned*)(lds + (bufoff) + ldsw + _i * 8192), 16, 0, 0); } while (0)
#define PG8_LDA(dst, b, h) do { if constexpr (FP8) { _Pragma("unroll") for (int m = 0; m < 4; ++m) { const v4i_t lo_ = *(const PG8_LAS v4i_t*)(lds + PG8_SA(b, h) + aoff + m * 2048), hi_ = *(const PG8_LAS v4i_t*)(lds + PG8_SA(b, h) + aoff + m * 2048 + 1024); dst##8[m] = __builtin_shufflevector(lo_, hi_, 0, 1, 2, 3, 4, 5, 6, 7); } } \
        else { _Pragma("unroll") for (int m = 0; m < 4; ++m) _Pragma("unroll") for (int k = 0; k < 2; ++k) dst[m][k] = *(const PG8_LAS bf16x8*)(lds + PG8_SA(b, h) + aoff + m * 2048 + k * 1024); } } while (0)
#define PG8_LDB(dst, b, h) do { if constexpr (FP8) { _Pragma("unroll") for (int n = 0; n < 2; ++n) { const v4i_t lo_ = *(const PG8_LAS v4i_t*)(lds + PG8_SB(b, h) + boff + n * 2048), hi_ = *(const PG8_LAS v4i_t*)(lds + PG8_SB(b, h) + boff + n * 2048 + 1024); dst##8[n] = __builtin_shufflevector(lo_, hi_, 0, 1, 2, 3, 4, 5, 6, 7); } } \
        else { _Pragma("unroll") for (int n = 0; n < 2; ++n) _Pragma("unroll") for (int k = 0; k < 2; ++k) dst[n][k] = *(const PG8_LAS bf16x8*)(lds + PG8_SB(b, h) + boff + n * 2048 + k * 1024); } } while (0)
#define PG8_MMA(ai, bj, At, Bt) do { __builtin_amdgcn_s_setprio(1); \
        if constexpr (FP8) {     \
            _Pragma("unroll") for (int m = 0; m < 4; ++m) _Pragma("unroll") for (int n = 0; n < 2; ++n) \
                asm volatile("v_mfma_scale_f32_16x16x128_f8f6f4 %0, %1, %2, %0, %3, %4 op_sel_hi:[0,0,0]" : "+v"(acc[ai][bj][m][n]) : "v"(Bt##8[n]), "v"(At##8[m]), "v"(sc_w8), "v"(sc_a8));     \
        } else { \
            _Pragma("unroll") for (int m = 0; m < 4; ++m) _Pragma("unroll") for (int n = 0; n < 2; ++n) _Pragma("unroll") for (int k = 0; k < 2; ++k) \
                acc[ai][bj][m][n] = __builtin_amdgcn_mfma_f32_16x16x32_bf16(Bt[n][k], At[m][k], acc[ai][bj][m][n], 0, 0, 0); } \
        __builtin_amdgcn_s_setprio(0); } while (0)
#define PG8_WAIT_V(n) asm volatile("s_waitcnt vmcnt(" #n ")" ::: "memory")
#define PG8_WAIT_L(n) asm volatile("s_waitcnt lgkmcnt(" #n ")" ::: "memory")
#define PG8_BAR __builtin_amdgcn_s_barrier()
#define PG8_SCHED __builtin_amdgcn_sched_barrier(0)
    Unit cur, nxt; int ui = 0;
    if (!S.next(0, cur)) return;
    f32x4 acc[2][2][4][2];
#pragma unroll
    for (int a = 0; a < 2; ++a)
#pragma unroll
        for (int b = 0; b < 2; ++b)
#pragma unroll
            for (int m = 0; m < 4; ++m)
#pragma unroll
                for (int n = 0; n < 2; ++n) acc[a][b][m][n] = (f32x4){0.f, 0.f, 0.f, 0.f};
    const int sc_w8 = 0x79797979, sc_a8 = 0x7F7F7F7F;
    bf16x8 At[4][2], B0[2][2], B1[2][2]; v8i_t At8[4], B08[2], B18[2];
    const char* cA = (const char*)g.A + (size_t)cur.pm * tstep; const char* cB = (const char*)g.Bt + (size_t)cur.pn * tstep;
    S.a_ready(cur);
    if constexpr (SP2) {
        PG8_STAGE(PG8_SB(0, 0), cB, voffB); PG8_STAGE(PG8_SB(0, 1), cB + hstep, voffB); PG8_STAGE(PG8_SA(0, 0), cA, voffA); PG8_STAGE(PG8_SA(0, 1), cA + hstep, voffA);
        if (wr == 1) PG8_BAR;
        PG8_WAIT_V(2); PG8_BAR;
        PG8_STAGE(PG8_SB(1, 0), cB + kstep, voffB); PG8_STAGE(PG8_SA(1, 0), cA + kstep, voffA); PG8_STAGE(PG8_SB(1, 1), cB + hstep + kstep, voffB);
        PG8_WAIT_V(6); PG8_BAR;
    } else {
        PG8_STAGE(PG8_SB(0, 0), cB, voffB); PG8_STAGE(PG8_SA(0, 0), cA, voffA); PG8_STAGE(PG8_SB(0, 1), cB + hstep, voffB); PG8_STAGE(PG8_SA(0, 1), cA + hstep, voffA);
        if (wr == 1) PG8_BAR;
        PG8_WAIT_V(4); PG8_BAR;
        PG8_STAGE(PG8_SB(1, 0), cB + kstep, voffB); PG8_STAGE(PG8_SA(1, 0), cA + kstep, voffA); PG8_STAGE(PG8_SB(1, 1), cB + hstep + kstep, voffB);
        PG8_WAIT_V(6); PG8_BAR;
    }
    for (;;) {
        const bool has_next = S.next(ui + 1, nxt);
        const char* nA = has_next ? (const char*)g.A + (size_t)nxt.pm * tstep : cA; const char* nB = has_next ? (const char*)g.Bt + (size_t)nxt.pn * tstep : cB;
#pragma unroll 1
        for (int t = 0; t < nt; t += 2) {
            const bool last = (t == nt - 2);
            const char* a1 = cA + (size_t)(t + 1) * kstep;
            const char* a2 = last ? nA : cA + (size_t)(t + 2) * kstep; const char* b2 = last ? nB : cB + (size_t)(t + 2) * kstep;
            const char* a3 = a2 + kstep; const char* b3 = b2 + kstep;
            if (last && has_next) S.a_ready(nxt);
            if constexpr (SP2) {
            PG8_LDB(B0, 0, 0); PG8_LDB(B1, 0, 1); PG8_SCHED; PG8_LDA(At, 0, 0); PG8_STAGE(PG8_SA(1, 1), a1 + hstep, voffA);
            PG8_WAIT_V(8); PG8_WAIT_L(0); PG8_BAR; PG8_MMA(0, 0, At, B0); PG8_MMA(0, 1, At, B1); PG8_BAR; PG8_SCHED;
            PG8_LDA(At, 0, 1); PG8_STAGE(PG8_SB(0, 0), b2, voffB); PG8_STAGE(PG8_SB(0, 1), b2 + hstep, voffB); PG8_STAGE(PG8_SA(0, 0), a2, voffA);
            PG8_WAIT_V(8); PG8_WAIT_L(0); PG8_BAR; PG8_MMA(1, 0, At, B0); PG8_MMA(1, 1, At, B1); PG8_BAR; PG8_SCHED;
            PG8_LDB(B0, 1, 0); PG8_LDB(B1, 1, 1); PG8_SCHED; PG8_LDA(At, 1, 0); PG8_STAGE(PG8_SA(0, 1), a2 + hstep, voffA);
            PG8_WAIT_V(8); PG8_WAIT_L(0); PG8_BAR; PG8_MMA(0, 0, At, B0); PG8_MMA(0, 1, At, B1); PG8_BAR; PG8_SCHED;
            PG8_LDA(At, 1, 1); PG8_STAGE(PG8_SB(1, 0), b3, voffB); PG8_STAGE(PG8_SB(1, 1), b3 + hstep, voffB); PG8_STAGE(PG8_SA(1, 0), a3, voffA);
            PG8_WAIT_V(8); PG8_WAIT_L(0); PG8_BAR; PG8_MMA(1, 0, At, B0); PG8_MMA(1, 1, At, B1); PG8_BAR; PG8_SCHED;
            } else {
            PG8_LDB(B0, 0, 0); PG8_SCHED; PG8_LDA(At, 0, 0); PG8_STAGE(PG8_SA(1, 1), a1 + hstep, voffA);
            PG8_WAIT_L(8); PG8_BAR; PG8_WAIT_L(0); PG8_MMA(0, 0, At, B0); PG8_BAR; PG8_SCHED;
            PG8_LDB(B1, 0, 1); PG8_STAGE(PG8_SB(0, 0), b2, voffB);
            PG8_BAR; PG8_WAIT_L(0); PG8_MMA(0, 1, At, B1); PG8_BAR;
            PG8_LDA(At, 0, 1); PG8_STAGE(PG8_SA(0, 0), a2, voffA);
            PG8_BAR; PG8_WAIT_L(0); PG8_MMA(1, 0, At, B0); PG8_BAR; PG8_SCHED;
            PG8_STAGE(PG8_SB(0, 1), b2 + hstep, voffB);
            PG8_WAIT_V(6); PG8_BAR; PG8_MMA(1, 1, At, B1); PG8_BAR;
            PG8_LDB(B0, 1, 0); PG8_SCHED; PG8_LDA(At, 1, 0); PG8_STAGE(PG8_SA(0, 1), a2 + hstep, voffA);
            PG8_WAIT_L(8); PG8_BAR; PG8_WAIT_L(0); PG8_MMA(0, 0, At, B0); PG8_BAR; PG8_SCHED;
            PG8_LDB(B1, 1, 1); PG8_STAGE(PG8_SB(1, 0), b3, voffB);
            PG8_BAR; PG8_WAIT_L(0); PG8_MMA(0, 1, At, B1); PG8_BAR;
            PG8_LDA(At, 1, 1); PG8_STAGE(PG8_SA(1, 0), a3, voffA);
            PG8_BAR; PG8_WAIT_L(0); PG8_MMA(1, 0, At, B0); PG8_BAR; PG8_SCHED;
            PG8_STAGE(PG8_SB(1, 1), b3 + hstep, voffB);
            PG8_WAIT_V(6); PG8_BAR; PG8_MMA(1, 1, At, B1); PG8_BAR;
            }
        }
        if constexpr (ALIGN_EPI) { if (wr == 0) PG8_BAR; }
        if constexpr (FP8) asm volatile("s_nop 15\n\ts_nop 15\n\ts_nop 7" ::: "memory");
        if constexpr (!Epi::AFTER_DRAIN) { int tid_e = threadIdx.x; asm volatile("" : "+v"(tid_e));
            E(acc, cur, wr, wc, tid_e & 15, (tid_e & 63) >> 4); S.done(cur); }
        if (!has_next) break;
#pragma unroll
        for (int a = 0; a < 2; ++a)
#pragma unroll
            for (int b = 0; b < 2; ++b)
#pragma unroll
                for (int m = 0; m < 4; ++m)
#pragma unroll
                    for (int n = 0; n < 2; ++n) acc[a][b][m][n] = (f32x4){0.f, 0.f, 0.f, 0.f};
        cur = nxt; cA = nA; cB = nB; ++ui;
        if constexpr (ALIGN_EPI) { if (wr == 1) PG8_BAR; }
    }
    PG8_WAIT_V(0);
    if constexpr (!ALIGN_EPI) { if (wr == 0) PG8_BAR; }
    PG8_BAR;
    if constexpr (Epi::AFTER_DRAIN) { E.fused(acc, cur, wr, wc, fr, fq, lds, wid, lane); S.done(cur); }
#undef PG8_SA
#undef PG8_SB
#undef PG8_STAGE
#undef PG8_LDA
#undef PG8_LDB
#undef PG8_MMA
#undef PG8_WAIT_V
#undef PG8_WAIT_L
#undef PG8_BAR
#undef PG8_SCHED
}
template <class Epi, class Sched, bool ALIGN_EPI = false, bool SP2 = false, bool FP8 = false>
__device__ __forceinline__ void gemm_phase_gather(PG8_LAS unsigned char* lds, const Gemm g, const Sched& S, const Epi& E) {
    int tid = threadIdx.x; asm volatile("" : "+v"(tid)); const int wid = __builtin_amdgcn_readfirstlane(tid >> 6), lane = tid & 63, wr = wid >> 2, wc = wid & 3, fr = lane & 15, fq = lane >> 4;
    const int K = g.K, nt = K / BK;
    unsigned voffA[2], voffB[2]; int rA[2]; unsigned vA[2][2], vN[2][2];
#pragma unroll
    for (int i = 0; i < 2; ++i) { int R, C; stage_rc(tid * 16 + i * 8192, R, C); const int Rb = Epi::PERM ? ((R & ~31) + perm32(R & 31)) : R;
        voffA[i] = (unsigned)C * 2u; rA[i] = R; voffB[i] = (unsigned)(Rb * K + C) * 2u; }
    const size_t kstep = (size_t)(BK * 2);
    const size_t hstep = (size_t)HALF * K * 2;
    const size_t tstep = 2 * hstep;
    const unsigned ldsw = (unsigned)wid * 1024u;
    const int aoff = lds_byte(wr * 64 + fr, fq * 8), boff = lds_byte(wc * 32 + fr, fq * 8);
#define PG8_SA(b, h) (((b) * 2 + (h)) * HTB)
#define PG8_SB(b, h) ((4 + (b) * 2 + (h)) * HTB)
#define PG8_STAGE(bufoff, gbase, voff) do { _Pragma("unroll") for (int _i = 0; _i < 2; ++_i) \
        __builtin_amdgcn_global_load_lds((const unsigned*)((const char*)(gbase) + (voff)[_i]), (PG8_LAS unsigned*)(lds + (bufoff) + ldsw + _i * 8192), 16, 0, 0); } while (0)
#define PG8_LDA(dst, b, h) do { if constexpr (FP8) { _Pragma("unroll") for (int m = 0; m < 4; ++m) { const v4i_t lo_ = *(const PG8_LAS v4i_t*)(lds + PG8_SA(b, h) + aoff + m * 2048), hi_ = *(const PG8_LAS v4i_t*)(lds + PG8_SA(b, h) + aoff + m * 2048 + 1024); dst##8[m] = __builtin_shufflevector(lo_, hi_, 0, 1, 2, 3, 4, 5, 6, 7); } } \
        else { _Pragma("unroll") for (int m = 0; m < 4; ++m) _Pragma("unroll") for (int k = 0; k < 2; ++k) dst[m][k] = *(const PG8_LAS bf16x8*)(lds + PG8_SA(b, h) + aoff + m * 2048 + k * 1024); } } while (0)
#define PG8_LDB(dst, b, h) do { if constexpr (FP8) { _Pragma("unroll") for (int n = 0; n < 2; ++n) { const v4i_t lo_ = *(const PG8_LAS v4i_t*)(lds + PG8_SB(b, h) + boff + n * 2048), hi_ = *(const PG8_LAS v4i_t*)(lds + PG8_SB(b, h) + boff + n * 2048 + 1024); dst##8[n] = __builtin_shufflevector(lo_, hi_, 0, 1, 2, 3, 4, 5, 6, 7); } } \
        else { _Pragma("unroll") for (int n = 0; n < 2; ++n) _Pragma("unroll") for (int k = 0; k < 2; ++k) dst[n][k] = *(const PG8_LAS bf16x8*)(lds + PG8_SB(b, h) + boff + n * 2048 + k * 1024); } } while (0)
#define PG8_MMA(ai, bj, At, Bt) do { __builtin_amdgcn_s_setprio(1); \
        if constexpr (FP8) {     \
            _Pragma("unroll") for (int m = 0; m < 4; ++m) _Pragma("unroll") for (int n = 0; n < 2; ++n) \
                asm volatile("v_mfma_scale_f32_16x16x128_f8f6f4 %0, %1, %2, %0, %3, %4 op_sel_hi:[0,0,0]" : "+v"(acc[ai][bj][m][n]) : "v"(Bt##8[n]), "v"(At##8[m]), "v"(sc_w8), "v"(sc_a8));     \
        } else { \
            _Pragma("unroll") for (int m = 0; m < 4; ++m) _Pragma("unroll") for (int n = 0; n < 2; ++n) _Pragma("unroll") for (int k = 0; k < 2; ++k) \
                acc[ai][bj][m][n] = __builtin_amdgcn_mfma_f32_16x16x32_bf16(Bt[n][k], At[m][k], acc[ai][bj][m][n], 0, 0, 0); } \
        __builtin_amdgcn_s_setprio(0); } while (0)
#define PG8_WAIT_V(n) asm volatile("s_waitcnt vmcnt(" #n ")" ::: "memory")
#define PG8_WAIT_L(n) asm volatile("s_waitcnt lgkmcnt(" #n ")" ::: "memory")
#define PG8_BAR __builtin_amdgcn_s_barrier()
#define PG8_SCHED __builtin_amdgcn_sched_barrier(0)
    Unit cur, nxt; int ui = 0;
    if (!S.next(0, cur)) return;
#define PG8_ROWS(dst, uidx) do { _Pragma("unroll") for (int h_ = 0; h_ < 2; ++h_) _Pragma("unroll") for (int i_ = 0; i_ < 2; ++i_) dst[h_][i_] = (unsigned)S.rowtab[(uidx) * 256 + h_ * HALF + rA[i_]] * (unsigned)(K * 2) + voffA[i_]; } while (0)
    PG8_ROWS(vA, 0);
    f32x4 acc[2][2][4][2];
#pragma unroll
    for (int a = 0; a < 2; ++a)
#pragma unroll
        for (int b = 0; b < 2; ++b)
#pragma unroll
            for (int m = 0; m < 4; ++m)
#pragma unroll
                for (int n = 0; n < 2; ++n) acc[a][b][m][n] = (f32x4){0.f, 0.f, 0.f, 0.f};
    const int sc_w8 = 0x79797979, sc_a8 = 0x7F7F7F7F;
    bf16x8 At[4][2], B0[2][2], B1[2][2]; v8i_t At8[4], B08[2], B18[2];
    const char* cA = (const char*)g.A; const char* cB = (const char*)g.Bt + (size_t)cur.pn * tstep;
    S.a_ready(cur);
    if constexpr (SP2) {
        PG8_STAGE(PG8_SB(0, 0), cB, voffB); PG8_STAGE(PG8_SB(0, 1), cB + hstep, voffB); PG8_STAGE(PG8_SA(0, 0), cA, vA[0]); PG8_STAGE(PG8_SA(0, 1), cA, vA[1]);
        if (wr == 1) PG8_BAR;
        PG8_WAIT_V(2); PG8_BAR;
        PG8_STAGE(PG8_SB(1, 0), cB + kstep, voffB); PG8_STAGE(PG8_SA(1, 0), cA + kstep, vA[0]); PG8_STAGE(PG8_SB(1, 1), cB + hstep + kstep, voffB);
        PG8_WAIT_V(6); PG8_BAR;
    } else {
        PG8_STAGE(PG8_SB(0, 0), cB, voffB); PG8_STAGE(PG8_SA(0, 0), cA, vA[0]); PG8_STAGE(PG8_SB(0, 1), cB + hstep, voffB); PG8_STAGE(PG8_SA(0, 1), cA, vA[1]);
        if (wr == 1) PG8_BAR;
        PG8_WAIT_V(4); PG8_BAR;
        PG8_STAGE(PG8_SB(1, 0), cB + kstep, voffB); PG8_STAGE(PG8_SA(1, 0), cA + kstep, vA[0]); PG8_STAGE(PG8_SB(1, 1), cB + hstep + kstep, voffB);
        PG8_WAIT_V(6); PG8_BAR;
    }
    for (;;) {
        const bool has_next = S.next(ui + 1, nxt);
        if (has_next) PG8_ROWS(vN, ui + 1);
        const char* nA = cA; const char* nB = has_next ? (const char*)g.Bt + (size_t)nxt.pn * tstep : cB;
#pragma unroll 1
        for (int t = 0; t < nt; t += 2) {
            const bool last = (t == nt - 2);
            unsigned vX[2][2];
#pragma unroll
            for (int h_ = 0; h_ < 2; ++h_)
#pragma unroll
                for (int i_ = 0; i_ < 2; ++i_) vX[h_][i_] = (last && has_next) ? vN[h_][i_] : vA[h_][i_];
            const char* a1 = cA + (size_t)(t + 1) * kstep;
            const char* a2 = last ? nA : cA + (size_t)(t + 2) * kstep; const char* b2 = last ? nB : cB + (size_t)(t + 2) * kstep;
            const char* a3 = a2 + kstep; const char* b3 = b2 + kstep;
            if (last && has_next) S.a_ready(nxt);
            if constexpr (SP2) {
            PG8_LDB(B0, 0, 0); PG8_LDB(B1, 0, 1); PG8_SCHED; PG8_LDA(At, 0, 0); PG8_STAGE(PG8_SA(1, 1), a1, vA[1]);
            PG8_WAIT_V(8); PG8_WAIT_L(0); PG8_BAR; PG8_MMA(0, 0, At, B0); PG8_MMA(0, 1, At, B1); PG8_BAR; PG8_SCHED;
            PG8_LDA(At, 0, 1); PG8_STAGE(PG8_SB(0, 0), b2, voffB); PG8_STAGE(PG8_SB(0, 1), b2 + hstep, voffB); PG8_STAGE(PG8_SA(0, 0), a2, vX[0]);
            PG8_WAIT_V(8); PG8_WAIT_L(0); PG8_BAR; PG8_MMA(1, 0, At, B0); PG8_MMA(1, 1, At, B1); PG8_BAR; PG8_SCHED;
            PG8_LDB(B0, 1, 0); PG8_LDB(B1, 1, 1); PG8_SCHED; PG8_LDA(At, 1, 0); PG8_STAGE(PG8_SA(0, 1), a2, vX[1]);
            PG8_WAIT_V(8); PG8_WAIT_L(0); PG8_BAR; PG8_MMA(0, 0, At, B0); PG8_MMA(0, 1, At, B1); PG8_BAR; PG8_SCHED;
            PG8_LDA(At, 1, 1); PG8_STAGE(PG8_SB(1, 0), b3, voffB); PG8_STAGE(PG8_SB(1, 1), b3 + hstep, voffB); PG8_STAGE(PG8_SA(1, 0), a3, vX[0]);
            PG8_WAIT_V(8); PG8_WAIT_L(0); PG8_BAR; PG8_MMA(1, 0, At, B0); PG8_MMA(1, 1, At, B1); PG8_BAR; PG8_SCHED;
            } else {
            PG8_LDB(B0, 0, 0); PG8_SCHED; PG8_LDA(At, 0, 0); PG8_STAGE(PG8_SA(1, 1), a1, vA[1]);
            PG8_WAIT_L(8); PG8_BAR; PG8_WAIT_L(0); PG8_MMA(0, 0, At, B0); PG8_BAR; PG8_SCHED;
            PG8_LDB(B1, 0, 1); PG8_STAGE(PG8_SB(0, 0), b2, voffB);
            PG8_BAR; PG8_WAIT_L(0); PG8_MMA(0, 1, At, B1); PG8_BAR;
            PG8_LDA(At, 0, 1); PG8_STAGE(PG8_SA(0, 0), a2, vX[0]);
            PG8_BAR; PG8_WAIT_L(0); PG8_MMA(1, 0, At, B0); PG8_BAR; PG8_SCHED;
            PG8_STAGE(PG8_SB(0, 1), b2 + hstep, voffB);
            PG8_WAIT_V(6); PG8_BAR; PG8_MMA(1, 1, At, B1); PG8_BAR;
            PG8_LDB(B0, 1, 0); PG8_SCHED; PG8_LDA(At, 1, 0); PG8_STAGE(PG8_SA(0, 1), a2, vX[1]);
            PG8_WAIT_L(8); PG8_BAR; PG8_WAIT_L(0); PG8_MMA(0, 0, At, B0); PG8_BAR; PG8_SCHED;
            PG8_LDB(B1, 1, 1); PG8_STAGE(PG8_SB(1, 0), b3, voffB);
            PG8_BAR; PG8_WAIT_L(0); PG8_MMA(0, 1, At, B1); PG8_BAR;
            PG8_LDA(At, 1, 1); PG8_STAGE(PG8_SA(1, 0), a3, vX[0]);
            PG8_BAR; PG8_WAIT_L(0); PG8_MMA(1, 0, At, B0); PG8_BAR; PG8_SCHED;
            PG8_STAGE(PG8_SB(1, 1), b3 + hstep, voffB);
            PG8_WAIT_V(6); PG8_BAR; PG8_MMA(1, 1, At, B1); PG8_BAR;
            }
        }
        if constexpr (ALIGN_EPI) { if (wr == 0) PG8_BAR; }
        if constexpr (FP8) asm volatile("s_nop 15\n\ts_nop 15\n\ts_nop 7" ::: "memory");
        if constexpr (!Epi::AFTER_DRAIN) { int tid_e = threadIdx.x; asm volatile("" : "+v"(tid_e));
            E(acc, cur, wr, wc, tid_e & 15, (tid_e & 63) >> 4); S.done(cur); }
        if (!has_next) break;
#pragma unroll
        for (int a = 0; a < 2; ++a)
#pragma unroll
            for (int b = 0; b < 2; ++b)
#pragma unroll
                for (int m = 0; m < 4; ++m)
#pragma unroll
                    for (int n = 0; n < 2; ++n) acc[a][b][m][n] = (f32x4){0.f, 0.f, 0.f, 0.f};
        cur = nxt; cA = nA; cB = nB; ++ui;
#pragma unroll
        for (int h_ = 0; h_ < 2; ++h_)
#pragma unroll
            for (int i_ = 0; i_ < 2; ++i_) vA[h_][i_] = vN[h_][i_];
        if constexpr (ALIGN_EPI) { if (wr == 1) PG8_BAR; }
    }
    PG8_WAIT_V(0);
    if constexpr (!ALIGN_EPI) { if (wr == 0) PG8_BAR; }
    PG8_BAR;
    if constexpr (Epi::AFTER_DRAIN) { E.fused(acc, cur, wr, wc, fr, fq, lds, wid, lane); S.done(cur); }
#undef PG8_ROWS
#undef PG8_SA
#undef PG8_SB
#undef PG8_STAGE
#undef PG8_LDA
#undef PG8_LDB
#undef PG8_MMA
#undef PG8_WAIT_V
#undef PG8_WAIT_L
#undef PG8_BAR
#undef PG8_SCHED
}
}

struct Params {
    const float *x, *c, *w_mod, *b_mod, *w_in, *w_pool, *pool_scale, *w_gk_up, *b_gk, *gla_norm_g, *w_out, *w_router, *b_router, *w1, *w3, *w2, *final_g;
    float* out; unsigned char* ws; int ph_lo, ph_hi;
};
typedef const __attribute__((address_space(4))) Params* CP;
#define LDSF(off) ((float*)(lds + (off)))

#define LAS __attribute__((address_space(3)))
#define XB_TMO      128
#define XB_XCNT(j)  (256  + 64 * (j))
#define XB_XSUB(j)  (1280 + 64 * (j))
#define XB_XGEN(j)  (2304 + 64 * (j))
#define XB_TOP      3328
#define XB_TOPGEN   3392
#define XCD_BAR_WORDS 3456
#define XB_SPIN_CAP (1u << 18)

__device__ __forceinline__ unsigned xb_ld(unsigned* p)              { return __hip_atomic_load(p, __ATOMIC_RELAXED, __HIP_MEMORY_SCOPE_AGENT); }
__device__ __forceinline__ unsigned xb_add(unsigned* p, unsigned v) { return __hip_atomic_fetch_add(p, v, __ATOMIC_RELAXED, __HIP_MEMORY_SCOPE_AGENT); }
__device__ __forceinline__ unsigned xb_xcc_id() { return (unsigned)__builtin_amdgcn_s_getreg((3 << 11) | 20) & 0xFu; }
#define XB_SPIN(cond, bar) do { unsigned _sp = 0; while (cond) { __builtin_amdgcn_s_sleep(1); \
    if ((++_sp & 255u) == 0u) { if (xb_ld(&(bar)[XB_TMO])) break; if (_sp > XB_SPIN_CAP) { atomicAdd(&(bar)[XB_TMO], 1u); break; } } } } while (0)

struct XcdBarrier {
    unsigned* bar; unsigned x;
    volatile LAS unsigned* st;
};

__device__ __forceinline__ XcdBarrier xcd_barrier_post(unsigned* bar, volatile LAS unsigned* st) {
    XcdBarrier b; b.bar = bar; b.x = xb_xcc_id(); b.st = st;
    if (threadIdx.x == 0) (void)xb_add(&bar[XB_XCNT(b.x)], 1u);
    return b;
}
__device__ __forceinline__ void xcd_barrier_complete(unsigned* bar, unsigned x, unsigned& nloc, unsigned& nx) {
    const unsigned G = gridDim.x * gridDim.y * gridDim.z;
    unsigned sum, cnt, mine, sp = 0u;
    for (;;) {
        sum = 0u; cnt = 0u; mine = 0u;
#pragma unroll
        for (unsigned j = 0; j < 16; ++j) { const unsigned c = xb_ld(&bar[XB_XCNT(j)]); sum += c; cnt += (c > 0u) ? 1u : 0u; mine = (j == x) ? c : mine; }
        if (sum == G) break;
        __builtin_amdgcn_s_sleep(1);
        if ((++sp & 255u) == 0u) { if (xb_ld(&bar[XB_TMO])) break; if (sp > XB_SPIN_CAP) { atomicAdd(&bar[XB_TMO], 1u); break; } }
    }
    nloc = mine > 0u ? mine : 1u; nx = cnt > 0u ? cnt : 1u;
}

__device__ __forceinline__ void xcd_barrier(const XcdBarrier& b) {
    asm volatile("s_waitcnt vmcnt(0)" ::: "memory");
    __syncthreads();
    if (threadIdx.x == 0) {
        unsigned* bar = b.bar;
        __builtin_amdgcn_s_waitcnt(0);
        unsigned nloc = b.st[0], nx = b.st[1];
        if (nloc == 0u) { xcd_barrier_complete(bar, b.x, nloc, nx); b.st[0] = nloc; b.st[1] = nx; }
        const unsigned old = xb_add(&bar[XB_XSUB(b.x)], 1u);
        const unsigned gen = old / nloc;
        if (old + 1u == (gen + 1u) * nloc) {
            __builtin_amdgcn_fence(__ATOMIC_RELEASE, "agent");
            asm volatile("s_waitcnt vmcnt(0)" ::: "memory");
            const unsigned og = xb_add(&bar[XB_TOP], 1u);
            const unsigned tg = og / nx;
            if (og + 1u == (tg + 1u) * nx) xb_add(&bar[XB_TOPGEN], 1u);
            else XB_SPIN(xb_ld(&bar[XB_TOPGEN]) == tg, bar);
            __builtin_amdgcn_fence(__ATOMIC_ACQUIRE, "agent");
            xb_add(&bar[XB_XGEN(b.x)], 1u);
            asm volatile("s_waitcnt vmcnt(0)" ::: "memory");
        } else {
            XB_SPIN(xb_ld(&bar[XB_XGEN(b.x)]) == gen, bar);
            __builtin_amdgcn_fence(__ATOMIC_ACQUIRE, "agent");
            asm volatile("s_waitcnt vmcnt(0)" ::: "memory");
        }
    }
    __syncthreads();
}

__device__ __forceinline__ void p0_transpose_item(const float* W, int K, int N, bf16* WT, int imode, float* scr, int item, int lane) {
    const int nblk = N / 32, kb = item / nblk, nb = item % nblk, k0 = 64 * kb, n0 = 32 * nb;
    const int rbase = imode == 0 ? n0 : (256 * (n0 >> 7) + (n0 & 127) + (imode == 2 ? 128 : 0));
#pragma unroll 32
    for (int i = 0; i < 32; ++i) { const int kk = 2 * i + (lane >> 5); scr[kk * 33 + (lane & 31)] = W[(size_t)(k0 + kk) * N + n0 + (lane & 31)]; }
    asm volatile("s_waitcnt lgkmcnt(0)" ::: "memory");
    const int c = lane & 7;
#pragma unroll
    for (int j = 0; j < 4; ++j) { const int n = (lane >> 3) + 8 * j; const float* s = scr + (8 * c) * 33 + n;
        u32x4 o; o.x = cvtpk(s[0 * 33], s[1 * 33]); o.y = cvtpk(s[2 * 33], s[3 * 33]); o.z = cvtpk(s[4 * 33], s[5 * 33]); o.w = cvtpk(s[6 * 33], s[7 * 33]);
        *(u32x4*)(WT + (size_t)(rbase + n) * K + k0 + 8 * c) = o; }
    asm volatile("s_waitcnt lgkmcnt(0)" ::: "memory");
}
__device__ __forceinline__ void p0_tile_load(f32x4 (&regs)[8], const float* W, int N, int k0, int n0, int tid) {
    const float* src = W + (size_t)(k0 + (tid >> 5)) * N + n0 + 4 * (tid & 31);
#pragma unroll
    for (int i = 0; i < 8; ++i) regs[i] = *(const f32x4*)(src + (size_t)(16 * i) * N);
}
__device__ __forceinline__ void p0_tile_to_lds(float* TL, const f32x4 (&regs)[8], int tid) {
#pragma unroll
    for (int i = 0; i < 8; ++i) { const int k = (tid >> 5) + 16 * i; *(f32x4*)(TL + k * 132 + ((4 * (tid & 31) + 8 * (k >> 5)) & 127)) = regs[i]; }
}
__device__ __forceinline__ int p0_row(int c, int perm) { return perm == 1 ? (c & ~255) + 128 * ((c >> 5) & 1) + 32 * ((c >> 6) & 3) + (c & 31) : perm == 2 ? (c & ~255) + 128 * ((c >> 3) & 1) + 32 * ((c >> 6) & 3) + 8 * ((c >> 4) & 3) + (c & 7) : c; }
__device__ __forceinline__ void p0_tile_store(const float* TL, bf16* WT, int K, int k0, int rbase, int perm, int tid) {
    const int n = tid >> 2, kq = tid & 3; const float* s = TL + (32 * kq) * 132 + ((n + 8 * kq) & 127);
    bf16* dst = WT + (size_t)p0_row(rbase + n, perm) * K + k0 + 32 * kq;
#pragma unroll
    for (int j = 0; j < 4; ++j) { u32x4 o; o.x = cvtpk(s[(8 * j) * 132], s[(8 * j + 1) * 132]); o.y = cvtpk(s[(8 * j + 2) * 132], s[(8 * j + 3) * 132]);
        o.z = cvtpk(s[(8 * j + 4) * 132], s[(8 * j + 5) * 132]); o.w = cvtpk(s[(8 * j + 6) * 132], s[(8 * j + 7) * 132]); *(u32x4*)(dst + 8 * j) = o; }
}
__device__ __forceinline__ unsigned pk4f8(float a, float b, float c, float d) { int w = __builtin_amdgcn_cvt_pk_fp8_f32(a * 64.f, b * 64.f, 0, false); w = __builtin_amdgcn_cvt_pk_fp8_f32(c * 64.f, d * 64.f, w, true); return (unsigned)w; }
__device__ __forceinline__ void p0_tile_store8(const float* TL, unsigned char* WT, int K, int k0, int rbase, int perm, int tid) {
    const int n = tid >> 2, kq = tid & 3; const float* s = TL + (32 * kq) * 132 + ((n + 8 * kq) & 127);
    unsigned char* dst = WT + (size_t)p0_row(rbase + n, perm) * K + k0 + 32 * kq;
#pragma unroll
    for (int j = 0; j < 2; ++j) { u32x4 o; o.x = pk4f8(s[(16 * j) * 132], s[(16 * j + 1) * 132], s[(16 * j + 2) * 132], s[(16 * j + 3) * 132]); o.y = pk4f8(s[(16 * j + 4) * 132], s[(16 * j + 5) * 132], s[(16 * j + 6) * 132], s[(16 * j + 7) * 132]);
        o.z = pk4f8(s[(16 * j + 8) * 132], s[(16 * j + 9) * 132], s[(16 * j + 10) * 132], s[(16 * j + 11) * 132]); o.w = pk4f8(s[(16 * j + 12) * 132], s[(16 * j + 13) * 132], s[(16 * j + 14) * 132], s[(16 * j + 15) * 132]); *(u32x4*)(dst + 16 * j) = o; }
}
struct P0Tile { const float* W; bf16* WT; int K, N, k0, n0, rbase, f8, perm; };
__device__ __forceinline__ P0Tile p0_tile(CP p, unsigned char* ws, int t) {
    P0Tile o;
    constexpr int T_IN = 2 * 8 * 16, T_OUT = 2 * 8 * 8, T_PL = 8, T_W1 = 64 * 8 * 4, T_W2 = 64 * 4 * 8;
    if (t < T_IN) { const int l = t / 128, r = t % 128; o.W = p->w_in + (size_t)l * 1024 * DIN; o.WT = (bf16*)(ws + WS_WIN) + (size_t)l * ZP * 1024; o.K = 1024; o.N = DIN; o.k0 = 128 * (r / 16); o.n0 = 128 * (r % 16); o.rbase = o.n0; o.f8 = 0; o.perm = 1; return o; } t -= T_IN;
    if (t < T_OUT) { const int l = t / 64, r = t % 64; o.W = p->w_out + (size_t)l * 1024 * 1024; o.WT = (bf16*)(ws + WS_WOUT + (size_t)l * 1024 * 1024); o.K = 1024; o.N = 1024; o.k0 = 128 * (r / 8); o.n0 = 128 * (r % 8); o.rbase = o.n0; o.f8 = 1; o.perm = 1; return o; } t -= T_OUT;
    if (t < T_PL) { o.W = p->w_pool + (size_t)t * 128 * 128; o.WT = (bf16*)(ws + WS_WPT) + (size_t)t * 128 * 128; o.K = 128; o.N = 128; o.k0 = 0; o.n0 = 0; o.rbase = 0; o.f8 = 0; o.perm = 0; return o; } t -= T_PL;
    if (t < 2 * T_W1) { const int w3 = t >= T_W1 ? 1 : 0; if (w3) t -= T_W1; const int le = t / 32, r = t % 32; o.W = (w3 ? p->w3 : p->w1) + (size_t)le * 1024 * 512; o.WT = (bf16*)(ws + WS_W13 + (size_t)le * 1024 * 1024);
        o.K = 1024; o.N = 512; o.k0 = 128 * (r / 4); o.n0 = 128 * (r % 4); o.rbase = 256 * (r % 4) + 128 * w3; o.f8 = 1; o.perm = 0; return o; } t -= 2 * T_W1;
    { const int le = t / 32, r = t % 32; o.W = p->w2 + (size_t)le * 512 * 1024; o.WT = (bf16*)(ws + WS_W2 + (size_t)le * 1024 * 512); o.K = 512; o.N = 1024; o.k0 = 128 * (r / 8); o.n0 = 128 * (r % 8); o.rbase = o.n0; o.f8 = 1; o.perm = 2; return o; }
}
constexpr int P0_NTILES = 2 * 8 * 16 + 2 * 8 * 8 + 8 + 2 * 64 * 8 * 4 + 64 * 4 * 8;
__device__ __forceinline__ void gemv32_item(unsigned char* lds, const float* in, int ld_in, bool act, const float* W, int ldw, int N, int NP, int n0, const float* bias, float* out, int ldo, int tid, int lane, int wave) {
    float* INT = (float*)lds + wave * 4096;
    __syncthreads();
#pragma unroll 1
    for (int i0 = 0; i0 < 64; i0 += 16) { float tv[16];
#pragma unroll
        for (int i = 0; i < 16; ++i) { const int idx = (i0 + i) * 64 + lane; tv[i] = in[(size_t)(idx >> 7) * ld_in + 128 * wave + (idx & 127)]; }
#pragma unroll
        for (int i = 0; i < 16; ++i) { const int idx = (i0 + i) * 64 + lane; float v = tv[i]; if (act) v = siluf(v); INT[(idx & 127) * 32 + (idx >> 7)] = v; } }
    asm volatile("s_waitcnt lgkmcnt(0)" ::: "memory");
    const int n = n0 + lane;
    float accs[2][16];
#pragma unroll
    for (int bh = 0; bh < 2; ++bh)
#pragma unroll
        for (int b = 0; b < 16; ++b) accs[bh][b] = 0.f;
    if (n < N) {
        const float* wp = W + (size_t)(128 * wave) * ldw + n;
#pragma unroll 1
        for (int k0 = 0; k0 < 128; k0 += 32) { float wr[32];
#pragma unroll
            for (int j = 0; j < 32; ++j) wr[j] = wp[(size_t)(k0 + j) * ldw];
#pragma unroll
            for (int j = 0; j < 32; ++j) { const float w = wr[j];
#pragma unroll
                for (int bh = 0; bh < 2; ++bh) { const f32x4* iv = (const f32x4*)(INT + (k0 + j) * 32 + 16 * bh);
#pragma unroll
                    for (int q = 0; q < 4; ++q) { const f32x4 v = iv[q]; accs[bh][4 * q + 0] += v[0] * w; accs[bh][4 * q + 1] += v[1] * w; accs[bh][4 * q + 2] += v[2] * w; accs[bh][4 * q + 3] += v[3] * w; }
                    asm volatile("" : "+v"(accs[bh][0]), "+v"(accs[bh][4]), "+v"(accs[bh][8]), "+v"(accs[bh][12]) :: "memory"); } } }
    }
    __syncthreads();
    float* RED = (float*)lds;
#pragma unroll
    for (int bh = 0; bh < 2; ++bh)
#pragma unroll
        for (int b = 0; b < 16; ++b) RED[(wave * 32 + 16 * bh + b) * 64 + lane] = accs[bh][b];
    __syncthreads();
#pragma unroll
    for (int q = 0; q < 4; ++q) { const int b = (tid >> 6) + 8 * q, col = tid & 63, nn = n0 + col; float sum = 0.f;
#pragma unroll
        for (int w = 0; w < 8; ++w) sum += RED[(w * 32 + b) * 64 + col];
        if (nn < N) out[(size_t)b * ldo + nn] = sum + (bias ? bias[nn] : 0.f); else if (nn < NP) out[(size_t)b * ldo + nn] = 0.f; }
    __syncthreads();
}
template <bool B_> struct BoolK { static constexpr bool value = B_; };
template <int NR>
__device__ __forceinline__ void rows_prep_loop(const float* x, const float* mod0, bf16* xsb, float* rstd_out, int gw, int ngw, int lane) {
    const int rpw = (((T + ngw - 1) / ngw) + NR - 1) / NR * NR, tfirst = gw * rpw, tlast = (tfirst + rpw) < T ? (tfirst + rpw) : T;
    struct Set { f32x4 v[NR][4]; };
    Set A, B; f32x4 scv[4];
#define RP_LOAD(S_, TB) do { _Pragma("unroll") for (int r = 0; r < NR; ++r) { const f32x4* xr_ = (const f32x4*)(x + (size_t)((TB) + r) * 1024) + lane; \
        _Pragma("unroll") for (int j = 0; j < 4; ++j) S_.v[r][j] = xr_[64 * j]; } } while (0)
#pragma unroll 1
    for (int t0 = tfirst; t0 < tlast; ) {
        const int tend = (((t0 >> 11) + 1) << 11) < tlast ? (((t0 >> 11) + 1) << 11) : tlast;
        { const f32x4* sr = (const f32x4*)(mod0 + (size_t)(t0 >> 11) * 6144 + 1024) + lane;
#pragma unroll
          for (int j = 0; j < 4; ++j) scv[j] = sr[64 * j] + 1.0f; }
        RP_LOAD(A, t0);
        auto step = [&](auto allc, Set& cur, Set& nxt, const int tb) __attribute__((always_inline)) { constexpr bool ALL = decltype(allc)::value;
            if (ALL || tb + NR < tend) RP_LOAD(nxt, tb + NR);
            asm volatile("" ::: "memory");
            float s[NR];
#pragma unroll
            for (int r = 0; r < NR; ++r) { s[r] = 0.f;
#pragma unroll
                for (int j = 0; j < 4; ++j) s[r] += (cur.v[r][j][0] * cur.v[r][j][0] + cur.v[r][j][1] * cur.v[r][j][1]) + (cur.v[r][j][2] * cur.v[r][j][2] + cur.v[r][j][3] * cur.v[r][j][3]); }
#pragma unroll
            for (int o = 1; o < 64; o <<= 1) {
#pragma unroll
                for (int r = 0; r < NR; ++r) s[r] += __shfl_xor(s[r], o); }
#pragma unroll
            for (int r = 0; r < NR; ++r) { const int t = tb + r;
                if (lane == 0) rstd_out[t] = __builtin_amdgcn_rsqf(s[r] * (1.f / 1024.f) + EPS);
                u32x2* o = (u32x2*)(xsb + (size_t)t * 1024) + lane;
#pragma unroll
                for (int j = 0; j < 4; ++j) { const f32x4 w = cur.v[r][j] * scv[j]; u32x2 q; q.x = cvtpk(w[0], w[1]); q.y = cvtpk(w[2], w[3]); o[64 * j] = q; } }
            asm volatile("" ::: "memory");
        };
        int tb = t0;
#pragma unroll 1
        for (; tb + 2 * NR < tend; tb += 2 * NR) { step(BoolK<true>{}, A, B, tb); step(BoolK<true>{}, B, A, tb + NR); }
#pragma unroll 1
        for (; tb < tend; tb += 2 * NR) { step(BoolK<false>{}, A, B, tb); if (tb + NR < tend) step(BoolK<false>{}, B, A, tb + NR); }
        t0 = tend; }
#undef RP_LOAD
}

constexpr int CH_R = 0;
constexpr int CH_QT = 4096;
constexpr int CH_BL = 6144;
constexpr int CH_DEC = 6400;
constexpr int CH_BC = 8192;
constexpr int CH_VT = 25600;
constexpr int CH_KDT = 44032;
constexpr int CH_STL = 53248;
constexpr int GL_R = 0;
constexpr int GL_QT = 8192;
constexpr int GL_BL = 10240;
constexpr int GL_BC = 10752;
constexpr int GL_VT = 43520;
constexpr int GL_QE = 61952;
constexpr int GL_KE = 80384;
constexpr int GL_OL = 98816;
constexpr int GL_NG = 132608;
constexpr int PL_UT = 0;
constexpr int PL_PL = 21760;
static_assert(GL_NG + 512 <= LDS_BYTES - 64, "mixer LDS map");

#define LBAR() do { asm volatile("s_waitcnt lgkmcnt(0)" ::: "memory"); __builtin_amdgcn_s_barrier(); asm volatile("" ::: "memory"); } while (0)
__device__ __forceinline__ float logsig16(float x) {
    const float t = __builtin_amdgcn_exp2f(fabsf(x) * -1.4426950408889634f), lg = __builtin_amdgcn_logf(1.0f + t);
    const float mn = __builtin_amdgcn_fmed3f(x, 0.f, -__builtin_inff());
    return fmaf(lg, -0.0625f, mn * (0.0625f * 1.4426950408889634f)); }

__device__ __forceinline__ void stage_vt(bf16* VT, const u32x4& v0, const u32x4& v1, int tok, int vg) {
    const unsigned w[8] = {v0.x, v0.y, v0.z, v0.w, v1.x, v1.y, v1.z, v1.w};
#pragma unroll
    for (int j = 0; j < 8; ++j) { VT[(16 * vg + 2 * j) * 72 + tok] = (bf16)(w[j] & 0xffffu); VT[(16 * vg + 2 * j + 1) * 72 + tok] = (bf16)(w[j] >> 16); }
}

constexpr int CP_R = 0, CP_QT = 8192, CP_BLD = 12288, CP_BC = 13312, CP_KDT = 48128, CP_VT = 66560, CP_STL = 103424;
static_assert(CP_STL + 2 * 18432 <= LDS_BYTES - 64, "chain LDS map");
template <bool B_> struct BoolC { static constexpr bool value = B_; };
__device__ __forceinline__ void gla_chain(unsigned char* lds, CP p, int l, int item, int tid, int lane, int wave) {
    const bf16* Z = (const bf16*)(p->ws + WS_Z); bf16* ST = (bf16*)(p->ws + WS_ST);
    const int dir = item >> 7, bh = item & 127, h = bh & 3, b = bh >> 2;
    const int l15 = lane & 15, kq4 = lane >> 4;
    const int d = 16 * (wave & 3) + l15, tg = 4 * (wave >> 2) + kq4;
    const int tk2 = tid & 63, gr2 = tid >> 6;
    const int vb = wave & 3, db = wave >> 2, r32 = lane & 31, hi = lane >> 5;
    typedef short bf16x4_t __attribute__((ext_vector_type(4)));
    bf16x4_t wHi, wLo;
    { const float* wup = p->w_gk_up + ((size_t)(l * 2 + dir) * 16 + 4 * kq4) * 256 + h * 64 + d;
#pragma unroll
      for (int kk = 0; kk < 4; ++kk) { const float w = wup[kk * 256]; const unsigned short hb = f2bf(w); wHi[kk] = (short)hb; wLo[kk] = (short)f2bf(w - bflo((unsigned)hb)); } }
    const float bias = p->b_gk[(l * 2 + dir) * 256 + h * 64 + d];
    f32x16 S = {};
    const bf16* zrow = Z + ((size_t)b * SEQ + 32 * (wave >> 2) + 8 * (l15 >> 2) + (l15 & 3)) * ZP + C_RF + dir * 16 + 4 * kq4;
    const bf16* zrow2 = Z + ((size_t)b * SEQ + tk2) * ZP;
    _Float16* bcg = (_Float16*)(p->ws + WS_BCG) + ((size_t)((dir * 128 + bh) * 32)) * 4096 + (size_t)(8 * tg) * 64 + d;
    unsigned char* stb = (unsigned char*)ST + ((size_t)((dir * 128 + bh) * 32)) * 8192 + (size_t)(tid >> 2) * 64 + 16 * (tid & 3);
#define CH_N(j) (dir ? 31 - (j) : (j))
#define CH_LOAD_R(j, blk) (*(const u32x2*)(zrow + ((size_t)CH_N(j) * 64 + 4 * (blk)) * ZP))
    u32x2 rA0 = {0u, 0u}, rA1 = rA0, rB0 = CH_LOAD_R(0, 0), rB1 = CH_LOAD_R(0, 1);
    u32x4 kA = {0u, 0u, 0u, 0u}, v0A = kA, v1A = kA, kB = kA, v0B = kA, v1B = kA;
    float gprev[8]; f32x4 dcv[4];
#pragma unroll
    for (int j = 0; j < 8; ++j) gprev[j] = 0.f;
#pragma unroll
    for (int rq = 0; rq < 4; ++rq) dcv[rq] = (f32x4){0.f, 0.f, 0.f, 0.f};
    LBAR();
    const unsigned incmask = dir == 0 ? ((1u << tg) - 1u) : (0xffu & ~((2u << tg) - 1u));
    auto interval = [&](auto allc, const int i, u32x2& r0, u32x2& r1, u32x4& kk, u32x4& vv0, u32x4& vv1) __attribute__((always_inline)) { constexpr bool ALL = decltype(allc)::value;
        if (ALL || (i >= 5 && i < 37)) { const int j = i - 5; const unsigned char* sr = lds + CP_STL + (j & 1) * 18432 + (tid >> 2) * 80 + 16 * (tid & 3);
            *(u32x4*)(stb + (size_t)CH_N(j) * 8192) = *(const u32x4*)sr; }
        if (ALL || (i >= 4 && i < 36)) { const int pq = (i - 4) & 1;
            const bf16* KDT = (const bf16*)(lds + CP_KDT + pq * 9216); const bf16* VT = (const bf16*)(lds + CP_VT + pq * 18432);
            unsigned char* stl_w = lds + CP_STL + pq * 18432 + (32 * vb + r32) * 80 + 32 * db + 4 * hi;
            f32x16 u = {};
#pragma unroll
            for (int s = 0; s < 4; ++s) {
                const bf16x8 a = *(const bf16x8*)(KDT + (32 * db + r32) * 72 + 16 * s + 8 * hi);
                const bf16x8 bb = *(const bf16x8*)(VT + (32 * vb + r32) * 72 + 16 * s + 8 * hi);
                u = __builtin_amdgcn_mfma_f32_32x32x16_bf16(a, bb, u, 0, 0, 0);
            }
#pragma unroll
            for (int rq = 0; rq < 4; ++rq) {
                *(unsigned*)(stl_w + 8 * rq) = pg8::pk4_fp8(S[4 * rq], S[4 * rq + 1], S[4 * rq + 2], S[4 * rq + 3]);
                const f32x4 dc = dcv[rq];
                S[4 * rq] = dc[0] * S[4 * rq] + u[4 * rq]; S[4 * rq + 1] = dc[1] * S[4 * rq + 1] + u[4 * rq + 1];
                S[4 * rq + 2] = dc[2] * S[4 * rq + 2] + u[4 * rq + 2]; S[4 * rq + 3] = dc[3] * S[4 * rq + 3] + u[4 * rq + 3];
            } }
        if (ALL || (i >= 3 && i < 35)) { const int pq = (i - 3) & 1;
            const float* BLD = (const float*)(lds + CP_BLD + pq * 512); const float* BC = (const float*)(lds + CP_BC + pq * 17408);
            bf16* KDT = (bf16*)(lds + CP_KDT + pq * 9216); bf16* VT = (bf16*)(lds + CP_VT + pq * 18432);
#pragma unroll
            for (int rq = 0; rq < 4; ++rq) dcv[rq] = *(const f32x4*)(BLD + 64 + 32 * db + 8 * rq + 4 * hi);
            const f32x4 c0 = *(const f32x4*)(BC + tk2 * 68 + 8 * gr2), c1 = *(const f32x4*)(BC + tk2 * 68 + 8 * gr2 + 4);
            const f32x4 l0 = *(const f32x4*)(BLD + 8 * gr2), l1 = *(const f32x4*)(BLD + 8 * gr2 + 4);
            const float kf[8] = {bflo(kk.x), bfhi(kk.x), bflo(kk.y), bfhi(kk.y), bflo(kk.z), bfhi(kk.z), bflo(kk.w), bfhi(kk.w)};
#pragma unroll
            for (int j = 0; j < 8; ++j) { const float bc = j < 4 ? c0[j & 3] : c1[j & 3], bl = j < 4 ? l0[j & 3] : l1[j & 3];
                KDT[(8 * gr2 + j) * 72 + tk2] = f2bf(kf[j] * __builtin_amdgcn_exp2f(bl - bc)); }
            stage_vt(VT, vv0, vv1, tk2, gr2); }
        if (ALL || (i >= 2 && i < 34)) { const int j2 = i - 2, pq = j2 & 1;
            const float* QT = (const float*)(lds + CP_QT + pq * 2048); float* BLD = (float*)(lds + CP_BLD + pq * 512); float* BC = (float*)(lds + CP_BC + pq * 17408);
            float off = 0.f, tot = 0.f;
#pragma unroll
            for (int q = 0; q < 8; ++q) { const float t = QT[q * 64 + d]; tot += t; off += ((incmask >> q) & 1u) ? t : 0.f; }
            _Float16* bo = bcg + (size_t)CH_N(j2) * 4096;
#pragma unroll
            for (int j = 0; j < 8; ++j) { const float bcv = gprev[j] + off; BC[(8 * tg + j) * 68 + d] = bcv; bo[j * 64] = (_Float16)bcv; }
            if (tg == 0) { BLD[d] = tot; BLD[64 + d] = __builtin_amdgcn_exp2f(tot); } }
        if (ALL || (i >= 1 && i < 33)) { const int pq = (i - 1) & 1;
            float* QT = (float*)(lds + CP_QT + pq * 2048);
            f32x4 x0 = {bias, bias, bias, bias}, x1 = x0;
            x0 = __builtin_amdgcn_mfma_f32_16x16x16bf16_1k(__builtin_bit_cast(bf16x4_t, r0), wHi, x0, 0, 0, 0); x0 = __builtin_amdgcn_mfma_f32_16x16x16bf16_1k(__builtin_bit_cast(bf16x4_t, r0), wLo, x0, 0, 0, 0);
            x1 = __builtin_amdgcn_mfma_f32_16x16x16bf16_1k(__builtin_bit_cast(bf16x4_t, r1), wHi, x1, 0, 0, 0); x1 = __builtin_amdgcn_mfma_f32_16x16x16bf16_1k(__builtin_bit_cast(bf16x4_t, r1), wLo, x1, 0, 0, 0);
#pragma unroll
            for (int j = 0; j < 4; ++j) { gprev[j] = logsig16(x0[j]); gprev[4 + j] = logsig16(x1[j]); }
            float run = 0.f;
            if (dir == 0) {
#pragma unroll
                for (int j = 0; j < 8; ++j) { run += gprev[j]; gprev[j] = run; }
            } else {
#pragma unroll
                for (int j = 7; j >= 0; --j) { run += gprev[j]; gprev[j] = run; }
            }
            QT[tg * 64 + d] = run; }
        if (ALL || i + 1 < 32) { r0 = CH_LOAD_R(i + 1, 0); r1 = CH_LOAD_R(i + 1, 1); }
        if (ALL || (i >= 1 && i - 1 < 32)) { const bf16* zr = zrow2 + (size_t)CH_N(i - 1) * 64 * ZP;
            kk = *(const u32x4*)(zr + C_K + h * 64 + 8 * gr2); vv0 = *(const u32x4*)(zr + C_V + h * 128 + 16 * gr2); vv1 = *(const u32x4*)(zr + C_V + h * 128 + 16 * gr2 + 8); }
        LBAR();
    };
    int i = 0;
#pragma unroll 1
    for (; i < 6; i += 2) { interval(BoolC<false>{}, i, rA0, rA1, kA, v0A, v1A); interval(BoolC<false>{}, i + 1, rB0, rB1, kB, v0B, v1B); }
#pragma unroll 1
    for (; i < 30; i += 2) { interval(BoolC<true>{}, i, rA0, rA1, kA, v0A, v1A); interval(BoolC<true>{}, i + 1, rB0, rB1, kB, v0B, v1B); }
#pragma unroll 1
    for (; i < 38; i += 2) { interval(BoolC<false>{}, i, rA0, rA1, kA, v0A, v1A); interval(BoolC<false>{}, i + 1, rB0, rB1, kB, v0B, v1B); }
#undef CH_N
#undef CH_LOAD_R
}

__device__ __forceinline__ void mixer_store(unsigned char* lds, unsigned char* dstbase, bool gla, const u32x4& g0, const u32x4& g1, int tid) {
    const float* OL = LDSF(GL_OL); const int tok = tid >> 3, vg = tid & 7;
    float o[16];
#pragma unroll
    for (int q = 0; q < 4; ++q) { const f32x4 t = *(const f32x4*)(OL + tok * 132 + 16 * vg + 4 * q); o[4 * q] = t[0]; o[4 * q + 1] = t[1]; o[4 * q + 2] = t[2]; o[4 * q + 3] = t[3]; }
    if (gla) {
        float ss = 0.f;
#pragma unroll
        for (int j = 0; j < 16; ++j) ss += o[j] * o[j];
        ss += __shfl_xor(ss, 1); ss += __shfl_xor(ss, 2); ss += __shfl_xor(ss, 4);
        const float rstd = __builtin_amdgcn_rsqf(ss * (1.f / 128.f) + EPS);
        const unsigned gw[8] = {g0.x, g0.y, g0.z, g0.w, g1.x, g1.y, g1.z, g1.w};
        const float* NG = LDSF(GL_NG) + 16 * vg;
#pragma unroll
        for (int j = 0; j < 8; ++j) { const float ga = bflo(gw[j]), gb = bfhi(gw[j]);
            o[2 * j] = o[2 * j] * rstd * NG[2 * j] * siluf(ga); o[2 * j + 1] = o[2 * j + 1] * rstd * NG[2 * j + 1] * siluf(gb); }
    }
    u32x4 w0;
    w0.x = pg8::pk4_fp8(o[0], o[1], o[2], o[3]); w0.y = pg8::pk4_fp8(o[4], o[5], o[6], o[7]); w0.z = pg8::pk4_fp8(o[8], o[9], o[10], o[11]); w0.w = pg8::pk4_fp8(o[12], o[13], o[14], o[15]);
    *(u32x4*)(dstbase + (size_t)tok * 1024 + 16 * vg) = w0;
}

__device__ __forceinline__ void gla_stepC_phase(unsigned char* lds, CP p, int l, int vcu, int G, int tid, int lane, int wave) {
    const bf16* Z = (const bf16*)(p->ws + WS_Z); const bf16* ST = (const bf16*)(p->ws + WS_ST); unsigned char* AB = p->ws + WS_ABUF; const _Float16* BCG = (const _Float16*)(p->ws + WS_BCG);
    bf16* QE = (bf16*)(lds + GL_QE); bf16* KE = (bf16*)(lds + GL_KE); bf16* VT = (bf16*)(lds + GL_VT);
    const int tok = tid >> 3, dg = tid & 7, tk2 = tid & 63, gr2 = tid >> 6;
    const int ib = wave >> 2, vb = wave & 3, r32 = lane & 31, hi = lane >> 5;
    if (tid < 128) LDSF(GL_NG)[tid] = p->gla_norm_g[l * 128 + tid];
    int u = vcu; if (u >= 4096) return;
    int n = u & 31, h = (u >> 5) & 3, b = u >> 7;
    typedef _Float16 h8 __attribute__((ext_vector_type(8)));
    u32x4 q8, k8, va, vb2, ga, gb; h8 bc[2];
#define SC_LOAD() do { const bf16* zr = Z + ((size_t)b * SEQ + n * 64 + tok) * ZP; const bf16* zr2 = Z + ((size_t)b * SEQ + n * 64 + tk2) * ZP; \
        q8 = *(const u32x4*)(zr + C_Q + h * 64 + 8 * dg); k8 = *(const u32x4*)(zr + C_K + h * 64 + 8 * dg); \
        va = *(const u32x4*)(zr2 + C_V + h * 128 + 16 * gr2); vb2 = *(const u32x4*)(zr2 + C_V + h * 128 + 16 * gr2 + 8); \
        ga = *(const u32x4*)(zr + C_G + h * 128 + 16 * dg); gb = *(const u32x4*)(zr + C_G + h * 128 + 16 * dg + 8); \
        _Pragma("unroll") for (int dd = 0; dd < 2; ++dd) { bc[dd] = *(const h8*)(BCG + ((size_t)((dd * 128 + b * 4 + h) * 32 + n)) * 4096 + tok * 64 + 8 * dg); } } while (0)
    SC_LOAD();
#pragma unroll 1
    for (;;) {
        const int bh = b * 4 + h, hc = h; const size_t row0 = (size_t)b * SEQ + n * 64;
        u32x2 sraw[2][4];
#pragma unroll
        for (int dd = 0; dd < 2; ++dd) { const unsigned char* Sg = (const unsigned char*)ST + ((size_t)((dd * 128 + bh) * 32 + n)) * 8192 + (size_t)(32 * vb + r32) * 64 + 8 * hi;
#pragma unroll
            for (int s = 0; s < 4; ++s) sraw[dd][s] = *(const u32x2*)(Sg + 16 * s); }
        { const float qf[8] = {bflo(q8.x), bfhi(q8.x), bflo(q8.y), bfhi(q8.y), bflo(q8.z), bfhi(q8.z), bflo(q8.w), bfhi(q8.w)};
          const float kf[8] = {bflo(k8.x), bfhi(k8.x), bflo(k8.y), bfhi(k8.y), bflo(k8.z), bfhi(k8.z), bflo(k8.w), bfhi(k8.w)};
#pragma unroll
          for (int dd = 0; dd < 2; ++dd) {
              float qe[8], ke[8];
#pragma unroll
              for (int j = 0; j < 8; ++j) { const float bcv = (float)bc[dd][j]; const float e = __builtin_amdgcn_exp2f(bcv); qe[j] = qf[j] * e * 0.125f; ke[j] = kf[j] * __builtin_amdgcn_exp2f(-bcv);     }
              u32x4 wq, wk;
              wq.x = cvtpk(qe[0], qe[1]); wq.y = cvtpk(qe[2], qe[3]); wq.z = cvtpk(qe[4], qe[5]); wq.w = cvtpk(qe[6], qe[7]);
              wk.x = cvtpk(ke[0], ke[1]); wk.y = cvtpk(ke[2], ke[3]); wk.z = cvtpk(ke[4], ke[5]); wk.w = cvtpk(ke[6], ke[7]);
              *(u32x4*)(QE + (dd * 64 + tok) * 72 + 8 * dg) = wq; *(u32x4*)(KE + (dd * 64 + tok) * 72 + 8 * dg) = wk;
          }
          stage_vt(VT, va, vb2, tk2, gr2); }
        const u32x4 gc0 = ga, gc1 = gb;
        const int un = u + G; const bool more = un < 4096;
        if (more) { n = un & 31; h = (un >> 5) & 3; b = un >> 7; SC_LOAD(); }
        LBAR();
        {
            f32x16 o = {};
#pragma unroll
            for (int dd = 0; dd < 2; ++dd) {
                bf16x8 qfr[4];
#pragma unroll
                for (int s = 0; s < 4; ++s) qfr[s] = *(const bf16x8*)(QE + (dd * 64 + 32 * ib + r32) * 72 + 16 * s + 8 * hi);
#pragma unroll
                for (int s = 0; s < 4; ++s) { typedef float f2_ __attribute__((ext_vector_type(2)));
                const f2_ c0 = __builtin_amdgcn_cvt_pk_f32_fp8((int)sraw[dd][s].x, false), c1 = __builtin_amdgcn_cvt_pk_f32_fp8((int)sraw[dd][s].x, true), c2 = __builtin_amdgcn_cvt_pk_f32_fp8((int)sraw[dd][s].y, false), c3 = __builtin_amdgcn_cvt_pk_f32_fp8((int)sraw[dd][s].y, true);
                u32x4 sw; sw.x = cvtpk(c0[0], c0[1]); sw.y = cvtpk(c1[0], c1[1]); sw.z = cvtpk(c2[0], c2[1]); sw.w = cvtpk(c3[0], c3[1]);
                o = __builtin_amdgcn_mfma_f32_32x32x16_bf16(qfr[s], __builtin_bit_cast(bf16x8, sw), o, 0, 0, 0); }
#pragma unroll
                for (int jb = 0; jb < 2; ++jb) {
                    if (dd == 0 ? (jb > ib) : (jb < ib)) continue;
                    f32x16 x = {};
#pragma unroll
                    for (int s = 0; s < 4; ++s) { const bf16x8 a = *(const bf16x8*)(KE + (dd * 64 + 32 * jb + r32) * 72 + 16 * s + 8 * hi); x = __builtin_amdgcn_mfma_f32_32x32x16_bf16(a, qfr[s], x, 0, 0, 0); }
                    if (jb == ib) {
#pragma unroll
                        for (int r = 0; r < 16; ++r) { const int j = (r & 3) + 8 * (r >> 2) + 4 * hi; const bool keep = dd == 0 ? (j <= r32) : (j > r32); if (!keep) x[r] = 0.f; } }
#pragma unroll
                    for (int s2 = 0; s2 < 2; ++s2) {
                        u32x4 pa; pa.x = cvtpk(x[8 * s2], x[8 * s2 + 1]); pa.y = cvtpk(x[8 * s2 + 2], x[8 * s2 + 3]); pa.z = cvtpk(x[8 * s2 + 4], x[8 * s2 + 5]); pa.w = cvtpk(x[8 * s2 + 6], x[8 * s2 + 7]);
                        const bf16* vp = VT + (32 * vb + r32) * 72 + 32 * jb + 16 * s2 + 4 * hi;
                        const u32x2 b0 = *(const u32x2*)vp, b1 = *(const u32x2*)(vp + 8);
                        u32x4 pb; pb.x = b0.x; pb.y = b0.y; pb.z = b1.x; pb.w = b1.y;
                        o = __builtin_amdgcn_mfma_f32_32x32x16_bf16(__builtin_bit_cast(bf16x8, pa), __builtin_bit_cast(bf16x8, pb), o, 0, 0, 0);
                    }
                }
            }
            float* OL = LDSF(GL_OL);
#pragma unroll
            for (int r = 0; r < 16; ++r) OL[(32 * ib + (r & 3) + 8 * (r >> 2) + 4 * hi) * 132 + 32 * vb + r32] = o[r];
        }
        LBAR();
        mixer_store(lds, AB + row0 * 1024 + 512 + hc * 128, true, gc0, gc1, tid);
        if (!more) break;
        u = un;
    }
#undef SC_LOAD
    LBAR();
}
__device__ __forceinline__ void pool_phase(unsigned char* lds, CP p, int l, int vcu, int G, int tid, int lane, int wave) {
    const bf16* Z = (const bf16*)(p->ws + WS_Z); unsigned char* AB = p->ws + WS_ABUF; const bf16* WPT = (const bf16*)(p->ws + WS_WPT);
    bf16* UT = (bf16*)(lds + PL_UT); bf16* PL = (bf16*)(lds + PL_PL);
    const int ib = wave >> 2, nb = wave & 3, r32 = lane & 31, hi = lane >> 5;
    int u = vcu; if (u >= 4096) return;
    int g = u & 3, tt = (u >> 2) & 31, b = u >> 7, gw_ = -1;
    bf16x8 wfr[8]; float sc = 0.f;
    u32x4 pre[3];
#define POOL_LOAD(bq, ttq, gq) do { _Pragma("unroll") for (int i_ = 0; i_ < 3; ++i_) { const int idx = tid + 512 * i_; const int rr = idx >> 4, chn = idx & 15, t = (ttq) * 64 - 8 + rr; \
        u32x4 v_ = {0u, 0u, 0u, 0u}; if (idx < 1280 && t >= 0 && t < SEQ) v_ = *(const u32x4*)(Z + ((size_t)(bq) * SEQ + t) * ZP + (gq) * 128 + 8 * chn); pre[i_] = v_; } } while (0)
    POOL_LOAD(b, tt, g);
#pragma unroll 1
    for (;;) {
        const int t0 = tt * 64, gc = g, bc = b;
        if (gc != gw_) { gw_ = gc; const bf16* wp = WPT + ((size_t)(l * 4 + gc) * 128 + 32 * nb + r32) * 128 + 8 * hi;
#pragma unroll
            for (int s = 0; s < 8; ++s) wfr[s] = *(const bf16x8*)(wp + 16 * s);
            sc = p->pool_scale[l * 512 + gc * 128 + 32 * nb + r32]; }
#pragma unroll
        for (int i_ = 0; i_ < 3; ++i_) { const int idx = tid + 512 * i_; if (idx < 1280) *(u32x4*)(UT + (idx >> 4) * 136 + 8 * (idx & 15)) = pre[i_]; }
        const int un = u + G; const bool more = un < 4096;
        if (more) { g = un & 3; tt = (un >> 2) & 31; b = un >> 7; POOL_LOAD(b, tt, g); }
        LBAR();
        { const int c = tid & 127, tq = tid >> 7, w = 2 << gc, half = w >> 1;
          const bf16* ut = UT + (16 * tq + 8) * 136 + c;
          const bf16* ulo = ut - half * 136;
          const bf16* uhi = ulo + w * 136;
#define UF(ptr, j) __uint_as_float(((unsigned)(ptr)[(j) * 136]) << 16)
          float s = 0.f;
          for (int j = 0; j < w; ++j) s += UF(ulo, j);
          const int tb = t0 + 16 * tq;
          bf16* pl = PL + (16 * tq) * 136 + c;
#pragma unroll
          for (int j = 0; j < 16; ++j) {
              const int t = tb + j, lo = max(t - half, 0), hi2 = min(t - half + w - 1, SEQ - 1);
              const float pooled = s * __builtin_amdgcn_rcpf((float)(hi2 - lo + 1)) - UF(ut, j);
              pl[j * 136] = f2bf(pooled);
              s += UF(uhi, j) - UF(ulo, j);
          }
#undef UF
        }
        LBAR();
        { f32x16 acc = {};
#pragma unroll
          for (int s = 0; s < 8; ++s) { const bf16x8 a = *(const bf16x8*)(PL + (32 * ib + r32) * 136 + 16 * s + 8 * hi); acc = __builtin_amdgcn_mfma_f32_32x32x16_bf16(a, wfr[s], acc, 0, 0, 0); }
          float* OL = LDSF(GL_OL);
#pragma unroll
          for (int r = 0; r < 16; ++r) OL[(32 * ib + (r & 3) + 8 * (r >> 2) + 4 * hi) * 132 + 32 * nb + r32] = acc[r] * sc; }
        LBAR();
        { const u32x4 zz = {0u, 0u, 0u, 0u}; mixer_store(lds, AB + ((size_t)bc * SEQ + t0) * 1024 + gc * 128, false, zz, zz, tid); }
        if (!more) break;
        u = un;
    }
#undef POOL_LOAD
    LBAR();
}

constexpr int RT_XS = 0;
constexpr int RT_H = 69632;
__device__ __forceinline__ void router_tile(unsigned char* lds, CP p, int l, int tile, int tid, int lane, int wave) {
    const bf16* X1 = (const bf16*)(p->ws + WS_XB); const float* ROWSQ = (const float*)(p->ws + WS_ROWSQ); unsigned char* H8 = p->ws + WS_ABUF;
    int* CNT = (int*)(p->ws + WS_CTL) + 64 + l * 64; int* TOK = (int*)(p->ws + WS_TOK); float* GWL = (float*)(p->ws + WS_GWL);
    float* XS = LDSF(RT_XS + wave * 8704); int* H = (int*)(lds + RT_H); int* HB = H + 32;
    if (tid < 32) H[tid] = 0;
    const int tb = tile * 256 + wave * 32, b = tb >> 11;
    const float* sc2 = (const float*)(p->ws + WS_MOD) + ((size_t)(l * 32 + b) * 6144) + 4 * 1024; const float* sh2 = sc2 - 1024;
    const int rsub = lane >> 4, c4 = lane & 15, r32 = lane & 31, hi = lane >> 5;
    float rs[8];
#pragma unroll
    for (int it = 0; it < 8; ++it) { const f32x4* q = (const f32x4*)(ROWSQ + (size_t)(tb + 4 * it + rsub) * 16); const f32x4 a = q[0], bq = q[1], c = q[2], d = q[3];
        const float s = ((a[0] + a[1]) + (a[2] + a[3])) + ((bq[0] + bq[1]) + (bq[2] + bq[3])) + ((c[0] + c[1]) + (c[2] + c[3])) + ((d[0] + d[1]) + (d[2] + d[3]));
        rs[it] = 1.0f / sqrtf(s * (1.f / 1024.f) + EPS); }
    f32x16 acc = {};
    u32x2 xn[8];
#pragma unroll
    for (int it = 0; it < 8; ++it) xn[it] = *(const u32x2*)(X1 + (size_t)(tb + 4 * it + rsub) * 1024 + 4 * c4);
#pragma unroll 1
    for (int k0 = 0; k0 < 1024; k0 += 64) {
        f32x4 xc[8];
#pragma unroll
        for (int it = 0; it < 8; ++it) xc[it] = (f32x4){bflo(xn[it].x), bfhi(xn[it].x), bflo(xn[it].y), bfhi(xn[it].y)};
        if (k0 + 64 < 1024) {
#pragma unroll
            for (int it = 0; it < 8; ++it) xn[it] = *(const u32x2*)(X1 + (size_t)(tb + 4 * it + rsub) * 1024 + k0 + 64 + 4 * c4); }
        float bw[32];
#pragma unroll
        for (int s = 0; s < 4; ++s)
#pragma unroll
            for (int j = 0; j < 8; ++j) bw[8 * s + j] = p->w_router[(size_t)(k0 + 16 * s + 8 * hi + j) * 32 + r32];
        const f32x4 scv = *(const f32x4*)(sc2 + k0 + 4 * c4) + 1.0f, shv = *(const f32x4*)(sh2 + k0 + 4 * c4);
#pragma unroll
        for (int it = 0; it < 8; ++it) { const int row = 4 * it + rsub;
            const f32x4 hv = xc[it] * rs[it] * scv + shv; *(f32x4*)(XS + row * 68 + 4 * c4) = hv;
            *(unsigned*)(H8 + (size_t)(tb + row) * 1024 + k0 + 4 * c4) = pg8::pk4_fp8(hv[0], hv[1], hv[2], hv[3]); }
        asm volatile("s_waitcnt lgkmcnt(0)" ::: "memory");
#pragma unroll
        for (int s = 0; s < 4; ++s) { const f32x4 a0 = *(const f32x4*)(XS + r32 * 68 + 16 * s + 8 * hi), a1 = *(const f32x4*)(XS + r32 * 68 + 16 * s + 8 * hi + 4);
            const float av[8] = {a0[0], a0[1], a0[2], a0[3], a1[0], a1[1], a1[2], a1[3]};
            u32x4 ah, al, bh, bl; unsigned* ahp = (unsigned*)&ah; unsigned* alp = (unsigned*)&al; unsigned* bhp = (unsigned*)&bh; unsigned* blp = (unsigned*)&bl;
#pragma unroll
            for (int q = 0; q < 4; ++q) { const unsigned h = cvtpk(av[2 * q], av[2 * q + 1]); ahp[q] = h; alp[q] = cvtpk(av[2 * q] - bflo(h), av[2 * q + 1] - bfhi(h));
                const float b0 = bw[8 * s + 2 * q], b1 = bw[8 * s + 2 * q + 1]; const unsigned g = cvtpk(b0, b1); bhp[q] = g; blp[q] = cvtpk(b0 - bflo(g), b1 - bfhi(g)); }
            acc = __builtin_amdgcn_mfma_f32_32x32x16_bf16(__builtin_bit_cast(bf16x8, ah), __builtin_bit_cast(bf16x8, bh), acc, 0, 0, 0);
            acc = __builtin_amdgcn_mfma_f32_32x32x16_bf16(__builtin_bit_cast(bf16x8, ah), __builtin_bit_cast(bf16x8, bl), acc, 0, 0, 0);
            acc = __builtin_amdgcn_mfma_f32_32x32x16_bf16(__builtin_bit_cast(bf16x8, al), __builtin_bit_cast(bf16x8, bh), acc, 0, 0, 0); }
        asm volatile("s_waitcnt lgkmcnt(0)" ::: "memory");
    }
#pragma unroll
    for (int r = 0; r < 16; ++r) XS[((r & 3) + 8 * (r >> 2) + 4 * hi) * 33 + r32] = acc[r];
    asm volatile("s_waitcnt lgkmcnt(0)" ::: "memory");
    int e1 = 0, e2 = 0, rk1 = 0, rk2 = 0; float gw1 = 0.f, gw2 = 0.f;
    if (lane < 32) {
        float s[32], sel[32];
#pragma unroll
        for (int e = 0; e < 32; ++e) { const float lg = XS[lane * 33 + e]; s[e] = __builtin_amdgcn_rcpf(1.0f + __expf(-lg)); sel[e] = s[e] + p->b_router[e]; }
        float best = 0.f; int gi = 0;
#pragma unroll
        for (int g = 0; g < 4; ++g) { float m1 = -INFINITY, m2 = -INFINITY;
#pragma unroll
            for (int j = 0; j < 8; ++j) { const float v = sel[8 * g + j]; if (v > m1) { m2 = m1; m1 = v; } else if (v > m2) m2 = v; }
            const float gs = m1 + m2; if (g == 0 || gs > best) { best = gs; gi = g; } }
        float ig[8], sg[8];
#pragma unroll
        for (int j = 0; j < 8; ++j) { ig[j] = gi == 0 ? sel[j] : gi == 1 ? sel[8 + j] : gi == 2 ? sel[16 + j] : sel[24 + j]; sg[j] = gi == 0 ? s[j] : gi == 1 ? s[8 + j] : gi == 2 ? s[16 + j] : s[24 + j]; }
        int l1 = 0; float v1 = ig[0], w1 = sg[0];
#pragma unroll
        for (int j = 1; j < 8; ++j) if (ig[j] > v1) { v1 = ig[j]; l1 = j; w1 = sg[j]; }
        int l2 = l1 ^ 1; float v2 = -INFINITY, w2 = 0.f;
#pragma unroll
        for (int j = 0; j < 8; ++j) if (j != l1 && (ig[j] > v2 || (j == (l1 ^ 1) && v2 == -INFINITY))) { v2 = ig[j]; l2 = j; w2 = sg[j]; }
        e1 = 8 * gi + l1; e2 = 8 * gi + l2; const float inv = 1.0f / (w1 + w2); gw1 = w1 * inv; gw2 = w2 * inv;
    }
    __syncthreads();
    if (lane < 32) { rk1 = atomicAdd(&H[e1], 1); rk2 = atomicAdd(&H[e2], 1); }
    __syncthreads();
    if (tid < 32) HB[tid] = atomicAdd(&CNT[tid], H[tid]);
    __syncthreads();
    if (lane < 32) { const int t = tb + lane; const int p1 = HB[e1] + rk1, p2 = HB[e2] + rk2;
        TOK[e1 * 65536 + p1] = 2 * t; TOK[e2 * 65536 + p2] = 2 * t + 1;
        GWL[2 * t] = gw1; GWL[2 * t + 1] = gw2; ((int*)(GWL + 2 * T))[2 * t] = (e1 << 16) | p1; ((int*)(GWL + 2 * T))[2 * t + 1] = (e2 << 16) | p2; }
    __syncthreads();
}
__device__ __forceinline__ void moe_tables(unsigned char* lds, CP p, int l, int tid) {
    int* tab = (int*)(lds + LDS_SPARE); const int* CNT = (const int*)(p->ws + WS_CTL) + 64 + l * 64;
    __syncthreads();
    if (tid < 64) {
        const int c = tid < 32 ? CNT[tid] : 0; int v = (c + 255) >> 8; const int own = v;
#pragma unroll
        for (int o = 1; o < 32; o <<= 1) { const int n = __shfl_up(v, o); if ((tid & 31) >= o) v += n; }
        if (tid < 32) { tab[2 + tid] = v - own; tab[34 + tid] = c; if (tid == 31) { tab[0] = v; tab[1] = (v + 7) & ~7; } }
    }
    __syncthreads();
    const int Rt = tab[0];
    for (int rt = tid; rt < Rt; rt += 512) { int e = 0;
#pragma unroll 1
        for (int q = 1; q < 32; ++q) if (tab[2 + q] <= rt) e = q;
        tab[128 + rt] = e; }
    __syncthreads();
}
constexpr int ROWTAB_OFF = LDS_SPARE + 4096, ROWTAB_UNITS = (LDS_BYTES - 64 - ROWTAB_OFF) / 1024;
__device__ __forceinline__ void moe_rowtab(unsigned char* lds, CP p, int G, int bx, int tid) {
    const int* tab = (const int*)(lds + LDS_SPARE); int* rowtab = (int*)(lds + ROWTAB_OFF); const int* TOK = (const int*)(p->ws + WS_TOK);
    pg8::MoeOrder S{(const PG8_LAS int*)(lds + LDS_SPARE), G, bx};
    int tv[ROWTAB_UNITS]; int nu = 0;
#pragma unroll
    for (int i = 0; i < ROWTAB_UNITS; ++i) { pg8::Unit u; tv[i] = 0;
        if (S.next(i, u)) { nu = i + 1; const int valid = u.x0 >> 8, e = u.x0 & 0xff, pos = u.x1 + tid;
            if (tid < 256 && valid && pos < tab[34 + e]) tv[i] = TOK[e * 65536 + pos] >> 1; } }
#pragma unroll
    for (int i = 0; i < ROWTAB_UNITS; ++i) if (i < nu && tid < 256) rowtab[i * 256 + tid] = tv[i];
    __syncthreads();
}
template <int NR>
__device__ __forceinline__ void combine_loop(CP p, int l, int gw, int ngw, int lane) {
    const bf16* XB = (const bf16*)(p->ws + WS_XB); const unsigned char* Yb = p->ws + WS_Y2;
    const float* GWT = (const float*)(p->ws + WS_GWL); const int* SLW = (const int*)(GWT + 2 * T);
    int sb; { const int* CNT = (const int*)(p->ws + WS_CTL) + 64 + l * 64; const int c = lane < 32 ? CNT[lane] : 0; int v = ((c + 255) >> 8) * 256; const int own = v;
#pragma unroll
        for (int o = 1; o < 32; o <<= 1) { const int n = __shfl_up(v, o); if ((lane & 31) >= o) v += n; }
        sb = v - own; }
    const int rpw = (((T + ngw - 1) / ngw) + NR - 1) / NR * NR, tfirst = gw * rpw, tlast = (tfirst + rpw) < T ? (tfirst + rpw) : T;
    struct Set { u32x2 xw[NR][4]; unsigned y0[NR][4], y1[NR][4]; float gA[NR], gB[NR]; int sA[NR], sB[NR]; };
    Set A, B;
    f32x4 g2v[4], scv[4];
#define CB_IDX(S_, TB) do { _Pragma("unroll") for (int r = 0; r < NR; ++r) { const int t_ = (TB) + r; S_.sA[r] = SLW[2 * t_]; S_.sB[r] = SLW[2 * t_ + 1]; } } while (0)
#define CB_LOAD(S_, TB) do { _Pragma("unroll") for (int r = 0; r < NR; ++r) { const int t_ = (TB) + r; \
        const int ra_ = __shfl(sb, S_.sA[r] >> 16) + (S_.sA[r] & 0xffff), rb_ = __shfl(sb, S_.sB[r] >> 16) + (S_.sB[r] & 0xffff); \
        const u32x2* xr_ = (const u32x2*)(XB + (size_t)t_ * 1024) + lane; const unsigned* ya_ = (const unsigned*)(Yb + (size_t)ra_ * 1024) + lane; const unsigned* yb_ = (const unsigned*)(Yb + (size_t)rb_ * 1024) + lane; \
        S_.gA[r] = GWT[2 * t_]; S_.gB[r] = GWT[2 * t_ + 1]; \
        _Pragma("unroll") for (int j = 0; j < 4; ++j) { S_.xw[r][j] = xr_[64 * j]; S_.y0[r][j] = ya_[64 * j]; S_.y1[r][j] = yb_[64 * j]; } } } while (0)
#pragma unroll 1
    for (int t0 = tfirst; t0 < tlast; ) {
    const int tend = (((t0 >> 11) + 1) << 11) < tlast ? (((t0 >> 11) + 1) << 11) : tlast;
    { const int bcur = t0 >> 11;
      const f32x4* g2 = (const f32x4*)((const float*)(p->ws + WS_MOD) + (size_t)(l * 32 + bcur) * 6144 + 5 * 1024) + lane;
      const f32x4* sc = (const f32x4*)((const float*)(p->ws + WS_MOD) + (size_t)((l + 1 < DEPTH ? l + 1 : l) * 32 + bcur) * 6144 + 1024) + lane;
#pragma unroll
      for (int j = 0; j < 4; ++j) { g2v[j] = g2[64 * j]; scv[j] = l + 1 < DEPTH ? sc[64 * j] + 1.0f : ((const f32x4*)p->final_g + lane)[64 * j]; } }
    CB_IDX(A, t0); if (t0 + NR < tend) CB_IDX(B, t0 + NR);
    CB_LOAD(A, t0);
    auto step = [&](auto allc, Set& cur, Set& nxt, const int tb) __attribute__((always_inline)) { constexpr bool ALL = decltype(allc)::value;
        if (ALL || tb + 2 * NR < tend) CB_IDX(cur, tb + 2 * NR);
        asm volatile("" ::: "memory");
        if (ALL || tb + NR < tend) CB_LOAD(nxt, tb + NR);
        asm volatile("" ::: "memory");
        f32x4 v[NR][4]; float s[NR];
#pragma unroll
        for (int r = 0; r < NR; ++r) { s[r] = 0.f;
#pragma unroll
            for (int j = 0; j < 4; ++j) { const unsigned a = cur.y0[r][j], bq = cur.y1[r][j]; const u32x2 xq = cur.xw[r][j];
                typedef float f2_ __attribute__((ext_vector_type(2)));
                const f2_ a01 = __builtin_amdgcn_cvt_pk_f32_fp8((int)a, false), a23 = __builtin_amdgcn_cvt_pk_f32_fp8((int)a, true), b01 = __builtin_amdgcn_cvt_pk_f32_fp8((int)bq, false), b23 = __builtin_amdgcn_cvt_pk_f32_fp8((int)bq, true);
                f32x4 ys = {cur.gA[r] * a01[0] + cur.gB[r] * b01[0], cur.gA[r] * a01[1] + cur.gB[r] * b01[1], cur.gA[r] * a23[0] + cur.gB[r] * b23[0], cur.gA[r] * a23[1] + cur.gB[r] * b23[1]};
                if (!((MK_MASK >> 10) & 1)) ys = (f32x4){0.f, 0.f, 0.f, 0.f};
                const f32x4 xv = {bflo(xq.x), bfhi(xq.x), bflo(xq.y), bfhi(xq.y)};
                v[r][j] = xv + g2v[j] * ys; s[r] += (v[r][j][0] * v[r][j][0] + v[r][j][1] * v[r][j][1]) + (v[r][j][2] * v[r][j][2] + v[r][j][3] * v[r][j][3]); } }
#pragma unroll
        for (int o = 1; o < 64; o <<= 1) {
#pragma unroll
            for (int r = 0; r < NR; ++r) s[r] += __shfl_xor(s[r], o); }
#pragma unroll
        for (int r = 0; r < NR; ++r) { const int t = tb + r;
            if (t < tend) {
            const float rstd = __builtin_amdgcn_rsqf(s[r] * (1.f / 1024.f) + EPS);
            if (l + 1 < DEPTH) {
                u32x2* xo = (u32x2*)((bf16*)(p->ws + WS_XB) + (size_t)t * 1024) + lane;
                u32x2* o = (u32x2*)((bf16*)(p->ws + WS_ABUF) + (size_t)t * 1024) + lane;
#pragma unroll
                for (int j = 0; j < 4; ++j) { u32x2 xq; xq.x = cvtpk(v[r][j][0], v[r][j][1]); xq.y = cvtpk(v[r][j][2], v[r][j][3]); xo[64 * j] = xq; const f32x4 w = v[r][j] * scv[j]; u32x2 q; q.x = cvtpk(w[0], w[1]); q.y = cvtpk(w[2], w[3]); o[64 * j] = q; }
                if (lane == 0) ((float*)(p->ws + WS_RSTD))[t] = rstd;
            } else {
                f32x4* xr = (f32x4*)(p->out + (size_t)t * 1024) + lane;
#pragma unroll
                for (int j = 0; j < 4; ++j) xr[64 * j] = v[r][j] * rstd * scv[j];
            } } }
        asm volatile("" ::: "memory");
    };
    int tb = t0;
#pragma unroll 1
    for (; tb + 3 * NR < tend; tb += 2 * NR) { step(BoolC<true>{}, A, B, tb); step(BoolC<true>{}, B, A, tb + NR); }
#pragma unroll 1
    for (; tb < tend; tb += 2 * NR) { step(BoolC<false>{}, A, B, tb); if (tb + NR < tend) step(BoolC<false>{}, B, A, tb + NR); }
    t0 = tend; }
#undef CB_LOAD
#undef CB_IDX
}

#define PHASE_ENTER \
        CP p = (CP)__builtin_amdgcn_kernarg_segment_ptr(); asm volatile("" : "+s"(p)); \
        int tid = threadIdx.x; asm volatile("" : "+v"(tid)); \
        const int lane = tid & 63, wave = __builtin_amdgcn_readfirstlane(tid >> 6); \
        int G = gridDim.x, bx = blockIdx.x; asm volatile("" : "+s"(G), "+s"(bx)); \
        const int vcu = (G % 8 == 0) ? (bx % 8) * (G / 8) + bx / 8 : bx; \
        const int gw = vcu * 8 + wave, NGW = G * 8; \
        unsigned char* ws = p->ws; float* MOD = (float*)(ws + WS_MOD); \
        (void)lane; (void)wave; (void)gw; (void)NGW; (void)MOD; (void)vcu;
#define RUN_PHASE(k, c, LL, ...) \
    if (p0.ph_lo <= (k) && (k) < p0.ph_hi) { \
        const unsigned long long tph0 = MK_DIL ? __builtin_amdgcn_s_memrealtime() : 0ull; \
        if ((MK_MASK >> (c)) & 1) { \
            _Pragma("unroll 1") for (int rep = 0; rep < ((((MK_REP >> (c)) & 1) && !((c) == 6 && (LL) == 1)) ? 2 : 1); ++rep) { PHASE_ENTER __VA_ARGS__ } } \
        if ((k) + 1 < p0.ph_hi) { if (p0.ph_lo < 0) grid.sync(); else xcd_barrier(bar); }     \
        if (MK_DIL && ((MK_DIL >> (c)) & 1)) { const unsigned long long t1 = __builtin_amdgcn_s_memrealtime(), dt = t1 - tph0; while (__builtin_amdgcn_s_memrealtime() - t1 < dt) __builtin_amdgcn_s_sleep(8); } \
    }
#define LAYER_PHASES(l) \
    RUN_PHASE(2 + 8 * (l), 2, l, {     \
        pg8::Gemm g{(const bf16*)(ws + WS_ABUF), (const bf16*)(ws + WS_WIN) + (size_t)(l) * ZP * 1024, T, ZP, 1024}; pg8::StaticOrder S; S.init(T, ZP, G, bx); \
        pg8::EpiZ E{(bf16*)(ws + WS_Z), (const float*)(ws + WS_RSTD), (const float*)(ws + WS_BIASIN) + (size_t)(l) * 32 * ZP, ZP, DIN}; \
        pg8::gemm_phase<pg8::EpiZ, pg8::StaticOrder, true, true>((PG8_LAS unsigned char*)lds, g, S, E); }) \
    RUN_PHASE(3 + 8 * (l), 3, l, {     \
        for (int item = vcu; item < 256; item += G) gla_chain(lds, p, l, item, tid, lane, wave); \
        pool_phase(lds, p, l, vcu, G, tid, lane, wave); if (MK_POOL2) pool_phase(lds, p, l, vcu, G, tid, lane, wave); }) \
    RUN_PHASE(4 + 8 * (l), 5, l, { gla_stepC_phase(lds, p, l, vcu, G, tid, lane, wave); }) \
    RUN_PHASE(5 + 8 * (l), 6, l, {     \
        pg8::Gemm g{(const bf16*)(ws + WS_ABUF), (const bf16*)(ws + WS_WOUT + (size_t)(l) * 1024 * 1024), T, 1024, 512}; pg8::StaticOrder S; S.init(T, 1024, G, bx);     \
        pg8::EpiRes E{(l) == 0 ? p->x : nullptr, (const bf16*)(ws + WS_XB), (bf16*)(ws + WS_XB), MOD + (size_t)(l) * 32 * 6144 + 2 * 1024, (float*)(ws + WS_ROWSQ)}; \
        pg8::gemm_phase<pg8::EpiRes, pg8::StaticOrder, true, true, true>((PG8_LAS unsigned char*)lds, g, S, E); }) \
    RUN_PHASE(6 + 8 * (l), 7, l, { for (int tile = vcu; tile < T / 256; tile += G) router_tile(lds, p, l, tile, tid, lane, wave); }) \
    RUN_PHASE(7 + 8 * (l), 9, l, {     \
        moe_tables(lds, p, l, tid); moe_rowtab(lds, p, G, bx, tid); \
        pg8::Gemm g{(const bf16*)(ws + WS_ABUF), (const bf16*)(ws + WS_W13 + (size_t)(l) * 32 * 1024 * 1024), T, 32 * 1024, 512};     \
        pg8::MoeOrderG S; S.tab = (const PG8_LAS int*)(lds + LDS_SPARE); S.G = G; S.c = bx; S.rowtab = (const PG8_LAS int*)(lds + ROWTAB_OFF); pg8::EpiAct E{ws + WS_ACT}; \
        pg8::gemm_phase_gather<pg8::EpiAct, pg8::MoeOrderG, true, true, true>((PG8_LAS unsigned char*)lds, g, S, E); }) \
    RUN_PHASE(8 + 8 * (l), 10, l, { \
        moe_tables(lds, p, l, tid); \
        pg8::Gemm g{(const bf16*)(ws + WS_ACT), (const bf16*)(ws + WS_W2 + (size_t)(l) * 32 * 1024 * 512), HS_ROWS, 32 * 1024, 256};     \
        pg8::MoeOrder S{(const PG8_LAS int*)(lds + LDS_SPARE), G, bx}; \
        pg8::EpiY E{ws + WS_Y2}; \
        pg8::gemm_phase<pg8::EpiY, pg8::MoeOrder, true, true, true>((PG8_LAS unsigned char*)lds, g, S, E); }) \
    RUN_PHASE(9 + 8 * (l), 11, l, { combine_loop<2>(p, l, gw, NGW, lane); })

constexpr int NPHASE = 2 + 8 * DEPTH;
__global__ void __launch_bounds__(512, 2) fwd_kernel(Params p0) {
    extern __shared__ __attribute__((aligned(16))) unsigned char lds[];
    cg::grid_group grid = cg::this_grid();
    if (threadIdx.x < 2) ((LAS unsigned*)(lds + LDS_BYTES - 64))[threadIdx.x] = 0u;
    __syncthreads();
    const XcdBarrier bar = xcd_barrier_post((unsigned*)(p0.ws + WS_CTL) + 4096, (volatile LAS unsigned*)(lds + LDS_BYTES - 64));
    RUN_PHASE(0, 0, 0, {
        if (vcu < 192) { const int l2 = vcu / 96, n0 = (vcu % 96) * 64;
            gemv32_item(lds, p->c, 1024, true, p->w_mod + (size_t)l2 * 1024 * 6144, 6144, 6144, 6144, n0, p->b_mod + l2 * 6144, MOD + (size_t)l2 * 32 * 6144, 6144, tid, lane, wave); }
        asm volatile("" : "+v"(tid));
        { u32x4* z = (u32x4*)(ws + WS_WIN); const u32x4 zero = {0u, 0u, 0u, 0u};
          for (int i = bx * 512 + tid; i < 2 * 224 * 128; i += G * 512) { const int l2 = i / (224 * 128), r = i % (224 * 128); z[(size_t)l2 * 2304 * 128 + 2080 * 128 + r] = zero; } }
        {
            float* scr = (float*)(lds + wave * 16384);
            for (int it = gw; it < 32; it += NGW) { const int l2 = it / 16; p0_transpose_item(p->w_in + (size_t)l2 * 1024 * DIN, 1024, DIN, (bf16*)(ws + WS_WIN) + (size_t)l2 * ZP * 1024, 0, scr, (it % 16) * 65 + 64, tid & 63); }
        }
        __syncthreads();
        {
            float* TL = (float*)lds; f32x4 regs[8];
            int t = vcu; P0Tile cur = p0_tile(p, ws, t < P0_NTILES ? t : 0);
            if (t < P0_NTILES) p0_tile_load(regs, cur.W, cur.N, cur.k0, cur.n0, tid);
            _Pragma("unroll 1")
            for (; t < P0_NTILES; t += G) {
                p0_tile_to_lds(TL, regs, tid);
                const int tn = t + G; P0Tile nxt = p0_tile(p, ws, tn < P0_NTILES ? tn : 0);
                if (tn < P0_NTILES) p0_tile_load(regs, nxt.W, nxt.N, nxt.k0, nxt.n0, tid);
                LBAR();
                if (cur.f8) p0_tile_store8(TL, (unsigned char*)cur.WT, cur.K, cur.k0, cur.rbase, cur.perm, tid); else p0_tile_store(TL, cur.WT, cur.K, cur.k0, cur.rbase, cur.perm, tid);
                LBAR();
                cur = nxt;
            }
        }
    })
    RUN_PHASE(1, 1, 0, {
        if (vcu < 72) { const int l2 = vcu / 36, n0 = (vcu % 36) * 64;
            gemv32_item(lds, MOD + (size_t)l2 * 32 * 6144, 6144, false, p->w_in + (size_t)l2 * 1024 * DIN, DIN, DIN, ZP, n0, nullptr, (float*)(ws + WS_BIASIN) + (size_t)l2 * 32 * ZP, ZP, tid, lane, wave); }
        int lane2 = lane; asm volatile("" : "+v"(lane2));
        rows_prep_loop<2>(p->x, MOD, (bf16*)(ws + WS_ABUF), (float*)(ws + WS_RSTD), gw, NGW, lane2);
    })
    LAYER_PHASES(0)
    LAYER_PHASES(1)
}

extern "C" void kernel_launch(void* const* d_in, const int* in_sizes, int n_in, void* d_out, int out_size, void* d_ws, size_t ws_size, hipStream_t stream) {
    static int grid = 0;
    if (grid == 0) {
        if (n_in != 17 || out_size != T * DM || ws_size < WS_END) { fprintf(stderr, "kernel_launch: unexpected shapes: n_in %d out %d ws %zu (need %zu)\n", n_in, out_size, ws_size, (size_t)WS_END); grid = -1; return; }
        int dev = 0, cus = 0, per_cu = 0;
        (void)hipGetDevice(&dev); (void)hipDeviceGetAttribute(&cus, hipDeviceAttributeMultiprocessorCount, dev);
        (void)hipFuncSetAttribute((const void*)fwd_kernel, hipFuncAttributeMaxDynamicSharedMemorySize, LDS_BYTES);
        (void)hipOccupancyMaxActiveBlocksPerMultiprocessor(&per_cu, (const void*)fwd_kernel, 512, LDS_BYTES);
        if (per_cu < 1) { fprintf(stderr, "kernel_launch: occupancy query says %d blocks per CU\n", per_cu); grid = -1; return; }
        grid = cus;
    }
    if (grid < 0) return;
    (void)hipMemsetAsync((char*)d_ws + WS_CTL, 0, 65536, stream);
    Params p{};
    const float** pp = (const float**)&p;
    for (int i = 0; i < 17; ++i) pp[i] = (const float*)d_in[i];
    p.out = (float*)d_out; p.ws = (unsigned char*)d_ws;
#if MK_MULTI
    for (int k = 0; k < NPHASE; ++k) { p.ph_lo = k; p.ph_hi = k + 1; void* args[] = {&p};
        hipError_t e = hipLaunchCooperativeKernel((const void*)fwd_kernel, dim3(grid), dim3(512), args, LDS_BYTES, stream);
        if (e != hipSuccess) { fprintf(stderr, "launch of phase %d failed: %s\n", k, hipGetErrorString(e)); break; } }
#else
    p.ph_lo = 0; p.ph_hi = NPHASE; void* args[] = {&p};
    hipError_t e = hipLaunchCooperativeKernel((const void*)fwd_kernel, dim3(grid), dim3(512), args, LDS_BYTES, stream);
    if (e != hipSuccess) fprintf(stderr, "cooperative launch failed: %s (grid %d)\n", hipGetErrorString(e), grid);
#endif
}
```
